# Optimizing an MI355X kernel written in HIP

```python
import jax
import jax.numpy as jnp
from jax import lax
import numpy as np

D_MODEL = 1024
BATCH = 4
SEQ = 4096
DEPTH = 4
DEC_BATCH = 128
DEC_SEQ = 4
PAST_LEN = 2048
PAGE_SIZE = 128

N_A = DEPTH // 2
N_B = DEPTH - N_A
RWKV_HEAD = 64
RWKV_H = D_MODEL // RWKV_HEAD
LORA_DECAY = 64
LORA_A = 64
LORA_V = 32
LORA_G = 160
GN_EPS = 64e-5
N_HEADS = 16
HEAD_DIM = 64
N_KV = 4
GROUP = N_HEADS // N_KV
CMP_STRIDE = 16
CMP_LEN = 2 * CMP_STRIDE
CMP_HID = 2 * HEAD_DIM
SEL_BLOCK = 64
N_SEL = 16
WINDOW = 512
Q_BLOCK = 64
QROW_BUDGET = 256
D_FF = 2816
RMS_EPS = 1e-6
NEG_INF = -1e30
FORCED_SCORE = 1e4

kernel_name = 'yoco_rwkv7_nsa_macaron_step'

RWKV_PARAMS = ('rw_mu', 'rw_w_rkv', 'rw_w0', 'rw_w1', 'rw_w2', 'rw_a0', 'rw_a1', 'rw_a2',
               'rw_g1', 'rw_g2', 'rw_k_k', 'rw_k_a', 'rw_r_k', 'rw_lnx_w', 'rw_lnx_b', 'rw_w_o')


def rms_norm(x, g):
    xf = x.astype(jnp.float32)
    y = xf * lax.rsqrt(jnp.mean(xf * xf, axis=-1, keepdims=True) + RMS_EPS)
    return (y * g.astype(jnp.float32)).astype(x.dtype)


def swiglu(x, w_in, w_out):
    gate, up = jnp.split(x @ w_in, 2, axis=-1)
    return (jax.nn.silu(gate) * up) @ w_out


def alibi_slopes(n):
    return jnp.exp2(-8.0 * jnp.arange(1, n + 1, dtype=jnp.float32) / n)


def query_block(n_rows, tq):
    return max(1, min(Q_BLOCK, tq, QROW_BUDGET // n_rows))


def rwkv7_mix(x, shift0, s0, v_first, ap, vres):
    (mu, w_rkv, w0, w1, w2, a0, a1, a2, g1, g2, k_k, k_a, r_k, lnx_w, lnx_b, w_o) = ap
    B, T, D = x.shape
    x_prev = jnp.concatenate([shift0[:, None, :].astype(x.dtype), x[:, :-1]], axis=1)
    xx = x_prev - x
    xs = x[None] + xx[None] * mu[:, None, None, :]
    r, k, v = jnp.einsum('cbtd,cde->cbte', xs[:3], w_rkv)
    xv, xw, xa, xg = xs[2], xs[3], xs[4], xs[5]
    w = -jax.nn.softplus(-(w0 + jnp.tanh(xw @ w1) @ w2)) - 0.5
    a = jax.nn.sigmoid(a0 + (xa @ a1) @ a2)
    g = jax.nn.sigmoid(xg @ g1) @ g2
    if vres is None:
        v_first = v
    else:
        v0, v1, v2 = vres
        v = v + (v_first - v) * jax.nn.sigmoid(v0 + (xv @ v1) @ v2)

    def heads(t):
        return t.astype(jnp.float32).reshape(B, T, RWKV_H, RWKV_HEAD)

    kk = heads(k * k_k)
    kk = kk * lax.rsqrt(jnp.maximum(jnp.sum(kk * kk, axis=-1, keepdims=True), 1e-24))
    k = k * (1.0 + (a - 1.0) * k_a)
    rh, kh, vh, ah = heads(r), heads(k), heads(v), heads(a)
    decay = jnp.exp(-jnp.exp(heads(w)))

    def tm(t):
        return jnp.swapaxes(t, 0, 1)

    def step(S, inp):
        r_t, w_t, k_t, v_t, a_t, b_t = inp
        sa = jnp.einsum('bhij,bhj->bhi', S, a_t)
        S = S * w_t[:, :, None, :] + sa[..., None] * b_t[:, :, None, :] + v_t[..., None] * k_t[:, :, None, :]
        return S, jnp.einsum('bhij,bhj->bhi', S, r_t)

    S_T, ys = lax.scan(step, s0.astype(jnp.float32),
                       (tm(rh), tm(decay), tm(kh), tm(vh), tm(-kk), tm(kk * ah)))
    y = jnp.swapaxes(ys, 0, 1)
    mean = jnp.mean(y, axis=-1, keepdims=True)
    var = jnp.mean(jnp.square(y - mean), axis=-1, keepdims=True)
    y = ((y - mean) * lax.rsqrt(var + GN_EPS)).reshape(B, T, D) * lnx_w + lnx_b
    bonus = jnp.sum(rh * kh * r_k.astype(jnp.float32), axis=-1, keepdims=True) * vh
    y = y + bonus.reshape(B, T, D)
    out = (y.astype(x.dtype) * g) @ w_o
    return out, x[:, -1], S_T.astype(s0.dtype), v_first


def nsa_compress(k, pos, w1, w2):
    B, tkp = k.shape[:2]
    n = tkp // CMP_STRIDE
    half = CMP_STRIDE * HEAD_DIM
    ch = k.reshape(B, n, CMP_STRIDE, N_KV, HEAD_DIM).transpose(0, 1, 3, 2, 4).reshape(B, n, N_KV, half)
    w1 = w1.astype(jnp.float32)
    h_lo = ch @ w1[:half]
    h_hi = ch @ w1[half:]
    h_hi = jnp.concatenate([h_hi[:, 1:], jnp.zeros_like(h_hi[:, :1])], axis=1)
    h = jax.nn.gelu(h_lo + h_hi + pos.astype(jnp.float32).reshape(-1) @ w1)
    return h @ w2.astype(jnp.float32)


def nsa_prepare(kc, vc, ks, vs, kw, vw, tq, cmp_pos, cmp_w1, cmp_w2):
    B, tk_pad = kc.shape[:2]
    k_cmp = nsa_compress(kc, cmp_pos[0], cmp_w1[0], cmp_w2[0]).transpose(0, 2, 1, 3)
    v_cmp = nsa_compress(vc, cmp_pos[1], cmp_w1[1], cmp_w2[1]).transpose(0, 2, 1, 3)
    n_sel = tk_pad // SEL_BLOCK

    def blocks(t):
        return t.reshape(B, n_sel, SEL_BLOCK, N_KV, HEAD_DIM).transpose(0, 3, 1, 2, 4)

    qb = query_block(B, tq)
    tq_pad = -(-tq // qb) * qb

    def pad_w(t):
        return jnp.pad(t, ((0, 0), (WINDOW, tq_pad - tq), (0, 0), (0, 0)))

    return (k_cmp, v_cmp, blocks(ks), blocks(vs), pad_w(kw), pad_w(vw))


def nsa_attend(q, gates, shared, q_pos0, w_pos0):
    k_cmp, v_cmp, ksb, vsb, kwp, vwp = shared
    B, TQ = q.shape[:2]
    NC, NS = k_cmp.shape[2], ksb.shape[2]
    n_top = min(N_SEL, NS)
    qb = query_block(B, TQ)
    n_qb = -(-TQ // qb)
    TQp = n_qb * qb
    padq = ((0, 0), (0, TQp - TQ), (0, 0), (0, 0))
    qg = jnp.pad(q.astype(jnp.float32) * HEAD_DIM ** -0.5, padq)
    qg = qg.reshape(B, n_qb, qb, N_KV, GROUP, HEAD_DIM).transpose(1, 0, 3, 4, 2, 5)
    gg = jnp.pad(gates, padq).reshape(B, n_qb, qb, N_KV, GROUP, 3).transpose(1, 0, 3, 4, 2, 5)
    slopes = alibi_slopes(N_HEADS).reshape(N_KV, GROUP)[None, :, :, None, None]
    cmp_start = jnp.arange(NC) * CMP_STRIDE
    cmp_end = cmp_start + (CMP_LEN - 1)
    blk = jnp.arange(NS)
    overlap = ((cmp_start[:, None] < (blk[None, :] + 1) * SEL_BLOCK)
               & (cmp_start[:, None] + CMP_LEN > blk[None, :] * SEL_BLOCK)).astype(jnp.float32)
    bi = jnp.arange(B)[:, None, None]
    hi = jnp.arange(N_KV)[None, :, None]
    within = jnp.arange(SEL_BLOCK)
    win_off = jnp.arange(WINDOW + qb)

    def one_block(args):
        i, qi, gi = args
        t0 = q_pos0 + i * qb
        t = t0 + jnp.arange(qb)
        d_c = t[:, None] - cmp_end[None, :]
        ok_c = d_c >= 0
        s = jnp.einsum('bkgqd,bknd->bkgqn', qi, k_cmp) - slopes * d_c.astype(jnp.float32)
        p_c = jnp.where(ok_c, jax.nn.softmax(jnp.where(ok_c, s, NEG_INF), axis=-1), 0.0)
        o_c = jnp.einsum('bkgqn,bknd->bkgqd', p_c, v_cmp)
        cur = t // SEL_BLOCK
        imp = jnp.einsum('bkgqn,ns->bkqs', p_c, overlap)
        forced = (blk[None, :] == 0) | (blk[None, :] == cur[:, None]) | (blk[None, :] == cur[:, None] - 1)
        imp = jnp.where(blk[None, :] <= cur[:, None], jnp.where(forced, FORCED_SCORE, imp), -1.0)
        _, idx = lax.top_k(imp, n_top)
        flat = idx.reshape(B, N_KV, qb * n_top)
        kg = ksb[bi, hi, flat].reshape(B, N_KV, qb, n_top * SEL_BLOCK, HEAD_DIM)
        vg = vsb[bi, hi, flat].reshape(B, N_KV, qb, n_top * SEL_BLOCK, HEAD_DIM)
        spos = (idx[..., None] * SEL_BLOCK + within).reshape(B, N_KV, qb, n_top * SEL_BLOCK)
        d_s = (t[:, None] - spos)[:, :, None]
        s = jnp.einsum('bkgqd,bkqsd->bkgqs', qi, kg) - slopes * d_s.astype(jnp.float32)
        p_s = jax.nn.softmax(jnp.where(d_s >= 0, s, NEG_INF), axis=-1)
        o_s = jnp.einsum('bkgqs,bkqsd->bkgqd', p_s, vg)
        start = t0 - w_pos0
        kw = lax.dynamic_slice_in_dim(kwp, start, WINDOW + qb, axis=1)
        vw = lax.dynamic_slice_in_dim(vwp, start, WINDOW + qb, axis=1)
        wpos = t0 - WINDOW + win_off
        d_w = t[:, None] - wpos[None, :]
        ok_w = (d_w >= 0) & (d_w <= WINDOW) & (wpos[None, :] >= w_pos0)
        s = jnp.einsum('bkgqd,bskd->bkgqs', qi, kw) - slopes * d_w.astype(jnp.float32)
        p_w = jax.nn.softmax(jnp.where(ok_w, s, NEG_INF), axis=-1)
        o_w = jnp.einsum('bkgqs,bskd->bkgqd', p_w, vw)
        return gi[..., 0:1] * o_c + gi[..., 1:2] * o_s + gi[..., 2:3] * o_w

    o = lax.map(one_block, (jnp.arange(n_qb), qg, gg))
    return o.transpose(1, 0, 4, 2, 3, 5).reshape(B, TQp, N_HEADS * HEAD_DIM)[:, :TQ]


def nsa_layer(xn, w_in, w_o, shared, q_pos0, w_pos0):
    B, T, _ = xn.shape
    nq = N_HEADS * HEAD_DIM
    z = xn @ w_in
    q = z[..., :nq].reshape(B, T, N_HEADS, HEAD_DIM)
    gates = jax.nn.sigmoid(z[..., nq:].astype(jnp.float32)).reshape(B, T, N_HEADS, 3)
    o = nsa_attend(q, gates, shared, q_pos0, w_pos0)
    return o.astype(xn.dtype) @ w_o


def trunk(x, shift_in, wkv_in, past_cs, win_buf, win_keep, q_pos0, P):
    B, T, _ = x.shape
    h = x
    shifts, states = [], []
    v_first = None
    shared = None
    w_pos0 = 0
    cs_new = None
    win_state = None
    for l in range(DEPTH):
        g = P['norm_g'][l]
        h = h + 0.5 * swiglu(rms_norm(h, g[0]), P['ffn_w_in'][l, 0], P['ffn_w_out'][l, 0])
        xn = rms_norm(h, g[1])
        if l < N_A:
            ap = tuple(P[n][l] for n in RWKV_PARAMS)
            vres = None if l == 0 else (P['rw_v0'][l - 1], P['rw_v1'][l - 1], P['rw_v2'][l - 1])
            mix, sh, st, v_first = rwkv7_mix(xn, shift_in[l], wkv_in[l], v_first, ap, vres)
            shifts.append(sh)
            states.append(st)
        else:
            mix = nsa_layer(xn, P['b_w_in'][l - N_A], P['b_w_o'][l - N_A], shared, q_pos0, w_pos0)
        h = h + mix
        h = h + 0.5 * swiglu(rms_norm(h, g[2]), P['ffn_w_in'][l, 1], P['ffn_w_out'][l, 1])
        if l == N_A - 1:
            kv = (rms_norm(h, P['kv_norm_g']) @ P['kv_w']).reshape(B, T, 6, N_KV, HEAD_DIM)
            cs_new = kv[:, :, :4]
            win_new = kv[:, :, 4:]
            tk = q_pos0 + T
            tk_pad = -(-tk // SEL_BLOCK) * SEL_BLOCK
            zpad = jnp.zeros((B, tk_pad - tk, N_KV, HEAD_DIM), jnp.float32)
            rows = []
            for c in range(4):
                past = [] if past_cs is None else [past_cs[:, :, c].astype(jnp.float32)]
                rows.append(jnp.concatenate(past + [cs_new[:, :, c].astype(jnp.float32), zpad], axis=1))
            win_all = win_new if win_buf is None else jnp.concatenate(
                [win_buf.astype(win_new.dtype), win_new], axis=1)
            w_pos0 = tk - win_all.shape[1]
            win_state = win_all[:, win_all.shape[1] - win_keep:]
            wf = win_all.astype(jnp.float32)
            shared = nsa_prepare(rows[0], rows[1], rows[2], rows[3], wf[:, :, 0], wf[:, :, 1], T,
                                 P['cmp_pos'], P['cmp_w1'], P['cmp_w2'])
    y = rms_norm(h, P['final_g'])
    return y, jnp.stack(shifts), jnp.stack(states), cs_new, win_state


def setup_inputs(seed: int = 0) -> dict:
    key = jax.random.key(seed)
    keys = jax.random.split(key, 64)
    counter = iter(range(64))

    def nk():
        return keys[next(counter)]

    def nrm(shape, scale=1.0):
        return scale * jax.random.normal(nk(), shape, jnp.float32)

    D = D_MODEL
    n_pages = PAST_LEN // PAGE_SIZE
    n_used = DEC_BATCH * n_pages
    n_pool = (5 * n_used + 3) // 4
    perm = jax.random.permutation(nk(), n_pool)
    page_table = perm[:n_used].reshape(DEC_BATCH, n_pages).astype(jnp.int32)
    ramp = (jnp.arange(D, dtype=jnp.float32) / (D - 1)) ** 1.2
    n_q = N_HEADS * HEAD_DIM
    return {
        'x_prompt': nrm((BATCH, SEQ, D)),
        'x_sample': nrm((DEC_BATCH, DEC_SEQ, D)),
        'cache_cs': nrm((n_pool, PAGE_SIZE, 4, N_KV, HEAD_DIM)),
        'cache_win': nrm((DEC_BATCH, min(WINDOW, PAST_LEN), 2, N_KV, HEAD_DIM)),
        'state_shift': nrm((N_A, DEC_BATCH, D)),
        'state_wkv': nrm((N_A, DEC_BATCH, RWKV_H, RWKV_HEAD, RWKV_HEAD), 0.5),
        'page_table': page_table,
        'norm_g': 1.0 + nrm((DEPTH, 3, D), 0.02),
        'ffn_w_in': nrm((DEPTH, 2, D, 2 * D_FF), D ** -0.5),
        'ffn_w_out': nrm((DEPTH, 2, D_FF, D), D_FF ** -0.5),
        'rw_mu': jax.random.uniform(nk(), (N_A, 6, D), jnp.float32),
        'rw_w_rkv': nrm((N_A, 3, D, D), D ** -0.5),
        'rw_w0': -6.5 + 5.0 * ramp + nrm((N_A, D), 0.1),
        'rw_w1': nrm((N_A, D, LORA_DECAY), D ** -0.5),
        'rw_w2': nrm((N_A, LORA_DECAY, D), 0.05),
        'rw_a0': nrm((N_A, D), 0.1),
        'rw_a1': nrm((N_A, D, LORA_A), D ** -0.5),
        'rw_a2': nrm((N_A, LORA_A, D), 0.1 * LORA_A ** -0.5),
        'rw_g1': nrm((N_A, D, LORA_G), D ** -0.5),
        'rw_g2': nrm((N_A, LORA_G, D), LORA_G ** -0.5),
        'rw_k_k': 0.85 + nrm((N_A, D), 0.05),
        'rw_k_a': 1.0 + nrm((N_A, D), 0.05),
        'rw_r_k': nrm((N_A, RWKV_H, RWKV_HEAD), 0.1),
        'rw_lnx_w': 1.0 + nrm((N_A, D), 0.02),
        'rw_lnx_b': nrm((N_A, D), 0.02),
        'rw_w_o': nrm((N_A, D, D), D ** -0.5),
        'rw_v0': 1.0 + nrm((N_A - 1, D), 0.1),
        'rw_v1': nrm((N_A - 1, D, LORA_V), D ** -0.5),
        'rw_v2': nrm((N_A - 1, LORA_V, D), 0.1 * LORA_V ** -0.5),
        'kv_norm_g': 1.0 + nrm((D,), 0.02),
        'kv_w': nrm((D, 6 * N_KV * HEAD_DIM), D ** -0.5),
        'cmp_pos': nrm((2, CMP_LEN, HEAD_DIM), 0.1),
        'cmp_w1': nrm((2, CMP_LEN * HEAD_DIM, CMP_HID), (CMP_LEN * HEAD_DIM) ** -0.5),
        'cmp_w2': nrm((2, CMP_HID, HEAD_DIM), CMP_HID ** -0.5),
        'b_w_in': nrm((N_B, D, n_q + 3 * N_HEADS), D ** -0.5),
        'b_w_o': nrm((N_B, n_q, D), n_q ** -0.5),
        'final_g': 1.0 + nrm((D,), 0.02),
    }


def reference(x_prompt, x_sample, cache_cs, cache_win, state_shift, state_wkv, page_table,
              norm_g, ffn_w_in, ffn_w_out, rw_mu, rw_w_rkv, rw_w0, rw_w1, rw_w2, rw_a0, rw_a1,
              rw_a2, rw_g1, rw_g2, rw_k_k, rw_k_a, rw_r_k, rw_lnx_w, rw_lnx_b, rw_w_o, rw_v0,
              rw_v1, rw_v2, kv_norm_g, kv_w, cmp_pos, cmp_w1, cmp_w2, b_w_in, b_w_o, final_g):
    P = dict(norm_g=norm_g, ffn_w_in=ffn_w_in, ffn_w_out=ffn_w_out, rw_mu=rw_mu,
             rw_w_rkv=rw_w_rkv, rw_w0=rw_w0, rw_w1=rw_w1, rw_w2=rw_w2, rw_a0=rw_a0,
             rw_a1=rw_a1, rw_a2=rw_a2, rw_g1=rw_g1, rw_g2=rw_g2, rw_k_k=rw_k_k, rw_k_a=rw_k_a,
             rw_r_k=rw_r_k, rw_lnx_w=rw_lnx_w, rw_lnx_b=rw_lnx_b, rw_w_o=rw_w_o, rw_v0=rw_v0,
             rw_v1=rw_v1, rw_v2=rw_v2, kv_norm_g=kv_norm_g, kv_w=kv_w, cmp_pos=cmp_pos,
             cmp_w1=cmp_w1, cmp_w2=cmp_w2, b_w_in=b_w_in, b_w_o=b_w_o, final_g=final_g)
    bp, tp = x_prompt.shape[:2]
    zero_shift = jnp.zeros((N_A, bp, D_MODEL), x_prompt.dtype)
    zero_wkv = jnp.zeros((N_A, bp, RWKV_H, RWKV_HEAD, RWKV_HEAD), jnp.float32)
    y_prompt, p_shift, p_wkv, p_cs, p_win = trunk(
        x_prompt, zero_shift, zero_wkv, None, None, min(WINDOW, tp), 0, P)
    n_seq, n_pages = page_table.shape
    past_len = n_pages * cache_cs.shape[1]
    past_cs = cache_cs[page_table].reshape(n_seq, past_len, 4, N_KV, HEAD_DIM)
    y_sample, s_shift, s_wkv, s_cs, s_win = trunk(
        x_sample, state_shift, state_wkv, past_cs, cache_win, cache_win.shape[1], past_len, P)
    return (y_prompt, y_sample, p_shift, p_wkv, p_cs, p_win, s_shift, s_wkv, s_cs, s_win)
```

```cpp
#include <hip/hip_runtime.h>
#include <cstdio>
#include <cstdint>

#ifndef MK_MULTI
#define MK_MULTI 0
#endif

#define LAS __attribute__((address_space(3)))
#define GAS __attribute__((address_space(1)))
#define CAS __attribute__((address_space(4)))
typedef unsigned short bf16_t;
typedef short bf16x8 __attribute__((ext_vector_type(8)));
typedef float f32x4 __attribute__((ext_vector_type(4)));
typedef float f32x2 __attribute__((ext_vector_type(2)));
typedef unsigned u32x4 __attribute__((ext_vector_type(4)));
typedef unsigned u32x2 __attribute__((ext_vector_type(2)));

constexpr int D = 1024, NBP = 4, TP = 4096, MP = NBP * TP, NBS = 128, TS = 4, MS = NBS * TS, MT = MP + MS;
constexpr int PAST = 2048, PAGE = 128, NPG = 16;
constexpr int DFF = 2816, NH = 16, HD = 64, NKV = 4;
constexpr int NR2 = 4096, KR3 = 384, NR3 = 4096, NKVW = 1536, NQI = 1280;
constexpr int CROWS_S = NBS * NKV * 128, CROWS_P = NBP * NKV * 256, CROWS = CROWS_S + CROWS_P;
constexpr int NCH_P = 64, NCH_S = NBS * NH, SIW = 320;
constexpr float RMS_EPS = 1e-6f, GN_EPS = 64e-5f;

constexpr size_t O_Y = 0, O_PSHIFT = (size_t)MT * D, O_PWKV = O_PSHIFT + 2 * NBP * D, O_PCS = O_PWKV + (size_t)2 * NBP * NH * 64 * 64, O_PWIN = O_PCS + (size_t)MP * 1024,
                 O_SSHIFT = O_PWIN + (size_t)NBP * 512 * 512, O_SWKV = O_SSHIFT + (size_t)2 * NBS * D, O_SCS = O_SWKV + (size_t)2 * NBS * NH * 64 * 64, O_SWIN = O_SCS + (size_t)MS * 1024;

constexpr size_t al256(size_t x) { return (x + 255) & ~(size_t)255; }
constexpr size_t WS_CTL = 0, CTL_BYTES = 1u << 20;
constexpr size_t SZ_WIN1 = (size_t)2 * DFF * D * 2, SZ_WOUT1 = (size_t)D * DFF * 2;
constexpr size_t WS_WIN = WS_CTL + CTL_BYTES;
constexpr size_t WS_WOUT = WS_WIN + 8 * SZ_WIN1;
constexpr size_t WS_WR2 = WS_WOUT + 8 * SZ_WOUT1;
constexpr size_t WS_WR3 = WS_WR2 + (size_t)2 * NR2 * D * 2;
constexpr size_t WS_WRO = WS_WR3 + (size_t)2 * NR3 * KR3 * 2;
constexpr size_t WS_WKV = WS_WRO + (size_t)2 * D * D * 2;
constexpr size_t WS_WQI = WS_WKV + (size_t)NKVW * D * 2;
constexpr size_t WS_WBO = WS_WQI + (size_t)2 * NQI * D * 2;
constexpr size_t WS_WC1 = WS_WBO + (size_t)2 * D * D * 2;
constexpr size_t WS_POSB = WS_WC1 + (size_t)2 * 256 * 1024 * 2;
constexpr size_t WS_H = al256(WS_POSB + 2 * 128 * 4);
constexpr size_t WS_HB = WS_H + (size_t)MT * D * 4;
constexpr size_t WS_RS = WS_HB + (size_t)MT * D * 2;
constexpr size_t WS_FFH = WS_RS + (size_t)MT * 16 * 4;
constexpr size_t WS_XS = WS_FFH + (size_t)MT * DFF * 2;
constexpr size_t WS_RKV = WS_XS + (size_t)6 * MT * D * 2;
constexpr size_t WS_LH = WS_RKV + (size_t)4 * MT * D * 4;
constexpr size_t WS_LU = WS_LH + (size_t)MT * KR3 * 2;
constexpr size_t WS_SIP = WS_LU + (size_t)MT * NR3 * 4;
constexpr size_t SIP_L = (size_t)NCH_P * TP * SIW, SIS_L = (size_t)NCH_S * TS * SIW;
constexpr size_t WS_SIS = WS_SIP + 2 * SIP_L * 4;
constexpr size_t WS_SV = WS_SIS + 2 * SIS_L * 4;
constexpr size_t WS_YS = WS_SV + (size_t)MT * D * 4;
constexpr size_t WS_YG = WS_YS + (size_t)MT * D * 4;
constexpr size_t WS_WINP = WS_YG + (size_t)MT * D * 2;
constexpr size_t WS_CST = WS_WINP + (size_t)MP * 512 * 4;
constexpr size_t WS_CH = WS_CST + (size_t)2 * CROWS * 1024 * 2;
constexpr size_t WS_KCMP = WS_CH + (size_t)2 * CROWS * 256 * 4;
constexpr size_t WS_QG = WS_KCMP + (size_t)2 * CROWS * 64 * 4;
constexpr size_t WS_AO = WS_QG + (size_t)MT * NQI * 4;
constexpr size_t WS_QB = WS_AO + (size_t)MT * D * 2;
constexpr size_t WS_KVS = WS_QB + (size_t)MT * D * 2;
constexpr size_t WS_KCB = WS_KVS + (size_t)4 * 16 * TP * 64 * 2;
constexpr size_t WS_TG = WS_KCB + (size_t)2 * 16 * 256 * 64 * 2;
constexpr size_t WS_SS = WS_TG + (size_t)NCH_P * 64 * 8192 * 4;
constexpr size_t WS_PART = WS_SS + (size_t)NCH_P * 64 * 4096 * 4;
constexpr size_t WS_YQ = WS_PART + (size_t)11 * MS * D * 4;
constexpr size_t SCN_L = (size_t)MP * NH * 7 * 64;
constexpr size_t WS_SCN = WS_YQ + (size_t)NCH_P * 64 * 12288 * 4;
constexpr size_t WS_END = WS_SCN + 2 * SCN_L * 2;

constexpr int NWAVES = 8, NTHREADS = 512;
constexpr int LDS_STAGE = 131072, LDS_MISC = LDS_STAGE, LDS_BYTES = LDS_STAGE + 16384;

__device__ __forceinline__ unsigned f2bf(float f) { unsigned u = __builtin_bit_cast(unsigned, f); return (u + 0x7fffu + ((u >> 16) & 1u)) >> 16; }
__device__ __forceinline__ unsigned pk2(float lo, float hi) { return f2bf(lo) | (f2bf(hi) << 16); }
__device__ __forceinline__ int lane_id_() { int l; asm volatile("v_mbcnt_lo_u32_b32 %0, -1, 0\n\tv_mbcnt_hi_u32_b32 %0, -1, %0" : "=v"(l)); return l; }
__device__ __forceinline__ float shflx_l(float v, int mask, int lane) { return __builtin_bit_cast(float, __builtin_amdgcn_ds_bpermute((lane ^ mask) << 2, __builtin_bit_cast(int, v))); }
__device__ __forceinline__ float shflx(float v, int mask) { return shflx_l(v, mask, lane_id_()); }
__device__ __forceinline__ float wave_sum(float v) { const int l = lane_id_();
#pragma unroll
    for (int o = 1; o < 64; o <<= 1) v += shflx_l(v, o, l);
    return v;
}
__device__ __forceinline__ float wave_max(float v) { const int l = lane_id_();
#pragma unroll
    for (int o = 1; o < 64; o <<= 1) v = fmaxf(v, shflx_l(v, o, l));
    return v;
}
__device__ __forceinline__ float sigmoidf_(float x) { return __builtin_amdgcn_rcpf(1.0f + __expf(-x)); }
__device__ __forceinline__ float tanh_fast(float x) { const float e = __expf(-2.0f * fabsf(x)); const float t = (1.0f - e) * __builtin_amdgcn_rcpf(1.0f + e); return x < 0.f ? -t : t; }
#define LDS_WAIT() asm volatile("s_waitcnt lgkmcnt(0)" ::: "memory")

#define XB_TMO      128
#define XB_XCNT(j)  (256  + 64 * (j))
#define XB_XSUB(j)  (1280 + 64 * (j))
#define XB_XGEN(j)  (2304 + 64 * (j))
#define XB_TOP      3328
#define XB_TOPGEN   3392
#define XCD_BAR_WORDS 3456
#define XB_SPIN_CAP (1u << 18)
__device__ __forceinline__ unsigned xb_ld(unsigned* p)              { return __hip_atomic_load(p, __ATOMIC_RELAXED, __HIP_MEMORY_SCOPE_AGENT); }
__device__ __forceinline__ unsigned xb_add(unsigned* p, unsigned v) { return __hip_atomic_fetch_add(p, v, __ATOMIC_RELAXED, __HIP_MEMORY_SCOPE_AGENT); }
__device__ __forceinline__ unsigned xb_xcc_id() { return (unsigned)__builtin_amdgcn_s_getreg((3 << 11) | 20) & 0xFu; }
#define XB_SPIN(cond, bar) do { unsigned _sp = 0; while (cond) { __builtin_amdgcn_s_sleep(1); \
    if ((++_sp & 255u) == 0u) { if (xb_ld(&(bar)[XB_TMO])) break; if (_sp > XB_SPIN_CAP) { atomicAdd(&(bar)[XB_TMO], 1u); break; } } } } while (0)
struct XcdBarrier { unsigned* bar; unsigned x; volatile LAS unsigned* st; };
__device__ __forceinline__ XcdBarrier xcd_barrier_post(unsigned* bar, volatile LAS unsigned* st) {
    XcdBarrier b; b.bar = bar; b.x = xb_xcc_id(); b.st = st;
    if (threadIdx.x == 0) (void)xb_add(&bar[XB_XCNT(b.x)], 1u);
    return b;
}
__device__ __forceinline__ void xcd_barrier_complete(unsigned* bar, unsigned x, unsigned& nloc, unsigned& nx) {
    const unsigned G = gridDim.x * gridDim.y * gridDim.z;
    unsigned sum, cnt, mine, sp = 0u;
    for (;;) {
        sum = 0u; cnt = 0u; mine = 0u;
#pragma unroll
        for (unsigned j = 0; j < 16; ++j) { const unsigned c = xb_ld(&bar[XB_XCNT(j)]); sum += c; cnt += (c > 0u) ? 1u : 0u; }
        if (sum == G) { mine = xb_ld(&bar[XB_XCNT(x)]); break; }
        __builtin_amdgcn_s_sleep(1);
        if ((++sp & 255u) == 0u) { if (xb_ld(&bar[XB_TMO])) break; if (sp > XB_SPIN_CAP) { atomicAdd(&bar[XB_TMO], 1u); break; } }
    }
    nloc = mine > 0u ? mine : 1u; nx = cnt > 0u ? cnt : 1u;
}
__device__ __forceinline__ void xcd_barrier(const XcdBarrier& b, const bool leader_thread) {
    asm volatile("s_waitcnt vmcnt(0)" ::: "memory");
    __syncthreads();
    if (leader_thread) {
        unsigned* bar = b.bar;
        __builtin_amdgcn_s_waitcnt(0);
        unsigned nloc = b.st[0], nx = b.st[1];
        if (nloc == 0u) { xcd_barrier_complete(bar, b.x, nloc, nx); b.st[0] = nloc; b.st[1] = nx; }
        const unsigned old = xb_add(&bar[XB_XSUB(b.x)], 1u);
        const unsigned gen = old / nloc;
        if (old + 1u == (gen + 1u) * nloc) {
            __builtin_amdgcn_fence(__ATOMIC_RELEASE, "agent");
            asm volatile("s_waitcnt vmcnt(0)" ::: "memory");
            const unsigned og = xb_add(&bar[XB_TOP], 1u);
            const unsigned tg = og / nx;
            if (og + 1u == (tg + 1u) * nx) xb_add(&bar[XB_TOPGEN], 1u);
            else XB_SPIN(xb_ld(&bar[XB_TOPGEN]) == tg, bar);
            __builtin_amdgcn_fence(__ATOMIC_ACQUIRE, "agent");
            xb_add(&bar[XB_XGEN(b.x)], 1u);
            asm volatile("s_waitcnt vmcnt(0)" ::: "memory");
        } else {
            XB_SPIN(xb_ld(&bar[XB_XGEN(b.x)]) == gen, bar);
            __builtin_amdgcn_fence(__ATOMIC_ACQUIRE, "agent");
            asm volatile("s_waitcnt vmcnt(0)" ::: "memory");
        }
    }
    __syncthreads();
}

namespace pg8 {
constexpr int BM = 256, BK = 64, HALF = 128, HTB = HALF * BK * 2, STAGE_BYTES = 8 * HTB, NXCD = 8, WGM = 8;
__host__ __device__ __forceinline__ int lds_byte(int r, int c) { const int st = (r >> 4) * 2 + (c >> 5), rr = r & 15, cc = c & 31, ob = rr * 64 + cc * 2; return st * 1024 + (ob ^ (((ob >> 9) & 1) << 5)); }
__host__ __device__ __forceinline__ void stage_rc(int b, int& R, int& C) { const int st = b / 1024, sb = b % 1024, swz = sb ^ (((sb >> 9) & 1) << 5); R = (st >> 1) * 16 + swz / 64; C = (st & 1) * 32 + (swz % 64) / 2; }
__host__ __device__ __forceinline__ int perm32(int rho) { const int n = rho >> 4, i = rho & 15; return 8 * (i >> 2) + 4 * n + (i & 3); }
struct Unit { int pm, pn, k0, nk; };
struct StaticOrder {
    int nM, nN, nwg, G, c;
    __device__ void init(int M, int N, int G_, int c_) { nM = M / BM; nN = N / BM; nwg = nM * nN; G = G_; c = c_; }
    __device__ bool next(int i, Unit& u) const {
        const long L = (long)i * G + c; if (L >= nwg) return false;
        int wgid = (int)L; { const int q = nwg / NXCD, r = nwg % NXCD, xcd = wgid % NXCD, off = wgid / NXCD; wgid = (xcd < r ? xcd * (q + 1) : r * (q + 1) + (xcd - r) * q) + off; }
        const int nig = WGM * nN, gid = wgid / nig, fm = gid * WGM, gsz = (nM - fm) < WGM ? (nM - fm) : WGM;
        u.pm = fm + ((wgid % nig) % gsz); u.pn = (wgid % nig) / gsz; u.k0 = 0; u.nk = 0; return true;
    }
};
struct OrderSplit { StaticOrder so; int G, c, npieces;
    __device__ void init(int K, int G_, int c_) { so.init(MP, D, G_, c_); G = G_; c = c_; npieces = K / (4 * BK); }
    __device__ bool next(int i, Unit& u) const { const int L = i * G + c; if (L < 256) { const int i0 = L / G; StaticOrder s2 = so; s2.c = L - i0 * G; return s2.next(i0, u); }
        const int idx = L - 256; if (idx >= 8 * npieces) return false; const int u8 = idx / npieces, pc = idx % npieces; u.pm = MP / 256 + (u8 >> 2); u.pn = u8 & 3; u.k0 = pc * 4; u.nk = 4; return true; } };
template <class Epi, class Sched, class PM>
__device__ __forceinline__ void gemm_phase(LAS unsigned char* lds, const int tid_in, const int K, const int lda, const int ldb, const Sched& S, const PM& P, const Epi& E) {
    int tid_ = tid_in; asm volatile("" : "+v"(tid_));
    const int tid = tid_, wid = __builtin_amdgcn_readfirstlane(tid >> 6), lane = tid & 63, wr = wid >> 2, wc = wid & 3, fr = lane & 15, fq = lane >> 4;
    const int nt = K / BK;
    unsigned voffA[2], voffB[2];
#pragma unroll
    for (int i = 0; i < 2; ++i) { int R, C; stage_rc(tid * 16 + i * 8192, R, C); const int Rb = Epi::PERM ? ((R & ~31) + perm32(R & 31)) : R;
        voffA[i] = (unsigned)(R * lda + C) * 2u; voffB[i] = (unsigned)(Rb * ldb + C) * 2u; }
    const size_t kstep = (size_t)(BK * 2);
    const size_t hstepA = (size_t)HALF * lda * 2, hstepB = (size_t)HALF * ldb * 2;
    const unsigned ldsw = (unsigned)wid * 1024u;
    const int aoff = lds_byte(wr * 64 + fr, fq * 8), boff = lds_byte(wc * 32 + fr, fq * 8);
#define PG8_SA(b, h) (((b) * 2 + (h)) * HTB)
#define PG8_SB(b, h) ((4 + (b) * 2 + (h)) * HTB)
#define PG8_STAGE(bufoff, gbase, voff) do { _Pragma("unroll") for (int _i = 0; _i < 2; ++_i) \
        __builtin_amdgcn_global_load_lds((const unsigned*)((const char*)(gbase) + (voff)[_i]), (LAS unsigned*)(lds + (bufoff) + ldsw + _i * 8192), 16, 0, 0); } while (0)
#define PG8_LDA(dst, b, h) do { _Pragma("unroll") for (int m = 0; m < 4; ++m) _Pragma("unroll") for (int k = 0; k < 2; ++k) dst[m][k] = *(const LAS bf16x8*)(lds + PG8_SA(b, h) + aoff + m * 2048 + k * 1024); } while (0)
#define PG8_LDB(dst, b, h) do { _Pragma("unroll") for (int n = 0; n < 2; ++n) _Pragma("unroll") for (int k = 0; k < 2; ++k) dst[n][k] = *(const LAS bf16x8*)(lds + PG8_SB(b, h) + boff + n * 2048 + k * 1024); } while (0)
#define PG8_MMA(ai, bj, At, Bt) do { __builtin_amdgcn_s_setprio(1); _Pragma("unroll") for (int m = 0; m < 4; ++m) _Pragma("unroll") for (int n = 0; n < 2; ++n) _Pragma("unroll") for (int k = 0; k < 2; ++k) \
        acc[ai][bj][m][n] = __builtin_amdgcn_mfma_f32_16x16x32_bf16(Bt[n][k], At[m][k], acc[ai][bj][m][n], 0, 0, 0); __builtin_amdgcn_s_setprio(0); } while (0)
#define PG8_WAIT_V(n) asm volatile("s_waitcnt vmcnt(" #n ")" ::: "memory")
#define PG8_WAIT_L(n) asm volatile("s_waitcnt lgkmcnt(" #n ")" ::: "memory")
#define PG8_BAR __builtin_amdgcn_s_barrier()
#define PG8_SCHED __builtin_amdgcn_sched_barrier(0)
    Unit cur, nxt; int ui = 0;
    if (!S.next(0, cur)) return;
    f32x4 acc[2][2][4][2];
#pragma unroll
    for (int a = 0; a < 2; ++a)
#pragma unroll
        for (int b = 0; b < 2; ++b)
#pragma unroll
            for (int m = 0; m < 4; ++m)
#pragma unroll
                for (int n = 0; n < 2; ++n) acc[a][b][m][n] = (f32x4){0.f, 0.f, 0.f, 0.f};
    bf16x8 At[4][2], B0[2][2], B1[2][2];
    const char* cA = P.a(cur) + (size_t)cur.k0 * (BK * 2); const char* cB = P.b(cur) + (size_t)cur.k0 * (BK * 2);
    PG8_STAGE(PG8_SB(0, 0), cB, voffB); PG8_STAGE(PG8_SB(0, 1), cB + hstepB, voffB); PG8_STAGE(PG8_SA(0, 0), cA, voffA); PG8_STAGE(PG8_SA(0, 1), cA + hstepA, voffA);
    if (wr == 1) PG8_BAR;
    PG8_WAIT_V(2); PG8_BAR;
    PG8_STAGE(PG8_SB(1, 0), cB + kstep, voffB); PG8_STAGE(PG8_SA(1, 0), cA + kstep, voffA); PG8_STAGE(PG8_SB(1, 1), cB + hstepB + kstep, voffB);
    PG8_WAIT_V(6); PG8_BAR;
    for (;;) {
        const bool has_next = S.next(ui + 1, nxt);
        const char* nA = has_next ? P.a(nxt) + (size_t)nxt.k0 * (BK * 2) : cA; const char* nB = has_next ? P.b(nxt) + (size_t)nxt.k0 * (BK * 2) : cB;
        const int ntc = cur.nk ? cur.nk : nt;
        for (int t = 0; t < ntc; t += 2) {
            const bool last = (t == ntc - 2);
            const char* a1 = cA + (size_t)(t + 1) * kstep;
            const char* a2 = last ? nA : cA + (size_t)(t + 2) * kstep; const char* b2 = last ? nB : cB + (size_t)(t + 2) * kstep;
            const char* a3 = a2 + kstep; const char* b3 = b2 + kstep;
            PG8_LDB(B0, 0, 0); PG8_LDB(B1, 0, 1); PG8_SCHED; PG8_LDA(At, 0, 0); PG8_STAGE(PG8_SA(1, 1), a1 + hstepA, voffA);
            PG8_WAIT_V(8); PG8_WAIT_L(0); PG8_BAR; PG8_MMA(0, 0, At, B0); PG8_MMA(0, 1, At, B1); PG8_BAR; PG8_SCHED;
            PG8_LDA(At, 0, 1); PG8_STAGE(PG8_SB(0, 0), b2, voffB); PG8_STAGE(PG8_SB(0, 1), b2 + hstepB, voffB); PG8_STAGE(PG8_SA(0, 0), a2, voffA);
            PG8_WAIT_V(8); PG8_WAIT_L(0); PG8_BAR; PG8_MMA(1, 0, At, B0); PG8_MMA(1, 1, At, B1); PG8_BAR; PG8_SCHED;
            PG8_LDB(B0, 1, 0); PG8_LDB(B1, 1, 1); PG8_SCHED; PG8_LDA(At, 1, 0); PG8_STAGE(PG8_SA(0, 1), a2 + hstepA, voffA);
            PG8_WAIT_V(8); PG8_WAIT_L(0); PG8_BAR; PG8_MMA(0, 0, At, B0); PG8_MMA(0, 1, At, B1); PG8_BAR; PG8_SCHED;
            PG8_LDA(At, 1, 1); PG8_STAGE(PG8_SB(1, 0), b3, voffB); PG8_STAGE(PG8_SB(1, 1), b3 + hstepB, voffB); PG8_STAGE(PG8_SA(1, 0), a3, voffA);
            PG8_WAIT_V(8); PG8_WAIT_L(0); PG8_BAR; PG8_MMA(1, 0, At, B0); PG8_MMA(1, 1, At, B1); PG8_BAR; PG8_SCHED;
        }
        if (wr == 0) PG8_BAR;
        { int le_; asm volatile("v_mbcnt_lo_u32_b32 %0, -1, 0\n\tv_mbcnt_hi_u32_b32 %0, -1, %0" : "=v"(le_));
          E(acc, cur, wr, wc, le_ & 15, le_ >> 4); }
        if (!has_next) break;
#pragma unroll
        for (int a = 0; a < 2; ++a)
#pragma unroll
            for (int b = 0; b < 2; ++b)
#pragma unroll
                for (int m = 0; m < 4; ++m)
#pragma unroll
                    for (int n = 0; n < 2; ++n) acc[a][b][m][n] = (f32x4){0.f, 0.f, 0.f, 0.f};
        cur = nxt; cA = nA; cB = nB; ++ui;
        if (wr == 1) PG8_BAR;
    }
    PG8_WAIT_V(0);
    PG8_BAR;
#undef PG8_SA
#undef PG8_SB
#undef PG8_STAGE
#undef PG8_LDA
#undef PG8_LDB
#undef PG8_MMA
#undef PG8_WAIT_V
#undef PG8_WAIT_L
#undef PG8_BAR
#undef PG8_SCHED
}
}
using pg8::Unit;

struct Args { const void* in[37]; float* out; unsigned char* ws; int ph_lo, ph_hi; };
struct Frame {
    LAS unsigned char* lds; int tid, lane, wave, gw, NGW, G, bx;
    const void* const* in; float* out; unsigned char* ws;
};
#define INF(i) ((const float*)F.in[i])
#define WSP(T, off) ((T*)(F.ws + (off)))

constexpr int LDS_TBL = LDS_STAGE;
template <class Sched> __device__ __forceinline__ void build_rs_table(LAS unsigned char* lds, const float* rs, const Sched& S, int t) {
    LAS float* tbl = (LAS float*)(lds + LDS_TBL); const int half = __builtin_amdgcn_readfirstlane(t >> 8), r = t & 255;
    f32x4 v[4][4]; bool ok[4];
#pragma unroll
    for (int j = 0; j < 4; ++j) { Unit u; ok[j] = S.next(2 * j + half, u);
        if (ok[j]) { const f32x4* p = (const f32x4*)(rs + (size_t)(u.pm * 256 + r) * 16); v[j][0] = p[0]; v[j][1] = p[1]; v[j][2] = p[2]; v[j][3] = p[3]; } }
#pragma unroll
    for (int j = 0; j < 4; ++j) if (ok[j]) { const f32x4 a = v[j][0], b = v[j][1], c = v[j][2], d = v[j][3];
        const float s = (((a.x + a.y) + (a.z + a.w)) + ((b.x + b.y) + (b.z + b.w))) + (((c.x + c.y) + (c.z + c.w)) + ((d.x + d.y) + (d.z + d.w)));
        tbl[(2 * j + half) * 256 + r] = 1.0f / sqrtf(s * (1.0f / D) + RMS_EPS); }
    __syncthreads();
}

struct PMSimple { const char* A; const char* B; size_t at, bt;
    __device__ __forceinline__ const char* a(const Unit& u) const { return A + (size_t)u.pm * at; }
    __device__ __forceinline__ const char* b(const Unit& u) const { return B + (size_t)u.pn * bt; } };

struct EpiFFN1 {
    static constexpr bool PERM = true;
    bf16_t* O; const LAS float* tbl; mutable int k;
    __device__ __forceinline__ void operator()(const f32x4 (&acc)[2][2][4][2], const Unit& u, int wr, int wc, int fr, int fq) const {
        const int row0 = u.pm * 256 + wr * 64 + fr, col0 = u.pn * 128 + wc * 32 + 8 * fq; const LAS float* tk = tbl + k * 256 + wr * 64 + fr; ++k;
#pragma unroll
        for (int ai = 0; ai < 2; ++ai)
#pragma unroll
            for (int m = 0; m < 4; ++m) { const int row = row0 + ai * 128 + m * 16; const float ir = tk[ai * 128 + m * 16];
                float o[8];
#pragma unroll
                for (int n = 0; n < 2; ++n)
#pragma unroll
                    for (int j = 0; j < 4; ++j) { const float g = acc[ai][0][m][n][j] * ir, up = acc[ai][1][m][n][j] * ir; o[n * 4 + j] = g * sigmoidf_(g) * up; }
                u32x4 w; w.x = pk2(o[0], o[1]); w.y = pk2(o[2], o[3]); w.z = pk2(o[4], o[5]); w.w = pk2(o[6], o[7]);
                *(u32x4*)(O + (size_t)row * DFF + col0) = w; }
    }
};
struct EpiResid {
    static constexpr bool PERM = false;
    float* H; bf16_t* HB; float* rs; float scale; float* part;
    __device__ __forceinline__ void operator()(const f32x4 (&acc)[2][2][4][2], const Unit& u, int wr, int wc, int fr, int fq) const {
        const int row0 = u.pm * 256 + wr * 64 + fr, col0 = u.pn * 256 + wc * 32 + 4 * fq;
        if (u.nk) { float* dst = part + (size_t)(u.k0 / u.nk) * MS * D;
#pragma unroll
            for (int ai = 0; ai < 2; ++ai)
#pragma unroll
                for (int m = 0; m < 4; ++m) { const int row = row0 + ai * 128 + m * 16 - MP;
#pragma unroll
                    for (int bj = 0; bj < 2; ++bj)
#pragma unroll
                        for (int n = 0; n < 2; ++n) *(f32x4*)(dst + (size_t)row * D + col0 + bj * 128 + n * 16) = acc[ai][bj][m][n]; }
            return; }
#pragma unroll
        for (int ai = 0; ai < 2; ++ai) {
            f32x4 hv[4][2][2];
#pragma unroll
            for (int m = 0; m < 4; ++m)
#pragma unroll
                for (int bj = 0; bj < 2; ++bj)
#pragma unroll
                    for (int n = 0; n < 2; ++n) hv[m][bj][n] = *(const f32x4*)(H + (size_t)(row0 + ai * 128 + m * 16) * D + col0 + bj * 128 + n * 16);
            __builtin_amdgcn_sched_barrier(0);
#pragma unroll
            for (int m = 0; m < 4; ++m) { const int row = row0 + ai * 128 + m * 16; float ss = 0.f;
#pragma unroll
                for (int bj = 0; bj < 2; ++bj)
#pragma unroll
                    for (int n = 0; n < 2; ++n) { const size_t off = (size_t)row * D + col0 + bj * 128 + n * 16;
                        f32x4 h = hv[m][bj][n]; h = h + acc[ai][bj][m][n] * scale; *(f32x4*)(H + off) = h;
                        u32x2 w; w.x = pk2(h.x, h.y); w.y = pk2(h.z, h.w); *(u32x2*)(HB + off) = w;
                        ss += (h.x * h.x + h.y * h.y) + (h.z * h.z + h.w * h.w); }
                ss += shflx(ss, 16); ss += shflx(ss, 32);
                if (fq == 0) rs[(size_t)row * 16 + u.pn * 4 + wc] = ss; }
            __builtin_amdgcn_sched_barrier(0); }
    }
};
struct EpiR2 {
    static constexpr bool PERM = false;
    float* RKV; int vslot; bf16_t* LH; bf16_t* SCN;
    __device__ __forceinline__ void operator()(const f32x4 (&acc)[2][2][4][2], const Unit& u, int wr, int wc, int fr, int fq) const {
        const int row0 = u.pm * 256 + wr * 64 + fr, cl0 = wc * 32 + 4 * fq;
        if (u.pn < 12 && u.pm < MP / 256) {
            const int q = u.pn >> 2;
#pragma unroll
            for (int ai = 0; ai < 2; ++ai)
#pragma unroll
                for (int m = 0; m < 4; ++m) { const int row = row0 + ai * 128 + m * 16, b = row >> 12, t = row & (TP - 1);
#pragma unroll
                    for (int bj = 0; bj < 2; ++bj)
#pragma unroll
                        for (int n = 0; n < 2; ++n) { const int head = (u.pn & 3) * 4 + 2 * bj + (wc >> 1), ch = 32 * (wc & 1) + 16 * n + 4 * fq; const f32x4 v = acc[ai][bj][m][n];
                            u32x2 w; w.x = pk2(v.x, v.y); w.y = pk2(v.z, v.w); *(u32x2*)(SCN + ((size_t)(b * NH + head) * TP + t) * 448 + q * 64 + ch) = w; } }
        } else if (u.pn < 12) { const int slot = u.pn < 4 ? 0 : (u.pn < 8 ? 1 : vslot); float* dst = RKV + (size_t)slot * MT * D; const int cb = (u.pn & 3) * 256;
#pragma unroll
            for (int ai = 0; ai < 2; ++ai)
#pragma unroll
                for (int m = 0; m < 4; ++m) { const int row = row0 + ai * 128 + m * 16;
#pragma unroll
                    for (int bj = 0; bj < 2; ++bj)
#pragma unroll
                        for (int n = 0; n < 2; ++n) *(f32x4*)(dst + (size_t)row * D + cb + cl0 + bj * 128 + n * 16) = acc[ai][bj][m][n]; }
        } else {
            const int q = u.pn - 12; const int lim = q == 0 ? 64 : (q == 1 ? 64 : (q == 2 ? 160 : 96)); const int base = q == 0 ? 0 : (q == 1 ? 64 : (q == 2 ? 128 : 288));
#pragma unroll
            for (int ai = 0; ai < 2; ++ai)
#pragma unroll
                for (int m = 0; m < 4; ++m) { const int row = row0 + ai * 128 + m * 16;
#pragma unroll
                    for (int bj = 0; bj < 2; ++bj)
#pragma unroll
                        for (int n = 0; n < 2; ++n) { const int c = cl0 + bj * 128 + n * 16; if (c < lim) { f32x4 v = acc[ai][bj][m][n];
                            if (q == 0) { v.x = tanh_fast(v.x); v.y = tanh_fast(v.y); v.z = tanh_fast(v.z); v.w = tanh_fast(v.w); }
                            if (q == 2) { v.x = sigmoidf_(v.x); v.y = sigmoidf_(v.y); v.z = sigmoidf_(v.z); v.w = sigmoidf_(v.w); }
                            if (q == 3 && c >= 32) v = (f32x4){0.f, 0.f, 0.f, 0.f};
                            u32x2 w; w.x = pk2(v.x, v.y); w.y = pk2(v.z, v.w); *(u32x2*)(LH + (size_t)row * KR3 + base + c) = w; } } }
        }
    }
};
struct PMR2 { const char* XS; const char* B;
    __device__ __forceinline__ const char* a(const Unit& u) const { const int s = u.pn < 4 ? 0 : (u.pn < 8 ? 1 : (u.pn < 12 ? 2 : (u.pn == 15 ? 2 : u.pn - 9))); return XS + ((size_t)s * MT + (size_t)u.pm * 256) * D * 2; }
    __device__ __forceinline__ const char* b(const Unit& u) const { return B + (size_t)u.pn * 256 * D * 2; } };
struct EpiR3 {
    static constexpr bool PERM = false;
    float* LU; bf16_t* SCN;
    __device__ __forceinline__ void operator()(const f32x4 (&acc)[2][2][4][2], const Unit& u, int wr, int wc, int fr, int fq) const {
        const int row0 = u.pm * 256 + wr * 64 + fr, col0 = u.pn * 256 + wc * 32 + 4 * fq;
        if (u.pm < MP / 256) { const int q = 3 + (u.pn >> 2);
#pragma unroll
            for (int ai = 0; ai < 2; ++ai)
#pragma unroll
                for (int m = 0; m < 4; ++m) { const int row = row0 + ai * 128 + m * 16, b = row >> 12, t = row & (TP - 1);
#pragma unroll
                    for (int bj = 0; bj < 2; ++bj)
#pragma unroll
                        for (int n = 0; n < 2; ++n) { const int head = (u.pn & 3) * 4 + 2 * bj + (wc >> 1), ch = 32 * (wc & 1) + 16 * n + 4 * fq; const f32x4 v = acc[ai][bj][m][n];
                            u32x2 w; w.x = pk2(v.x, v.y); w.y = pk2(v.z, v.w); *(u32x2*)(SCN + ((size_t)(b * NH + head) * TP + t) * 448 + q * 64 + ch) = w; } }
        } else {
#pragma unroll
            for (int ai = 0; ai < 2; ++ai)
#pragma unroll
                for (int m = 0; m < 4; ++m) { float* rowp = LU + (size_t)(row0 + ai * 128 + m * 16) * NR3 + col0;
#pragma unroll
                    for (int bj = 0; bj < 2; ++bj)
#pragma unroll
                        for (int n = 0; n < 2; ++n) *(f32x4*)(rowp + bj * 128 + n * 16) = acc[ai][bj][m][n]; } }
    }
};
struct EpiF32 {
    static constexpr bool PERM = false;
    float* C; int ldc;
    __device__ __forceinline__ void operator()(const f32x4 (&acc)[2][2][4][2], const Unit& u, int wr, int wc, int fr, int fq) const {
        const int row0 = u.pm * 256 + wr * 64 + fr, col0 = u.pn * 256 + wc * 32 + 4 * fq;
#pragma unroll
        for (int ai = 0; ai < 2; ++ai)
#pragma unroll
            for (int m = 0; m < 4; ++m) { float* rowp = C + (size_t)(row0 + ai * 128 + m * 16) * ldc + col0;
#pragma unroll
                for (int bj = 0; bj < 2; ++bj)
#pragma unroll
                    for (int n = 0; n < 2; ++n) *(f32x4*)(rowp + bj * 128 + n * 16) = acc[ai][bj][m][n]; }
    }
};
struct EpiKV {
    static constexpr bool PERM = false;
    float* out; float* winp; const LAS float* tbl; mutable int k;
    __device__ __forceinline__ void operator()(const f32x4 (&acc)[2][2][4][2], const Unit& u, int wr, int wc, int fr, int fq) const {
        const int row0 = u.pm * 256 + wr * 64 + fr, col0 = u.pn * 256 + wc * 32 + 4 * fq; const LAS float* tk = tbl + k * 256 + wr * 64 + fr; ++k;
#pragma unroll
        for (int ai = 0; ai < 2; ++ai)
#pragma unroll
            for (int m = 0; m < 4; ++m) { const int row = row0 + ai * 128 + m * 16; const float ir = tk[ai * 128 + m * 16];
#pragma unroll
                for (int bj = 0; bj < 2; ++bj)
#pragma unroll
                    for (int n = 0; n < 2; ++n) { const int c = col0 + bj * 128 + n * 16; const f32x4 v = acc[ai][bj][m][n] * ir;
                        if (c < 1024) { float* dst = row < MP ? out + O_PCS + (size_t)row * 1024 + c : out + O_SCS + (size_t)(row - MP) * 1024 + c; *(f32x4*)dst = v; }
                        else { const int c2 = c - 1024;
                            if (row < MP) { *(f32x4*)(winp + (size_t)row * 512 + c2) = v; const int t = row & (TP - 1), b = row >> 12;
                                if (t >= TP - 512) *(f32x4*)(out + O_PWIN + ((size_t)b * 512 + (t - (TP - 512))) * 512 + c2) = v; }
                            else { const int ms = row - MP, b = ms >> 2, t = ms & 3; *(f32x4*)(out + O_SWIN + ((size_t)b * 512 + 508 + t) * 512 + c2) = v; } } } }
    }
};
struct EpiQI {
    static constexpr bool PERM = false;
    float* QG; bf16_t* QB; const LAS float* tbl; mutable int k;
    __device__ __forceinline__ void operator()(const f32x4 (&acc)[2][2][4][2], const Unit& u, int wr, int wc, int fr, int fq) const {
        const int row0 = u.pm * 256 + wr * 64 + fr, col0 = u.pn * 256 + wc * 32 + 4 * fq; const LAS float* tk = tbl + k * 256 + wr * 64 + fr; ++k;
#pragma unroll
        for (int ai = 0; ai < 2; ++ai)
#pragma unroll
            for (int m = 0; m < 4; ++m) { const int row = row0 + ai * 128 + m * 16; const float ir = tk[ai * 128 + m * 16];
#pragma unroll
                for (int bj = 0; bj < 2; ++bj)
#pragma unroll
                    for (int n = 0; n < 2; ++n) { const int c = col0 + bj * 128 + n * 16; f32x4 v = acc[ai][bj][m][n] * ir;
                        if (c < 1024) { v = v * 0.125f; const f32x4 v2 = v * 1.4426950408889634f; u32x2 w; w.x = pk2(v2.x, v2.y); w.y = pk2(v2.z, v2.w); *(u32x2*)(QB + (size_t)row * D + c) = w; }
                        else { v.x = sigmoidf_(v.x); v.y = sigmoidf_(v.y); v.z = sigmoidf_(v.z); v.w = sigmoidf_(v.w); }
                        *(f32x4*)(QG + (size_t)row * NQI + c) = v; } }
    }
};
struct OrderC1 { int G, c;
    __device__ bool next(int i, Unit& u) const { const int L = i * G + c; if (L >= 2 * (CROWS / 256)) return false; u.pn = L / (CROWS / 256); u.pm = L % (CROWS / 256); u.k0 = 0; u.nk = 0; return true; } };
struct PMC1 { const char* A; const char* B;
    __device__ __forceinline__ const char* a(const Unit& u) const { return A + ((size_t)u.pn * CROWS + (size_t)u.pm * 256) * 1024 * 2; }
    __device__ __forceinline__ const char* b(const Unit& u) const { return B + (size_t)u.pn * 256 * 1024 * 2; } };
struct EpiC1 {
    static constexpr bool PERM = false;
    float* C;
    __device__ __forceinline__ void operator()(const f32x4 (&acc)[2][2][4][2], const Unit& u, int wr, int wc, int fr, int fq) const {
        const int row0 = u.pm * 256 + wr * 64 + fr, col0 = wc * 32 + 4 * fq;
#pragma unroll
        for (int ai = 0; ai < 2; ++ai)
#pragma unroll
            for (int m = 0; m < 4; ++m) { float* rowp = C + ((size_t)u.pn * CROWS + row0 + ai * 128 + m * 16) * 256 + col0;
#pragma unroll
                for (int bj = 0; bj < 2; ++bj)
#pragma unroll
                    for (int n = 0; n < 2; ++n) *(f32x4*)(rowp + bj * 128 + n * 16) = acc[ai][bj][m][n]; }
    }
};


#ifndef EN_P0
#define EN_P0 1
#endif
#ifndef EN_GEMM
#define EN_GEMM 1
#endif
#ifndef EN_ELT
#define EN_ELT 1
#endif
#ifndef EN_SCAN
#define EN_SCAN 1
#endif
#ifndef EN_ATT
#define EN_ATT 1
#endif

__device__ __forceinline__ int vt_slot(int k) { const int kk = k & 15; return (k & ~15) + ((kk >> 2) & 1) * 8 + (kk & 3) + 4 * (kk >> 3); }
struct RowInfo { int stream, b, t, tlen; };
__device__ __forceinline__ RowInfo row_info(int m) { RowInfo r; if (m < MP) { r.stream = 0; r.b = m >> 12; r.t = m & (TP - 1); r.tlen = TP; } else { const int ms = m - MP; r.stream = 1; r.b = ms >> 2; r.t = ms & 3; r.tlen = TS; } return r; }

__device__ __forceinline__ void transpose_item(const float* W, int ldw, int nvalid, int k0, int n0, bf16_t* WT, int ldk, int drow0, const float* kscale, LAS float* scr, int lane) {
    float tv[32], kv[32];
#pragma unroll
    for (int i = 0; i < 32; ++i) { const int kk = 2 * i + (lane >> 5), col = n0 + (lane & 31); tv[i] = col < nvalid ? W[(size_t)(k0 + kk) * ldw + col] : 0.f; }
    if (kscale) {
#pragma unroll
        for (int i = 0; i < 32; ++i) kv[i] = kscale[k0 + 2 * i + (lane >> 5)]; }
#pragma unroll
    for (int i = 0; i < 32; ++i) { const int kk = 2 * i + (lane >> 5); float v = tv[i]; if (kscale) v *= kv[i]; scr[kk * 33 + (lane & 31)] = v; }
    LDS_WAIT(); asm volatile("" ::: "memory");
    const int c = lane & 7;
    float rv[4][8];
#pragma unroll
    for (int j = 0; j < 4; ++j) { const int n = (lane >> 3) + 8 * j; const LAS float* s = scr + (8 * c) * 33 + n;
#pragma unroll
        for (int e = 0; e < 8; ++e) rv[j][e] = s[e * 33]; }
    __builtin_amdgcn_sched_barrier(0);
#pragma unroll
    for (int j = 0; j < 4; ++j) { const int n = (lane >> 3) + 8 * j;
        u32x4 o; o.x = pk2(rv[j][0], rv[j][1]); o.y = pk2(rv[j][2], rv[j][3]); o.z = pk2(rv[j][4], rv[j][5]); o.w = pk2(rv[j][6], rv[j][7]);
        *(u32x4*)(WT + (size_t)(drow0 + n) * ldk + k0 + 8 * c) = o; }
    LDS_WAIT(); asm volatile("" ::: "memory");
}
__device__ __forceinline__ void transpose_matrix(Frame& F, const float* W, int K, int N, int nvalid, bf16_t* WT, int ldk, int drow_base, const float* kscale, LAS float* scr) {
    const int ng = (N + 31) / 32, nk = K / 64, nit = ng * nk;
    for (int it = F.gw; it < nit; it += F.NGW) { const int kb = it / ng, nb = it % ng; transpose_item(W, N, nvalid, kb * 64, nb * 32, WT, ldk, drow_base + nb * 32, kscale, scr, F.lane); }
}
__device__ __forceinline__ void zero_bf16(Frame& F, bf16_t* p, size_t n8) {
    u32x4 z = (u32x4){0u, 0u, 0u, 0u};
    for (size_t i = (size_t)F.bx * NTHREADS + F.tid; i < n8; i += (size_t)F.G * NTHREADS) ((u32x4*)p)[i] = z;
}
__device__ __forceinline__ void p0_ffn(Frame& F, int lf, LAS float* scr) {
    const float* norm_g = INF(7);
    const float* Win = INF(8) + (size_t)lf * D * 2 * DFF; bf16_t* WT = WSP(bf16_t, WS_WIN) + (size_t)lf * 2 * DFF * D;
    const float* g = norm_g + (size_t)((lf >> 1) * 3 + ((lf & 1) ? 2 : 0)) * D;
    const int ng = 2 * DFF / 32, nit = ng * (D / 64);
    for (int it = F.gw; it < nit; it += F.NGW) { const int kb = it / ng, nb = it % ng; const int col = nb * 32; const int isup = col >= DFF, j = isup ? col - DFF : col;
        const int drow = (j >> 7) * 256 + isup * 128 + (j & 127);
        transpose_item(Win, 2 * DFF, 2 * DFF, kb * 64, col, WT, D, drow, g, scr, F.lane); }
    transpose_matrix(F, INF(9) + (size_t)lf * DFF * D, DFF, D, D, WSP(bf16_t, WS_WOUT) + (size_t)lf * D * DFF, DFF, 0, nullptr, scr);
}
__device__ __forceinline__ void p0_rwkv(Frame& F, int l, bool with_lora, LAS float* scr) {
    bf16_t* W2 = WSP(bf16_t, WS_WR2) + (size_t)l * NR2 * D;
    for (int c = 0; c < 3; ++c) transpose_matrix(F, INF(11) + ((size_t)l * 3 + c) * D * D, D, D, D, W2, D, c * 1024, nullptr, scr);
    if (!with_lora) zero_bf16(F, W2 + (size_t)3072 * D, (size_t)1024 * D * 2 / 16);
    else {
        zero_bf16(F, W2 + (size_t)3136 * D, (size_t)(3328 - 3136) * D * 2 / 16); zero_bf16(F, W2 + (size_t)3392 * D, (size_t)(3584 - 3392) * D * 2 / 16);
        zero_bf16(F, W2 + (size_t)3744 * D, (size_t)(3840 - 3744) * D * 2 / 16); zero_bf16(F, W2 + (size_t)3872 * D, (size_t)(4096 - 3872) * D * 2 / 16);
        transpose_matrix(F, INF(13) + (size_t)l * D * 64, D, 64, 64, W2, D, 3072, nullptr, scr);
        transpose_matrix(F, INF(16) + (size_t)l * D * 64, D, 64, 64, W2, D, 3328, nullptr, scr);
        transpose_matrix(F, INF(18) + (size_t)l * D * 160, D, 160, 160, W2, D, 3584, nullptr, scr);
        transpose_matrix(F, INF(27), D, 32, 32, W2, D, 3840, nullptr, scr); }
    transpose_matrix(F, INF(25) + (size_t)l * D * D, D, D, D, WSP(bf16_t, WS_WRO) + (size_t)l * D * D, D, 0, nullptr, scr);
    bf16_t* W3 = WSP(bf16_t, WS_WR3) + (size_t)l * NR3 * KR3;
    const size_t nth3 = (size_t)F.G * NTHREADS;
    for (size_t i0 = (size_t)F.bx * NTHREADS + F.tid; i0 < (size_t)NR3 * KR3; i0 += 4 * nth3) { float v[4];
#pragma unroll
        for (int e = 0; e < 4; ++e) { const size_t i = i0 + e * nth3; v[e] = 0.f; if (i < (size_t)NR3 * KR3) { const int n = (int)(i / KR3), k = (int)(i % KR3), q = n >> 10, ch = n & 1023;
            if (q == 0) { if (k < 64) v[e] = INF(14)[((size_t)l * 64 + k) * D + ch]; }
            else if (q == 1) { if (k >= 64 && k < 128) v[e] = INF(17)[((size_t)l * 64 + (k - 64)) * D + ch]; }
            else if (q == 2) { if (k >= 128 && k < 288) v[e] = INF(19)[((size_t)l * 160 + (k - 128)) * D + ch]; }
            else { if (l == 1 && k >= 288 && k < 320) v[e] = INF(28)[(size_t)(k - 288) * D + ch]; } } }
#pragma unroll
        for (int e = 0; e < 4; ++e) { const size_t i = i0 + e * nth3; if (i < (size_t)NR3 * KR3) W3[i] = (bf16_t)f2bf(v[e]); } }
}
constexpr int SWIN_SPLIT = 96;
__device__ __forceinline__ void swin_copy(Frame& F, int b_lo, int b_hi) {
    const size_t per = (size_t)508 * 512 / 4; const f32x4* cw = (const f32x4*)INF(3); f32x4* sw = (f32x4*)(F.out + O_SWIN);
    const size_t nth = (size_t)F.G * NTHREADS, tot = (size_t)(b_hi - b_lo) * per;
    for (size_t i0 = (size_t)F.bx * NTHREADS + F.tid; i0 < tot; i0 += 8 * nth) { f32x4 v[8];
#pragma unroll
        for (int q = 0; q < 8; ++q) { const size_t i = i0 + q * nth; if (i < tot) { const size_t b = b_lo + i / per, r = i % per; v[q] = cw[b * (512 * 512 / 4) + 4 * 512 / 4 + r]; } }
#pragma unroll
        for (int q = 0; q < 8; ++q) { const size_t i = i0 + q * nth; if (i < tot) { const size_t b = b_lo + i / per, r = i % per; sw[b * (512 * 512 / 4) + r] = v[q]; } } }
}
__device__ __forceinline__ void p0_part(Frame& F, int part) {
    LAS float* scr = (LAS float*)(F.lds + F.wave * 16384);
    if (part == 0) {
        p0_ffn(F, 0, scr); p0_ffn(F, 1, scr); p0_rwkv(F, 0, false, scr);
        for (int grp = F.gw; grp < MT / 4; grp += F.NGW) { f32x4 v[4][4];
#pragma unroll
            for (int q = 0; q < 4; ++q) { const int m = grp * 4 + q; const float* src = m < MP ? INF(0) + (size_t)m * D : INF(1) + (size_t)(m - MP) * D;
#pragma unroll
                for (int j = 0; j < 4; ++j) v[q][j] = *(const f32x4*)(src + j * 256 + F.lane * 4); }
#pragma unroll
            for (int q = 0; q < 4; ++q) { const int m = grp * 4 + q; float ss = 0.f;
#pragma unroll
                for (int j = 0; j < 4; ++j) { const f32x4 x = v[q][j]; *(f32x4*)(WSP(float, WS_H) + (size_t)m * D + j * 256 + F.lane * 4) = x;
                    u32x2 w; w.x = pk2(x.x, x.y); w.y = pk2(x.z, x.w); *(u32x2*)(WSP(bf16_t, WS_HB) + (size_t)m * D + j * 256 + F.lane * 4) = w; ss += (x.x * x.x + x.y * x.y) + (x.z * x.z + x.w * x.w); }
                ss = wave_sum(ss); if (F.lane < 16) WSP(float, WS_RS)[(size_t)m * 16 + F.lane] = F.lane == 0 ? ss : 0.f; } }
    } else if (part == 1) {
        p0_ffn(F, 2, scr); p0_ffn(F, 3, scr); p0_rwkv(F, 1, true, scr);
        swin_copy(F, 0, 32);
    } else {
        const float* norm_g = INF(7);
        for (int lf = 4; lf < 6; ++lf) p0_ffn(F, lf, scr);
        swin_copy(F, 32, 64);
        for (int l = 0; l < 2; ++l) {
            transpose_matrix(F, INF(34) + (size_t)l * D * 1072, D, 1072, 1072, WSP(bf16_t, WS_WQI) + (size_t)l * NQI * D, D, 0, norm_g + (size_t)((2 + l) * 3 + 1) * D, scr);
            zero_bf16(F, WSP(bf16_t, WS_WQI) + (size_t)l * NQI * D + (size_t)1088 * D, (size_t)(NQI - 1088) * D * 2 / 16);
            transpose_matrix(F, INF(35) + (size_t)l * D * D, D, D, D, WSP(bf16_t, WS_WBO) + (size_t)l * D * D, D, 0, nullptr, scr);
            transpose_matrix(F, INF(32) + (size_t)l * 2048 * 128, 1024, 128, 128, WSP(bf16_t, WS_WC1) + (size_t)l * 256 * 1024, 1024, 0, nullptr, scr);
            transpose_matrix(F, INF(32) + (size_t)l * 2048 * 128 + (size_t)1024 * 128, 1024, 128, 128, WSP(bf16_t, WS_WC1) + (size_t)l * 256 * 1024, 1024, 128, nullptr, scr); }
        transpose_matrix(F, INF(30), D, NKVW, NKVW, WSP(bf16_t, WS_WKV), D, 0, INF(29), scr);
        for (int o = F.gw; o < 256; o += F.NGW) { const int which = o >> 7, n = o & 127; float s = 0.f;
            for (int k = F.lane; k < 2048; k += 64) s += INF(31)[(size_t)which * 2048 + k] * INF(32)[((size_t)which * 2048 + k) * 128 + n];
            s = wave_sum(s); if (F.lane == 0) WSP(float, WS_POSB)[o] = s; }
    }
}
__device__ __forceinline__ void p0b_prologue(Frame& F) {
    LAS float* scr = (LAS float*)(F.lds + F.wave * 16384);
    bf16_t* W2 = WSP(bf16_t, WS_WR2);
    transpose_matrix(F, INF(13), D, 64, 64, W2, D, 3072, nullptr, scr);
    transpose_matrix(F, INF(16), D, 64, 64, W2, D, 3328, nullptr, scr);
    transpose_matrix(F, INF(18), D, 160, 160, W2, D, 3584, nullptr, scr);
}

__device__ __forceinline__ void r1_phase(Frame& F, int l) {
    const float* H = WSP(float, WS_H); const float* g = INF(7) + (size_t)(l * 3 + 1) * D; const float* mu = INF(10) + (size_t)l * 6 * D; bf16_t* XS = WSP(bf16_t, WS_XS);
    for (int grp = F.gw; grp < MT / 4; grp += F.NGW) { const int m0 = grp * 4; const RowInfo ri = row_info(m0);
        f32x4 x[5][4]; float ss[5];
#pragma unroll
        for (int q = 0; q < 5; ++q) { const int m = m0 - 1 + q;
            if (q > 0 || ri.t > 0) {
#pragma unroll
                for (int j = 0; j < 4; ++j) x[q][j] = *(const f32x4*)(H + (size_t)m * D + j * 256 + F.lane * 4); }
            else {
#pragma unroll
                for (int j = 0; j < 4; ++j) x[q][j] = (f32x4){0.f, 0.f, 0.f, 0.f}; } }
        __builtin_amdgcn_sched_barrier(0);
#pragma unroll
        for (int q = 0; q < 5; ++q) { ss[q] = 0.f;
#pragma unroll
            for (int j = 0; j < 4; ++j) ss[q] += (x[q][j].x * x[q][j].x + x[q][j].y * x[q][j].y) + (x[q][j].z * x[q][j].z + x[q][j].w * x[q][j].w); }
#pragma unroll
        for (int q = 0; q < 5; ++q) ss[q] = 1.0f / sqrtf(wave_sum(ss[q]) * (1.0f / D) + RMS_EPS);
#pragma unroll
        for (int j = 0; j < 4; ++j) { const int c = j * 256 + F.lane * 4; const f32x4 gg = *(const f32x4*)(g + c);
#pragma unroll
            for (int q = 0; q < 5; ++q) x[q][j] = x[q][j] * ss[q] * gg;
            if (ri.t == 0) x[0][j] = ri.stream == 1 ? *(const f32x4*)(INF(4) + ((size_t)l * NBS + ri.b) * D + c) : (f32x4){0.f, 0.f, 0.f, 0.f};
            f32x4 mm[6];
#pragma unroll
            for (int s6 = 0; s6 < 6; ++s6) mm[s6] = *(const f32x4*)(mu + (size_t)s6 * D + c);
#pragma unroll
            for (int q = 1; q < 5; ++q) { const int m = m0 - 1 + q; const f32x4 xx = x[q - 1][j] - x[q][j];
#pragma unroll
                for (int s6 = 0; s6 < 6; ++s6) { const f32x4 v = x[q][j] + xx * mm[s6]; u32x2 w; w.x = pk2(v.x, v.y); w.y = pk2(v.z, v.w); *(u32x2*)(XS + ((size_t)s6 * MT + m) * D + c) = w; } }
            if (ri.t + 4 == ri.tlen) { float* dst = ri.stream == 0 ? F.out + O_PSHIFT + ((size_t)l * NBP + ri.b) * D + c : F.out + O_SSHIFT + ((size_t)l * NBS + ri.b) * D + c; *(f32x4*)dst = x[4][j]; }
        }
    }
}

__device__ __forceinline__ float softplusf_(float x) { return fmaxf(x, 0.f) + log1pf(__expf(-fabsf(x))); }
__device__ __forceinline__ void r4_phase(Frame& F, int l) {
    const float* R = WSP(float, WS_RKV); const float* Kk = R + (size_t)MT * D; const float* V = R + (size_t)(2 + l) * MT * D; const float* VF = R + (size_t)2 * MT * D;
    const float* LU = WSP(float, WS_LU); float* SV = WSP(float, WS_SV);
    const float* w0 = INF(12) + (size_t)l * D; const float* a0 = INF(15) + (size_t)l * D; const float* k_k = INF(20) + (size_t)l * D; const float* k_a = INF(21) + (size_t)l * D; const float* v0 = INF(26);
    for (int m = MP + F.gw; m < MT; m += F.NGW) {
        const RowInfo ri = row_info(m); const int h = F.lane >> 2, j0 = (F.lane & 3) * 16, c0 = F.lane * 16;
        float* si = ri.stream == 0 ? WSP(float, WS_SIP) + (size_t)l * SIP_L + ((size_t)(ri.b * NH + h) * TP + ri.t) * SIW : WSP(float, WS_SIS) + (size_t)l * SIS_L + ((size_t)(ri.b * NH + h) * TS + ri.t) * SIW;
        float ss = 0.f;
#pragma unroll
        for (int q = 0; q < 4; ++q) { const f32x4 k = *(const f32x4*)(Kk + (size_t)m * D + c0 + q * 4), kk = *(const f32x4*)(k_k + c0 + q * 4); const f32x4 p = k * kk; ss += (p.x * p.x + p.y * p.y) + (p.z * p.z + p.w * p.w); }
        ss += shflx(ss, 1); ss += shflx(ss, 2);
        const float rn = 1.0f / sqrtf(fmaxf(ss, 1e-24f));
#pragma unroll
        for (int q = 0; q < 4; ++q) { const int c = c0 + q * 4, j = j0 + q * 4;
            const f32x4 r = *(const f32x4*)(R + (size_t)m * D + c), k = *(const f32x4*)(Kk + (size_t)m * D + c); f32x4 v = *(const f32x4*)(V + (size_t)m * D + c);
            const f32x4 wp = *(const f32x4*)(LU + (size_t)m * NR3 + c), ap = *(const f32x4*)(LU + (size_t)m * NR3 + 1024 + c);
            const f32x4 w0v = *(const f32x4*)(w0 + c), a0v = *(const f32x4*)(a0 + c), kkv = *(const f32x4*)(k_k + c), kav = *(const f32x4*)(k_a + c);
            f32x4 dec, a, km, an, bn;
#pragma unroll
            for (int e = 0; e < 4; ++e) { const float wl = -softplusf_(-(w0v[e] + wp[e])) - 0.5f; dec[e] = __expf(-__expf(wl)); a[e] = sigmoidf_(a0v[e] + ap[e]);
                const float kn = k[e] * kkv[e] * rn; an[e] = -kn; bn[e] = kn * a[e]; km[e] = k[e] * (1.0f + (a[e] - 1.0f) * kav[e]); }
            if (l == 1) { const f32x4 vg = *(const f32x4*)(LU + (size_t)m * NR3 + 3072 + c), v0v = *(const f32x4*)(v0 + c), vf = *(const f32x4*)(VF + (size_t)m * D + c);
#pragma unroll
                for (int e = 0; e < 4; ++e) v[e] = v[e] + (vf[e] - v[e]) * sigmoidf_(v0v[e] + vg[e]); }
            *(f32x4*)(si + 0 * 64 + j) = dec; *(f32x4*)(si + 1 * 64 + j) = km; *(f32x4*)(si + 2 * 64 + j) = an; *(f32x4*)(si + 3 * 64 + j) = bn; *(f32x4*)(si + 4 * 64 + j) = r;
            *(f32x4*)(SV + (size_t)m * D + c) = v; }
    }
}

__device__ __forceinline__ void scan_chain(const float* si_g, const float* v, float* y, int tlen, const float* s0, float* sT, int lane) {
    float s[64];
    if (s0) {
#pragma unroll
        for (int q = 0; q < 16; ++q) { const f32x4 t = *(const f32x4*)(s0 + (size_t)lane * 64 + q * 4); s[q * 4] = t.x; s[q * 4 + 1] = t.y; s[q * 4 + 2] = t.z; s[q * 4 + 3] = t.w; }
    } else {
#pragma unroll
        for (int j = 0; j < 64; ++j) s[j] = 0.f;
    }
    const CAS float* sp = (const CAS float*)(unsigned long long)si_g;
    for (int t = 0; t < tlen; ++t) {
        const float vi = v[(size_t)t * D + lane];
        float sa = 0.f;
#pragma unroll
        for (int j = 0; j < 64; ++j) sa += s[j] * sp[128 + j];
        float yy = 0.f;
#pragma unroll
        for (int j = 0; j < 64; ++j) { s[j] = s[j] * sp[j] + sa * sp[192 + j] + vi * sp[64 + j]; yy += s[j] * sp[256 + j]; }
        y[(size_t)t * D + lane] = yy;
        sp += SIW;
    }
#pragma unroll
    for (int q = 0; q < 16; ++q) *(f32x4*)(sT + (size_t)lane * 64 + q * 4) = (f32x4){s[q * 4], s[q * 4 + 1], s[q * 4 + 2], s[q * 4 + 3]};
}
__device__ __forceinline__ void r5_phase(Frame& F, int l) {
    const float* SV = WSP(float, WS_SV); float* YS = WSP(float, WS_YS);
    if (F.wave == 0 && F.bx < NCH_P) { const int ch = F.bx, b = ch >> 4, h = ch & 15;
        scan_chain(WSP(float, WS_SIP) + (size_t)l * SIP_L + (size_t)ch * TP * SIW, SV + (size_t)b * TP * D + h * 64, YS + (size_t)b * TP * D + h * 64, TP, nullptr, F.out + O_PWKV + ((size_t)(l * NBP + b) * NH + h) * 4096, F.lane);
    } else {
        const int nworkers = F.G * NWAVES - NCH_P; int widx = (F.wave == 0) ? F.bx - NCH_P : NCH_P * 0 + (F.G - NCH_P) + F.bx * (NWAVES - 1) + (F.wave - 1);
        for (int ch = widx; ch < NCH_S; ch += nworkers) { const int b = ch >> 4, h = ch & 15;
            scan_chain(WSP(float, WS_SIS) + (size_t)l * SIS_L + (size_t)ch * TS * SIW, SV + (size_t)(MP + b * TS) * D + h * 64, YS + (size_t)(MP + b * TS) * D + h * 64, TS,
                       INF(5) + ((size_t)(l * NBS + b) * NH + h) * 4096, F.out + O_SWKV + ((size_t)(l * NBS + b) * NH + h) * 4096, F.lane); }
        __syncthreads(); { Frame F2 = F; F2.bx = F.bx - NCH_P; F2.G = F.G - NCH_P; F2.gw = F2.bx * NWAVES + F.wave; F2.NGW = F2.G * NWAVES; p0_part(F2, 1 + l); }
    }
}


constexpr int NCHK = TP / 64;
#define RL(x, j) __builtin_bit_cast(float, __builtin_amdgcn_readlane(__builtin_bit_cast(int, (x)), (j)))
__device__ __forceinline__ float dpp_add(float v, const int ctrl_sel) {
    int r;
    if (ctrl_sel == 0) r = __builtin_amdgcn_update_dpp(0, __builtin_bit_cast(int, v), 0xB1, 0xF, 0xF, true);
    else if (ctrl_sel == 1) r = __builtin_amdgcn_update_dpp(0, __builtin_bit_cast(int, v), 0x4E, 0xF, 0xF, true);
    else if (ctrl_sel == 2) r = __builtin_amdgcn_update_dpp(0, __builtin_bit_cast(int, v), 0x141, 0xF, 0xF, true);
    else r = __builtin_amdgcn_update_dpp(0, __builtin_bit_cast(int, v), 0x140, 0xF, 0xF, true);
    return v + __builtin_bit_cast(float, r); }
__device__ __forceinline__ float wave_sum_dpp(float v) { v = dpp_add(v, 0); v = dpp_add(v, 1); v = dpp_add(v, 2); v = dpp_add(v, 3); return (RL(v, 0) + RL(v, 16)) + (RL(v, 32) + RL(v, 48)); }
struct StepIn { float w, k, a, b, r, v; };
struct RawIn { float r, k, v, wp, ap, vg, vf; };
struct ChanC { float w0, a0, kk, ka, v0; };
__device__ __forceinline__ float bf2f(bf16_t u) { return __builtin_bit_cast(float, (unsigned)u << 16); }
__device__ __forceinline__ void rawin_load(RawIn& x, const bf16_t* rec_, int lane, int l) {
    const GAS bf16_t* rec = (const GAS bf16_t*)rec_; const GAS bf16_t* rec0 = rec - (size_t)l * SCN_L; const unsigned o = (unsigned)lane;
    const GAS bf16_t* pl = rec + o;
    x.r = bf2f(pl[0]); x.k = bf2f(pl[64]); x.v = bf2f(pl[128]); x.wp = bf2f(pl[192]); x.ap = bf2f(pl[256]);
    if (l == 1) { x.vg = bf2f(pl[384]); x.vf = bf2f((rec0 + o)[128]); } else { x.vg = 0.f; x.vf = 0.f; } }
__device__ __forceinline__ void rawin_xform(StepIn& s, const RawIn& x, const LAS float* cb, int l) {
    ChanC cc; cc.w0 = cb[0]; cc.a0 = cb[64]; cc.kk = cb[128]; cc.ka = cb[192]; cc.v0 = cb[256];
    const float z = -(cc.w0 + x.wp); const float wl = -(fmaxf(z, 0.f) + __logf(1.0f + __expf(-fabsf(z)))) - 0.5f;
    s.w = __expf(-__expf(wl)); const float a = __builtin_amdgcn_rcpf(1.0f + __expf(-(cc.a0 + x.ap)));
    const float kk = x.k * cc.kk; const float ss = wave_sum_dpp(kk * kk); const float kn = kk * __builtin_amdgcn_rsqf(fmaxf(ss, 1e-24f));
    s.a = -kn; s.b = kn * a; s.k = x.k * (1.0f + (a - 1.0f) * cc.ka); s.r = x.r;
    s.v = (l == 1) ? x.v + (x.vf - x.v) * __builtin_amdgcn_rcpf(1.0f + __expf(-(cc.v0 + x.vg))) : x.v; }
struct SG8 { f32x4 bk[4], r4[2]; };
__device__ __forceinline__ f32x2 fma2(f32x2 a, f32x2 b, f32x2 c) { return __builtin_elementwise_fma(a, b, c); }
__device__ __forceinline__ void stepA(f32x2 (&g)[32], f32x2 (&tt)[32], const StepIn& s, LAS float* sb, int lane, float& y0, float& q) {
    { const int jp = (lane >> 1) * 4 + (lane & 1); sb[lane] = s.a; sb[64 + jp] = s.b; sb[64 + jp + 2] = s.k; sb[192 + lane] = s.r; }
    asm volatile("s_waitcnt lgkmcnt(0)" ::: "memory");
    f32x2 sga = (f32x2){0.f, 0.f}, sta = (f32x2){0.f, 0.f}; LAS float* pb = sb;
    f32x4 a4[16];
#pragma unroll
    for (int jq = 0; jq < 16; ++jq) a4[jq] = *(const LAS f32x4*)(pb + 4 * jq);
    SG8 d0, d1, d2;
#define SA_LD(gi, d) do { _Pragma("unroll") for (int e = 0; e < 4; ++e) d.bk[e] = *(const LAS f32x4*)(pb + 64 + 4 * (4 * (gi) + e)); \
        _Pragma("unroll") for (int e = 0; e < 2; ++e) d.r4[e] = *(const LAS f32x4*)(pb + 192 + 4 * (2 * (gi) + e)); } while (0)
#define SA_CP(gi, d) do { _Pragma("unroll") for (int e = 0; e < 4; ++e) { const int jp = 4 * (gi) + e; const f32x2 b2 = (f32x2){d.bk[e].x, d.bk[e].y}, k2 = (f32x2){d.bk[e].z, d.bk[e].w}; \
        const f32x2 r2 = (e & 1) ? (f32x2){d.r4[e >> 1].z, d.r4[e >> 1].w} : (f32x2){d.r4[e >> 1].x, d.r4[e >> 1].y}; \
        g[jp] = fma2(sv2, k2, fma2(sg2, b2, g[jp])); tt[jp] = fma2(st2, b2, tt[jp]); yab = fma2(g[jp], r2, yab); qab = fma2(tt[jp], r2, qab); } \
        asm volatile("" : "+v"(pb), "+v"(yab), "+v"(qab)); } while (0)
    SA_LD(0, d0);
#pragma unroll
    for (int jq = 0; jq < 16; ++jq) { const f32x2 lo = (f32x2){a4[jq].x, a4[jq].y}, hi = (f32x2){a4[jq].z, a4[jq].w};
        sga = fma2(g[2 * jq], lo, sga); sga = fma2(g[2 * jq + 1], hi, sga); sta = fma2(tt[2 * jq], lo, sta); sta = fma2(tt[2 * jq + 1], hi, sta); }
    const float sg = sga.x + sga.y, st = sta.x + sta.y; const f32x2 sg2 = (f32x2){sg, sg}, st2 = (f32x2){st, st}, sv2 = (f32x2){s.v, s.v}; f32x2 yab = (f32x2){0.f, 0.f}, qab = (f32x2){0.f, 0.f};
    asm volatile("" : "+v"(pb), "+v"(yab));
    SA_LD(1, d1); SA_LD(2, d2);
    SA_CP(0, d0); SA_LD(3, d0); SA_CP(1, d1); SA_LD(4, d1); SA_CP(2, d2); SA_LD(5, d2); SA_CP(3, d0); SA_LD(6, d0);
    SA_CP(4, d1); SA_LD(7, d1); SA_CP(5, d2); SA_CP(6, d0); SA_CP(7, d1);
#undef SA_LD
#undef SA_CP
    y0 = yab.x + yab.y; q = qab.x + qab.y;
    asm volatile("" ::: "memory");
}
__device__ __forceinline__ float stepC(float (&g)[64], const StepIn& s) {
    float sg0 = 0.f, sg1 = 0.f;
#pragma unroll
    for (int j = 0; j < 64; j += 2) { sg0 = fmaf(g[j], RL(s.a, j), sg0); sg1 = fmaf(g[j + 1], RL(s.a, j + 1), sg1); if ((j & 15) == 14) __builtin_amdgcn_sched_barrier(0); }
    const float sg = sg0 + sg1; float y0 = 0.f, y1 = 0.f;
#pragma unroll
    for (int j = 0; j < 64; j += 2) {
        g[j] = fmaf(s.v, RL(s.k, j), fmaf(sg, RL(s.b, j), g[j] * RL(s.w, j))); y0 = fmaf(g[j], RL(s.r, j), y0);
        g[j + 1] = fmaf(s.v, RL(s.k, j + 1), fmaf(sg, RL(s.b, j + 1), g[j + 1] * RL(s.w, j + 1))); y1 = fmaf(g[j + 1], RL(s.r, j + 1), y1);
        if ((j & 7) == 6) __builtin_amdgcn_sched_barrier(0); }
    return y0 + y1;
}
__device__ __forceinline__ void scanA_phase(Frame& F, int l) {
    const bf16_t* SCN = WSP(bf16_t, WS_SCN) + (size_t)l * SCN_L; float* TG = WSP(float, WS_TG);
    for (int job = F.gw; job < NCH_P * NCHK; job += F.NGW) { const int ch = job >> 6, c = job & 63, b = ch >> 4, h = ch & 15; const size_t m0 = (size_t)b * TP + c * 64;
        int lane_; asm volatile("v_mbcnt_lo_u32_b32 %0, -1, 0\n\tv_mbcnt_hi_u32_b32 %0, -1, %0" : "=v"(lane_)); const int lane = lane_, cn = h * 64 + lane;
        f32x2 g[32], tt[32]; LAS float* sb = (LAS float*)(F.lds + F.wave * 4096); LAS float* cb = sb + 320 + lane;
        cb[0] = INF(12)[(size_t)l * D + cn]; cb[64] = INF(15)[(size_t)l * D + cn]; cb[128] = INF(20)[(size_t)l * D + cn]; cb[192] = INF(21)[(size_t)l * D + cn]; cb[256] = INF(26)[cn]; cb[320] = INF(22)[(size_t)l * D + cn];
#pragma unroll
        for (int j = 0; j < 32; ++j) { g[j] = (f32x2){0.f, 0.f}; tt[j] = (f32x2){(2 * j == lane) ? 1.f : 0.f, (2 * j + 1 == lane) ? 1.f : 0.f}; }
        const size_t rbase = ((size_t)ch * TP + c * 64) * 448;
        StepIn s; float Pj = 1.0f; unsigned ur, uk, uv, uw, ua, ug = 0u, uf = 0u; const unsigned vo = (unsigned)lane * 2u;
#define GLD_U16(dst, base, OFF) asm volatile("global_load_ushort %0, %1, %2 offset:" #OFF : "=v"(dst) : "v"(vo), "s"(base) : "memory")
#define RAW_ISSUE(tt_) do { const unsigned long long a_ = (unsigned long long)(SCN + rbase + (size_t)(tt_) * 448); \
            const unsigned long long rb_ = ((unsigned long long)(unsigned)__builtin_amdgcn_readfirstlane((unsigned)(a_ >> 32)) << 32) | (unsigned)__builtin_amdgcn_readfirstlane((unsigned)a_); \
            GLD_U16(ur, rb_, 0); GLD_U16(uk, rb_, 128); GLD_U16(uv, rb_, 256); GLD_U16(uw, rb_, 384); GLD_U16(ua, rb_, 512); \
            if (l == 1) { GLD_U16(ug, rb_, 768); const unsigned long long r0_ = rb_ - (unsigned long long)SCN_L * 2ull; GLD_U16(uf, r0_, 256); } } while (0)
        RAW_ISSUE(0);
        GAS float* yq = (GAS float*)(WSP(float, WS_YQ) + (size_t)job * 12288);
        float py0 = 0.f, pq = 0.f, pvb = 0.f;
#pragma unroll 1
        for (int t = 0; t < 64; ++t) {
            asm volatile("s_waitcnt vmcnt(0)" : "+v"(ur), "+v"(uk), "+v"(uv), "+v"(uw), "+v"(ua), "+v"(ug), "+v"(uf) : : "memory");
            if (t > 0) { const unsigned o = (unsigned)((t - 1) * 64 + lane); yq[o] = py0; yq[4096 + o] = pq; yq[8192 + o] = pvb; }
            RawIn x0; x0.r = __builtin_bit_cast(float, ur << 16); x0.k = __builtin_bit_cast(float, uk << 16); x0.v = __builtin_bit_cast(float, uv << 16); x0.wp = __builtin_bit_cast(float, uw << 16); x0.ap = __builtin_bit_cast(float, ua << 16);
            x0.vg = __builtin_bit_cast(float, ug << 16); x0.vf = __builtin_bit_cast(float, uf << 16);
            asm volatile("" : "+v"(x0.r), "+v"(x0.k), "+v"(x0.v), "+v"(x0.wp), "+v"(x0.ap), "+v"(x0.vg), "+v"(x0.vf));
            if (t + 1 < 64) RAW_ISSUE(t + 1);
            rawin_xform(s, x0, cb, l);
            const float bon = wave_sum_dpp(s.r * s.k * cb[320]);
            { const float Pp = Pj; Pj *= s.w; const float iP = __builtin_amdgcn_rcpf(Pj); s.a *= Pp; s.b *= iP; s.k *= iP; s.r *= Pj; }
            float y0, q; stepA(g, tt, s, sb, lane, y0, q); py0 = y0; pq = q; pvb = s.v * bon; }
        { const unsigned o = (unsigned)(63 * 64 + lane); yq[o] = py0; yq[4096 + o] = pq; yq[8192 + o] = pvb; }
#undef RAW_ISSUE
#undef GLD_U16
        float* gt = TG + (size_t)job * 8192; float* tm = gt + 4096;
        sb[lane] = Pj; asm volatile("s_waitcnt lgkmcnt(0)" ::: "memory");
#pragma unroll
        for (int j = 0; j < 32; ++j) { const f32x2 p2 = *(const LAS f32x2*)(sb + 2 * j); g[j] = g[j] * p2; tt[j] = tt[j] * p2; }
#pragma unroll
        for (int j = 0; j < 32; ++j) { gt[(2 * j) * 64 + lane] = g[j].x; gt[(2 * j + 1) * 64 + lane] = g[j].y; }
#pragma unroll
        for (int q = 0; q < 16; ++q) *(f32x4*)(tm + lane * 64 + q * 4) = (f32x4){tt[2 * q].x, tt[2 * q].y, tt[2 * q + 1].x, tt[2 * q + 1].y};
    }
}
__device__ __forceinline__ void scanC_phase(Frame& F, int l) {
    const bf16_t* SCN = WSP(bf16_t, WS_SCN) + (size_t)l * SCN_L; bf16_t* YG = WSP(bf16_t, WS_YG); const float* SS = WSP(float, WS_SS);
    const int lane = F.lane, c16 = lane & 15, g4 = lane >> 4;
    for (int job = F.gw; job < NCH_P * NCHK; job += F.NGW) { const int ch = job >> 6, c = job & 63, b = ch >> 4, h = ch & 15; const size_t m0 = (size_t)b * TP + c * 64;
        const float* yq = WSP(float, WS_YQ) + (size_t)job * 12288; const float* sp = SS + (size_t)job * 4096;
        float lw[4], lb[4];
#pragma unroll
        for (int ct = 0; ct < 4; ++ct) { lw[ct] = INF(23)[(size_t)l * D + h * 64 + 16 * ct + c16]; lb[ct] = INF(24)[(size_t)l * D + h * 64 + 16 * ct + c16]; }
        float sv[16][4];
        if (c > 0) {
#pragma unroll
            for (int ks = 0; ks < 16; ++ks)
#pragma unroll
                for (int ct = 0; ct < 4; ++ct) sv[ks][ct] = sp[(16 * ct + c16) * 64 + 4 * ks + g4]; }
#pragma unroll 1
        for (int tt = 0; tt < 4; ++tt) {
            f32x4 acc[4]; float av[16], vbv[4][4], gtv[4][4];
#pragma unroll
            for (int ct = 0; ct < 4; ++ct)
#pragma unroll
                for (int rg = 0; rg < 4; ++rg) acc[ct][rg] = yq[(16 * tt + 4 * g4 + rg) * 64 + 16 * ct + c16];
#pragma unroll
            for (int ks = 0; ks < 16; ++ks) av[ks] = yq[4096 + (16 * tt + c16) * 64 + 4 * ks + g4];
#pragma unroll
            for (int rg = 0; rg < 4; ++rg)
#pragma unroll
                for (int ct = 0; ct < 4; ++ct) { const int t = 16 * tt + 4 * g4 + rg, i = 16 * ct + c16; vbv[rg][ct] = yq[8192 + t * 64 + i]; gtv[rg][ct] = bf2f(SCN[((size_t)ch * TP + c * 64 + t) * 448 + 320 + i]); }
            if (c > 0) {
#pragma unroll
                for (int ks = 0; ks < 16; ++ks)
#pragma unroll
                    for (int ct = 0; ct < 4; ++ct) acc[ct] = __builtin_amdgcn_mfma_f32_16x16x4f32(av[ks], sv[ks][ct], acc[ct], 0, 0, 0); }
#pragma unroll
            for (int rg = 0; rg < 4; ++rg) { const int t = 16 * tt + 4 * g4 + rg;
                float s1 = (acc[0][rg] + acc[1][rg]) + (acc[2][rg] + acc[3][rg]);
                s1 += shflx(s1, 1); s1 += shflx(s1, 2); s1 += shflx(s1, 4); s1 += shflx(s1, 8);
                const float mean = s1 * (1.0f / 64.0f); float d[4], s2 = 0.f;
#pragma unroll
                for (int ct = 0; ct < 4; ++ct) { d[ct] = acc[ct][rg] - mean; s2 += d[ct] * d[ct]; }
                s2 += shflx(s2, 1); s2 += shflx(s2, 2); s2 += shflx(s2, 4); s2 += shflx(s2, 8);
                const float rstd = 1.0f / sqrtf(s2 * (1.0f / 64.0f) + GN_EPS);
#pragma unroll
                for (int ct = 0; ct < 4; ++ct) { const int i = 16 * ct + c16;
                    YG[(m0 + t) * D + h * 64 + i] = (bf16_t)f2bf((d[ct] * rstd * lw[ct] + lb[ct] + vbv[rg][ct]) * gtv[rg][ct]); } }
        }
    }
}
__device__ __forceinline__ void scanB_phase(Frame& F, int l) {
    if (F.bx < NCH_P) {
        const int ch = F.bx, b = ch >> 4, h = ch & 15, w = F.wave, lane = F.lane, c16 = lane & 15, g4 = lane >> 4;
        const float* TG = WSP(float, WS_TG) + (size_t)ch * NCHK * 8192; float* SS = WSP(float, WS_SS) + (size_t)ch * NCHK * 4096;
        LAS float* TL = (LAS float*)F.lds;
        LAS float* SL = (LAS float*)(F.lds + 49152) + w * (16 * 68);
        LAS float* GL = (LAS float*)(F.lds + 81920);
        if (w < 4) { for (int e = lane; e < 16 * 68; e += 64) SL[e] = 0.f; }
#define SCANB_DMA(cc_) do { const char* src_ = (const char*)(TG + (size_t)(cc_) * 8192 + 4096); LAS char* dst_ = (LAS char*)TL + ((cc_) % 3) * 16384; \
        _Pragma("unroll") for (int i4 = 0; i4 < 4; ++i4) __builtin_amdgcn_global_load_lds((const unsigned*)(src_ + (i4 * 256 + (w - 4) * 64 + lane) * 16), (LAS unsigned*)(dst_ + (i4 * 256 + (w - 4) * 64) * 16), 16, 0, 0); \
        const char* srg_ = (const char*)(TG + (size_t)(cc_) * 8192); LAS char* dsg_ = (LAS char*)GL + ((cc_) % 3) * 16384; \
        _Pragma("unroll") for (int i4 = 0; i4 < 4; ++i4) { const int s_ = i4 * 256 + (w - 4) * 64 + lane, R_ = s_ >> 4; \
            __builtin_amdgcn_global_load_lds((const unsigned*)(srg_ + (R_ * 16 + ((s_ & 15) ^ (R_ & 15))) * 16), (LAS unsigned*)(dsg_ + (i4 * 256 + (w - 4) * 64) * 16), 16, 0, 0); } } while (0)
        if (w >= 4) { SCANB_DMA(0); SCANB_DMA(1); asm volatile("s_waitcnt vmcnt(8)" ::: "memory"); }
        asm volatile("s_waitcnt lgkmcnt(0)" ::: "memory"); __syncthreads();
        for (int c = 0; c < NCHK; ++c) {
            if (w >= 4 && c + 2 < NCHK) SCANB_DMA(c + 2);
            if (w < 4) { const LAS float* tl = TL + (c % 3) * 4096; const LAS float* gl = GL + (c % 3) * 4096; f32x4 acc[4], gv[4];
#pragma unroll
                for (int ct = 0; ct < 4; ++ct) acc[ct] = (f32x4){0.f, 0.f, 0.f, 0.f};
                float av[16], tv[2][4][4];
#pragma unroll
                for (int ks = 0; ks < 16; ++ks) av[ks] = SL[c16 * 68 + 4 * ks + g4];
#pragma unroll
                for (int ct = 0; ct < 4; ++ct) gv[ct] = *(const LAS f32x4*)(gl + (16 * ct + c16) * 64 + 4 * ((4 * w + g4) ^ c16));
#pragma unroll
                for (int k4 = 0; k4 < 4; ++k4)
#pragma unroll
                    for (int ct = 0; ct < 4; ++ct) tv[0][k4][ct] = tl[(4 * k4 + g4) * 64 + 16 * ct + c16];
                __builtin_amdgcn_sched_barrier(0);
#pragma unroll
                for (int grp = 0; grp < 4; ++grp) {
                    if (grp < 3) {
#pragma unroll
                        for (int k4 = 0; k4 < 4; ++k4)
#pragma unroll
                            for (int ct = 0; ct < 4; ++ct) tv[(grp + 1) & 1][k4][ct] = tl[(4 * (4 * (grp + 1) + k4) + g4) * 64 + 16 * ct + c16]; }
                    __builtin_amdgcn_sched_barrier(0);
#pragma unroll
                    for (int k4 = 0; k4 < 4; ++k4)
#pragma unroll
                        for (int ct = 0; ct < 4; ++ct) acc[ct] = __builtin_amdgcn_mfma_f32_16x16x4f32(av[4 * grp + k4], tv[grp & 1][k4][ct], acc[ct], 0, 0, 0);
                    __builtin_amdgcn_sched_barrier(0); }
#pragma unroll
                for (int ct = 0; ct < 4; ++ct) acc[ct] = acc[ct] + gv[ct];
                asm volatile("s_waitcnt lgkmcnt(0)" ::: "memory");
                GAS float* so = (GAS float*)((c + 1 < NCHK) ? SS + (size_t)(c + 1) * 4096 : F.out + O_PWKV + ((size_t)(l * NBP + b) * NH + h) * 4096);
#pragma unroll
                for (int ct = 0; ct < 4; ++ct)
#pragma unroll
                    for (int rg = 0; rg < 4; ++rg) { SL[(4 * g4 + rg) * 68 + 16 * ct + c16] = acc[ct][rg]; so[(16 * w + 4 * g4 + rg) * 64 + 16 * ct + c16] = acc[ct][rg]; }
                asm volatile("s_waitcnt lgkmcnt(0)" ::: "memory");
            }
            if (w >= 4) { if (c + 2 < NCHK) asm volatile("s_waitcnt vmcnt(8)" ::: "memory"); else asm volatile("s_waitcnt vmcnt(0)" ::: "memory"); }
            __syncthreads();
        }
#undef SCANB_DMA
    } else {
        const float* SV = WSP(float, WS_SV); float* YS = WSP(float, WS_YS);
        const int nworkers = (F.G - NCH_P) * NWAVES; const int widx = (F.bx - NCH_P) * NWAVES + F.wave;
        for (int ch = widx; ch < NCH_S; ch += nworkers) { const int b = ch >> 4, h = ch & 15;
            scan_chain(WSP(float, WS_SIS) + (size_t)l * SIS_L + (size_t)ch * TS * SIW, SV + (size_t)(MP + b * TS) * D + h * 64, YS + (size_t)(MP + b * TS) * D + h * 64, TS,
                       INF(5) + ((size_t)(l * NBS + b) * NH + h) * 4096, F.out + O_SWKV + ((size_t)(l * NBS + b) * NH + h) * 4096, F.lane); }
        __syncthreads(); { Frame F2 = F; F2.bx = F.bx - NCH_P; F2.G = F.G - NCH_P; F2.gw = F2.bx * NWAVES + F.wave; F2.NGW = F2.G * NWAVES; p0_part(F2, 1 + l); }
    }
}

__device__ __forceinline__ void r5b_phase(Frame& F, int l) {
    const float* YS = WSP(float, WS_YS); const float* SV = WSP(float, WS_SV); const float* LU = WSP(float, WS_LU); bf16_t* YG = WSP(bf16_t, WS_YG);
    const float* lw = INF(23) + (size_t)l * D; const float* lb = INF(24) + (size_t)l * D; const float* rk = INF(22) + (size_t)l * D;
    for (int m = MP + F.gw; m < MT; m += F.NGW) {
        const RowInfo ri = row_info(m); const int h = F.lane >> 2, j0 = (F.lane & 3) * 16, c0 = F.lane * 16;
        const float* si = ri.stream == 0 ? WSP(float, WS_SIP) + (size_t)l * SIP_L + ((size_t)(ri.b * NH + h) * TP + ri.t) * SIW : WSP(float, WS_SIS) + (size_t)l * SIS_L + ((size_t)(ri.b * NH + h) * TS + ri.t) * SIW;
        f32x4 y[4]; float s1 = 0.f, bon = 0.f;
#pragma unroll
        for (int q = 0; q < 4; ++q) { y[q] = *(const f32x4*)(YS + (size_t)m * D + c0 + q * 4); s1 += (y[q].x + y[q].y) + (y[q].z + y[q].w);
            const f32x4 k = *(const f32x4*)(si + 64 + j0 + q * 4), r = *(const f32x4*)(si + 256 + j0 + q * 4), rkv = *(const f32x4*)(rk + c0 + q * 4);
            bon += (r.x * k.x * rkv.x + r.y * k.y * rkv.y) + (r.z * k.z * rkv.z + r.w * k.w * rkv.w); }
        s1 += shflx(s1, 1); s1 += shflx(s1, 2); bon += shflx(bon, 1); bon += shflx(bon, 2);
        const float mean = s1 * (1.0f / 64.0f); float s2 = 0.f;
#pragma unroll
        for (int q = 0; q < 4; ++q) { const f32x4 d = y[q] - mean; s2 += (d.x * d.x + d.y * d.y) + (d.z * d.z + d.w * d.w); }
        s2 += shflx(s2, 1); s2 += shflx(s2, 2);
        const float rstd = 1.0f / sqrtf(s2 * (1.0f / 64.0f) + GN_EPS);
#pragma unroll
        for (int q = 0; q < 4; ++q) { const int c = c0 + q * 4; const f32x4 w = *(const f32x4*)(lw + c), b = *(const f32x4*)(lb + c), v = *(const f32x4*)(SV + (size_t)m * D + c), g = *(const f32x4*)(LU + (size_t)m * NR3 + 2048 + c);
            const f32x4 o = ((y[q] - mean) * rstd * w + b + v * bon) * g;
            u32x2 ww; ww.x = pk2(o.x, o.y); ww.y = pk2(o.z, o.w); *(u32x2*)(YG + (size_t)m * D + c) = ww; }
    }
}

__device__ __forceinline__ const float* cst_src(Frame& F, int it, int p, int d0) {
    const float* cache = INF(2); const int* pt = (const int*)F.in[6]; const int which = it / CROWS, row = it % CROWS;
    if (row < CROWS_S) { const int bk = row >> 7, n = row & 127, b = bk >> 2, kvh = bk & 3, pos = 16 * n + p; const int page = pt[b * NPG + (pos >> 7)];
        return cache + (((size_t)page * PAGE + (pos & 127)) * 4 + which) * 256 + kvh * 64 + d0; }
    const int r2 = row - CROWS_S, bk = r2 >> 8, n = r2 & 255, b = bk >> 2, kvh = bk & 3, pos = 16 * n + p;
    return F.out + O_PCS + (((size_t)b * TP + pos) * 4 + which) * 256 + kvh * 64 + d0; }
__device__ __forceinline__ void cst_phase(Frame& F) {
    bf16_t* CST = WSP(bf16_t, WS_CST);
    const int p = F.lane >> 2, d0 = (F.lane & 3) * 16;
    for (int it0 = F.gw; it0 < 2 * CROWS; it0 += 4 * F.NGW) { const float* src[4]; f32x4 v[4][4];
#pragma unroll
        for (int q = 0; q < 4; ++q) { const int it = it0 + q * F.NGW; src[q] = cst_src(F, it < 2 * CROWS ? it : it0, p, d0); }
#pragma unroll
        for (int q = 0; q < 4; ++q)
#pragma unroll
            for (int e = 0; e < 4; ++e) v[q][e] = *(const f32x4*)(src[q] + 4 * e);
#pragma unroll
        for (int q = 0; q < 4; ++q) { const int it = it0 + q * F.NGW; if (it < 2 * CROWS) { u32x4 w0, w1;
            w0.x = pk2(v[q][0].x, v[q][0].y); w0.y = pk2(v[q][0].z, v[q][0].w); w0.z = pk2(v[q][1].x, v[q][1].y); w0.w = pk2(v[q][1].z, v[q][1].w);
            w1.x = pk2(v[q][2].x, v[q][2].y); w1.y = pk2(v[q][2].z, v[q][2].w); w1.z = pk2(v[q][3].x, v[q][3].y); w1.w = pk2(v[q][3].z, v[q][3].w);
            bf16_t* dst = CST + (size_t)it * 1024 + p * 64 + d0; *(u32x4*)dst = w0; *(u32x4*)(dst + 8) = w1; } }
    }
}
__device__ __forceinline__ float gelu_tanh(float x) { const float u = 0.7978845608028654f * (x + 0.044715f * x * x * x); return 0.5f * x * (1.0f + tanh_fast(u)); }
__device__ __forceinline__ void c2_phase(Frame& F) {
    const float* CH = WSP(float, WS_CH); float* KC = WSP(float, WS_KCMP); const float* posb = WSP(float, WS_POSB); LAS float* hv = (LAS float*)(F.lds + F.wave * 2048);
    for (int it0 = F.gw * 4; it0 < 2 * CROWS; it0 += 4 * F.NGW) { const int which = it0 / CROWS, row0 = it0 % CROWS;
        const float* w2 = INF(33) + (size_t)which * 128 * 64;
        float xl[4][2], xh[4][2], pb[2];
#pragma unroll
        for (int e = 0; e < 2; ++e) pb[e] = posb[which * 128 + F.lane + 64 * e];
#pragma unroll
        for (int q = 0; q < 4; ++q) { const int row = row0 + q; bool has_hi; if (row < CROWS_S) has_hi = (row & 127) != 127; else has_hi = ((row - CROWS_S) & 255) != 255;
            const float* lo = CH + ((size_t)which * CROWS + row) * 256; const float* hi = has_hi ? lo + 256 + 128 : lo;
#pragma unroll
            for (int e = 0; e < 2; ++e) { const int c = F.lane + 64 * e; xl[q][e] = lo[c]; const float hval = hi[c]; xh[q][e] = has_hi ? hval : 0.f; } }
        __builtin_amdgcn_sched_barrier(0);
#pragma unroll
        for (int q = 0; q < 4; ++q)
#pragma unroll
            for (int e = 0; e < 2; ++e) { const int c = F.lane + 64 * e; const float x = xl[q][e] + xh[q][e] + pb[e]; hv[c * 4 + q] = gelu_tanh(x); }
        LDS_WAIT(); asm volatile("" ::: "memory");
        float o0 = 0.f, o1 = 0.f, o2 = 0.f, o3 = 0.f;
        const GAS float* w2g = (const GAS float*)w2 + F.lane;
#pragma unroll 32
        for (int c = 0; c < 128; ++c) { const float w = w2g[c * 64]; const f32x4 h4 = *(const LAS f32x4*)(hv + c * 4); o0 += h4.x * w; o1 += h4.y * w; o2 += h4.z * w; o3 += h4.w * w; }
#pragma unroll
        for (int q = 0; q < 4; ++q) { const int row = row0 + q; const float o = q == 0 ? o0 : (q == 1 ? o1 : (q == 2 ? o2 : o3));
            KC[((size_t)which * CROWS + row) * 64 + F.lane] = o;
            if (row >= CROWS_S) { const int r2 = row - CROWS_S, bkc = r2 >> 8, n = r2 & 255; bf16_t* KCB = WSP(bf16_t, WS_KCB);
                if (which == 0) KCB[(size_t)r2 * 64 + F.lane] = (bf16_t)f2bf(o);
                else KCB[(size_t)16 * 256 * 64 + ((size_t)(bkc * 4 + (n >> 6)) * 64 + F.lane) * 64 + vt_slot(n & 63)] = (bf16_t)f2bf(o); } }
        LDS_WAIT(); asm volatile("" ::: "memory"); }
}


constexpr size_t KVB = (size_t)16 * TP * 64;
__device__ __forceinline__ void kvstage_phase(Frame& F) {
    bf16_t* KS = WSP(bf16_t, WS_KVS); const float* winp = WSP(float, WS_WINP);
    for (int it = F.gw; it < 16 * 64 * 4; it += F.NGW) { const int which = it & 3, blk = (it >> 2) & 63, bk = it >> 8, b = bk >> 2, kvh = bk & 3;
        const float* src; size_t pitch;
        if (which < 2) { src = F.out + O_PCS + ((size_t)(b * TP + blk * 64) * 4 + 2 + which) * 256 + kvh * 64; pitch = 1024; }
        else { src = winp + (size_t)(b * TP + blk * 64) * 512 + (which - 2) * 256 + kvh * 64; pitch = 512; }
        bf16_t* dst = KS + (size_t)which * KVB + ((size_t)bk * TP + blk * 64) * 64;
        if ((which & 1) == 0) { const float* rp = src + (size_t)F.lane * pitch; u32x4 w[8];
#pragma unroll
            for (int c = 0; c < 8; ++c) { const f32x4 a = *(const f32x4*)(rp + c * 8), bq = *(const f32x4*)(rp + c * 8 + 4); w[c].x = pk2(a.x, a.y); w[c].y = pk2(a.z, a.w); w[c].z = pk2(bq.x, bq.y); w[c].w = pk2(bq.z, bq.w); }
#pragma unroll
            for (int c = 0; c < 8; ++c) *(u32x4*)(dst + (size_t)F.lane * 64 + c * 8) = w[c];
        } else { float v[64];
#pragma unroll
            for (int k = 0; k < 64; ++k) v[k] = src[(size_t)k * pitch + F.lane];
#pragma unroll
            for (int c = 0; c < 8; ++c) { u32x4 w;
                const int kb = 16 * (c >> 1) + 4 * (c & 1);
                w.x = pk2(v[kb + 0], v[kb + 1]); w.y = pk2(v[kb + 2], v[kb + 3]); w.z = pk2(v[kb + 8], v[kb + 9]); w.w = pk2(v[kb + 10], v[kb + 11]);
                *(u32x4*)(dst + (size_t)F.lane * 64 + c * 8) = w; } }
    }
}

typedef __bf16 bf16x2v __attribute__((ext_vector_type(2)));
typedef float f32x16 __attribute__((ext_vector_type(16)));
#define MFMA32(a, b, c) __builtin_amdgcn_mfma_f32_32x32x16_bf16((a), (b), (c), 0, 0, 0)
__device__ __forceinline__ unsigned cvtpk(float a, float b) { f32x2 v; v.x = a; v.y = b; return __builtin_bit_cast(unsigned, __builtin_convertvector(v, bf16x2v)); }
template <int S> __device__ __forceinline__ bf16x8 pack8(const f32x16& x) { u32x4 p; p.x = cvtpk(x[8 * S], x[8 * S + 1]); p.y = cvtpk(x[8 * S + 2], x[8 * S + 3]); p.z = cvtpk(x[8 * S + 4], x[8 * S + 5]); p.w = cvtpk(x[8 * S + 6], x[8 * S + 7]); return __builtin_bit_cast(bf16x8, p); }
__device__ __forceinline__ void xchg32(float v, float& lo, float& hi) { const auto r = __builtin_amdgcn_permlane32_swap(__builtin_bit_cast(unsigned, v), __builtin_bit_cast(unsigned, v), false, false); lo = __builtin_bit_cast(float, r[0]); hi = __builtin_bit_cast(float, r[1]); }
constexpr int AP_KB = 64 * 128, AP_BUF = 2 * AP_KB, AP_IMPG = 2 * AP_BUF, AP_SELM = AP_IMPG + 4 * 64 * 65 * 4, AP_UNI = AP_SELM + 512, AP_PARK = AP_IMPG, AP_QF = AP_UNI + 64, AP_GATE = 133120;
constexpr float LOG2E = 1.4426950408889634f;
__device__ __forceinline__ void tile_dma(const bf16_t* kg, const bf16_t* vg, LAS unsigned char* buf, int wave, int lane) {
    const int row = wave * 8 + (lane >> 3), cs = (lane & 7) ^ ((row >> 1) & 7), off = row * 128 + cs * 16;
    __builtin_amdgcn_global_load_lds((const unsigned*)((const char*)kg + off), (LAS unsigned*)(buf + wave * 1024), 16, 0, 0);
    __builtin_amdgcn_global_load_lds((const unsigned*)((const char*)vg + off), (LAS unsigned*)(buf + AP_KB + wave * 1024), 16, 0, 0);
}
#define TILE_SYNC() do { asm volatile("s_waitcnt vmcnt(0)" ::: "memory"); __syncthreads(); } while (0)
__device__ __forceinline__ void ap_scores(f32x16 (&sc)[2], const LAS unsigned char* kb, const LAS unsigned char* qf, const int ka0) {
    bf16x8 qv[4];
#pragma unroll
    for (int ds = 0; ds < 4; ++ds) qv[ds] = *(const LAS bf16x8*)(qf + ds * 1024);
#pragma unroll
    for (int kt = 0; kt < 2; ++kt) {
#pragma unroll
        for (int i = 0; i < 16; ++i) sc[kt][i] = 0.f;
#pragma unroll
        for (int ds = 0; ds < 4; ++ds) { const bf16x8 a = *(const LAS bf16x8*)(kb + kt * 4096 + (ka0 ^ (ds * 32))); sc[kt] = MFMA32(a, qv[ds], sc[kt]); }
        if (kt == 0) __builtin_amdgcn_sched_barrier(0); }
}
template <bool EDGE> __device__ __forceinline__ void ap_bias(f32x16 (&sc)[2], float bs, float b0, int lo, int hi, int h) {
    const float bh = bs * (float)(4 * h) + b0; const int lo2 = lo - 4 * h, hi2 = hi - 4 * h;
#pragma unroll
    for (int kt = 0; kt < 2; ++kt)
#pragma unroll
        for (int i = 0; i < 16; ++i) { const int c = 32 * kt + (i & 3) + 8 * (i >> 2); float x = sc[kt][i] + (bs * (float)c + bh);
            if (EDGE) x = (c >= lo2 && c <= hi2) ? x : -1e30f; sc[kt][i] = x; }
}
struct ApSt { f32x16 o0, o1; float m, l; };
__device__ __forceinline__ void ap_pv(f32x16& o0, f32x16& o1, const f32x16 (&p)[2], const LAS unsigned char* vb, const int ka0) {
    asm volatile("" ::: "memory");
    bf16x8 pf[4]; pf[0] = pack8<0>(p[0]); pf[1] = pack8<1>(p[0]); pf[2] = pack8<0>(p[1]); pf[3] = pack8<1>(p[1]);
#pragma unroll
    for (int ks = 0; ks < 4; ++ks) { const bf16x8 v0 = *(const LAS bf16x8*)(vb + (ka0 ^ (ks * 32))), v1 = *(const LAS bf16x8*)(vb + 4096 + (ka0 ^ (ks * 32)));
        o0 = MFMA32(v0, pf[ks], o0); o1 = MFMA32(v1, pf[ks], o1); }
}
template <bool EDGE> __device__ __forceinline__ void ap_online(ApSt& st, const LAS unsigned char* buf, const LAS unsigned char* qf, float bs, float b0, int lo, int hi, const int ka0, int h) {
    f32x16 sc[2]; ap_scores(sc, buf, qf, ka0); ap_bias<EDGE>(sc, bs, b0, lo, hi, h);
    float tm = -1e30f;
#pragma unroll
    for (int kt = 0; kt < 2; ++kt)
#pragma unroll
        for (int i = 0; i < 16; ++i) tm = fmaxf(tm, sc[kt][i]);
    tm = fmaxf(tm, shflx(tm, 32));
    const float mn = fmaxf(st.m, tm), mu = fmaxf(mn, -1e29f), corr = __builtin_amdgcn_exp2f(st.m - mn); float rs = 0.f;
#pragma unroll
    for (int kt = 0; kt < 2; ++kt)
#pragma unroll
        for (int i = 0; i < 16; ++i) { const float p = __builtin_amdgcn_exp2f(sc[kt][i] - mu); sc[kt][i] = p; rs += p; }
    rs += shflx(rs, 32);
    st.l = st.l * corr + rs; st.m = mn; st.o0 = st.o0 * corr; st.o1 = st.o1 * corr;
    ap_pv(st.o0, st.o1, sc, buf + AP_KB, ka0);
}
__device__ __forceinline__ void attp_phase(Frame& F, int l) {
    const bf16_t* QB = WSP(bf16_t, WS_QB); const float* QG = WSP(float, WS_QG); bf16_t* AO = WSP(bf16_t, WS_AO);
    const bf16_t* KS = WSP(bf16_t, WS_KVS); const bf16_t* VST = KS + KVB; const bf16_t* KW = KS + 2 * KVB; const bf16_t* VWT = KS + 3 * KVB;
    const bf16_t* KCB = WSP(bf16_t, WS_KCB); const bf16_t* VCT = KCB + (size_t)16 * 256 * 64;
    LAS unsigned char* lds = F.lds; LAS float* IMPG = (LAS float*)(lds + AP_IMPG); LAS unsigned long long* SELM = (LAS unsigned long long*)(lds + AP_SELM); LAS unsigned long long* UNI = (LAS unsigned long long*)(lds + AP_UNI);
    const int nun_ = F.G == 256 ? 2 : (512 + F.G - 1) / F.G;
    for (int r_ = 0; r_ < nun_; ++r_) { const int u = F.G == 256 ? (2 * (F.bx & 7) + r_) * 32 + (F.bx >> 3) : F.bx + r_ * F.G; if (u >= 512) break;
#pragma unroll 1
        for (int mem = 0; mem < 2; ++mem) {
            int wv_ = F.wave; asm volatile("" : "+v"(wv_)); const int w = __builtin_amdgcn_readfirstlane(wv_), g = w >> 1, qh = w & 1;
            int lane_; asm volatile("v_mbcnt_lo_u32_b32 %0, -1, 0\n\tv_mbcnt_hi_u32_b32 %0, -1, %0" : "=v"(lane_));
            const int lane = lane_, tid = w * 64 + lane, r = lane & 31, h = lane >> 5, q = qh * 32 + r;
            const int bk = u >> 5, ii = u & 31, i = mem ? 63 - ii : ii, b = bk >> 2, kvh = bk & 3, t0 = 64 * i, tpos = t0 + q, head = kvh * 4 + g; const size_t m = (size_t)b * TP + tpos;
            LAS unsigned char* qf = lds + AP_QF + w * 4096 + lane * 16;
#pragma unroll
            for (int ds = 0; ds < 4; ++ds) *(LAS bf16x8*)(qf + ds * 1024) = *(const bf16x8*)(QB + m * D + head * 64 + ds * 16 + h * 8);
            const float slope2 = exp2f(-0.5f * (float)(head + 1)) * LOG2E;
            const float gq0 = QG[m * NQI + 1024 + head * 3], gq1 = QG[m * NQI + 1024 + head * 3 + 1], gq2 = QG[m * NQI + 1024 + head * 3 + 2]; LAS float* gsl = (LAS float*)(lds + AP_GATE) + tid;
            LAS float* park = (LAS float*)(lds + AP_PARK) + tid;
            const int ka0 = r * 128 + ((h ^ ((r >> 1) & 7)) << 4);
            const int nct = (4 * i + 3 + 63) >> 6; const int hic = (tpos - 31) >> 4;
            const bf16_t* kc = KCB + (size_t)bk * 256 * 64; const bf16_t* vc = VCT + (size_t)bk * 256 * 64;
            float cm = -1e30f, cl = 0.f;
            tile_dma(kc, vc, lds, w, lane); TILE_SYNC();
            gsl[0] = gq0; gsl[512] = gq1; gsl[1024] = gq2;
            for (int T = 0; T < nct; ++T) { LAS unsigned char* buf = lds + (T & 1) * AP_BUF;
                if (T + 1 < nct) tile_dma(kc + (size_t)(T + 1) * 4096, vc + (size_t)(T + 1) * 4096, lds + ((T + 1) & 1) * AP_BUF, w, lane);
                f32x16 sc[2]; ap_scores(sc, buf, qf, ka0); ap_bias<true>(sc, slope2 * 16.f, slope2 * (float)(1024 * T + 31 - t0), 0, hic - 64 * T, h);
                float tm = -1e30f;
#pragma unroll
                for (int kt = 0; kt < 2; ++kt)
#pragma unroll
                    for (int e = 0; e < 16; ++e) tm = fmaxf(tm, sc[kt][e]);
                tm = fmaxf(tm, shflx(tm, 32));
                const float mn = fmaxf(cm, tm), mu = fmaxf(mn, -1e29f); float rs = 0.f;
#pragma unroll
                for (int kt = 0; kt < 2; ++kt)
#pragma unroll
                    for (int e = 0; e < 16; ++e) rs += __builtin_amdgcn_exp2f(sc[kt][e] - mu);
                rs += shflx(rs, 32);
                cl = cl * __builtin_amdgcn_exp2f(cm - mn) + rs; cm = mn;
                TILE_SYNC(); }
            f32x16 o0, o1;
            { const float cmu = fmaxf(cm, -1e29f), cinv = cl > 0.f ? 1.0f / cl : 0.f;
#pragma unroll
              for (int e = 0; e < 16; ++e) { o0[e] = 0.f; o1[e] = 0.f; }
              float carry = 0.f;
              tile_dma(kc, vc, lds, w, lane); TILE_SYNC();
              for (int T = 0; T < nct; ++T) { LAS unsigned char* buf = lds + (T & 1) * AP_BUF;
                  if (T + 1 < nct) tile_dma(kc + (size_t)(T + 1) * 4096, vc + (size_t)(T + 1) * 4096, lds + ((T + 1) & 1) * AP_BUF, w, lane);
                  f32x16 sc[2]; ap_scores(sc, buf, qf, ka0); ap_bias<true>(sc, slope2 * 16.f, slope2 * (float)(1024 * T + 31 - t0), 0, hic - 64 * T, h);
#pragma unroll
                  for (int kt = 0; kt < 2; ++kt)
#pragma unroll
                      for (int e = 0; e < 16; ++e) sc[kt][e] = __builtin_amdgcn_exp2f(sc[kt][e] - cmu) * cinv;
#pragma unroll
                  for (int kt = 0; kt < 2; ++kt) { float gs[4], xl[4];
#pragma unroll
                      for (int a = 0; a < 4; ++a) { gs[a] = (sc[kt][4 * a] + sc[kt][4 * a + 1]) + (sc[kt][4 * a + 2] + sc[kt][4 * a + 3]); xl[a] = shflx(sc[kt][4 * a + 3], 32); }
                      float val[4];
                      if (h) {
#pragma unroll
                          for (int a = 0; a < 4; ++a) val[a] = gs[a] + xl[a];
                      } else { val[0] = gs[0] + carry; val[1] = gs[1] + xl[0]; val[2] = gs[2] + xl[1]; val[3] = gs[3] + xl[2]; carry = xl[3]; }
#pragma unroll
                      for (int a = 0; a < 4; ++a) { const int blk = 16 * T + 8 * kt + 2 * a + h; IMPG[(g * 64 + q) * 65 + blk] = val[a]; } }
                  ap_pv(o0, o1, sc, buf + AP_KB, ka0);
                  TILE_SYNC(); }
            }
            { unsigned long long uni = 0ull;
#pragma unroll 1
              for (int qq = 0; qq < 8; ++qq) { const int q2 = w * 8 + qq; float val;
                  { const float imp = lane <= i ? ((IMPG[(0 * 64 + q2) * 65 + lane] + IMPG[(1 * 64 + q2) * 65 + lane]) + (IMPG[(2 * 64 + q2) * 65 + lane] + IMPG[(3 * 64 + q2) * 65 + lane])) : 0.f;
                    const bool forced = lane == 0 || lane == i || lane == i - 1; val = lane <= i ? (forced ? 1e4f : imp) : -1.f; }
                  int rank = 0;
                  for (int s2 = 0; s2 < 64; ++s2) { const float v2 = __builtin_bit_cast(float, __builtin_amdgcn_readlane(__builtin_bit_cast(int, val), s2)); rank += (v2 > val || (v2 == val && s2 < lane)) ? 1 : 0; }
                  const unsigned long long sm = __ballot(rank < 16 && lane <= i); uni |= sm; if (lane == 0) SELM[q2] = sm; }
              if (lane == 0) UNI[w] = uni; }
            __syncthreads();
            { const float g0 = gsl[0];
#pragma unroll
              for (int e = 0; e < 16; ++e) { park[e * 512] = o0[e] * g0; park[(16 + e) * 512] = o1[e] * g0; } }
            unsigned long long uni = 0ull;
#pragma unroll
            for (int ww = 0; ww < 8; ++ww) uni |= UNI[ww];
            uni = ((unsigned long long)__builtin_amdgcn_readfirstlane((unsigned)(uni >> 32)) << 32) | (unsigned)__builtin_amdgcn_readfirstlane((unsigned)uni);
            { ApSt st;
#pragma unroll
              for (int e = 0; e < 16; ++e) { st.o0[e] = 0.f; st.o1[e] = 0.f; }
              st.m = -1e30f; st.l = 0.f;
              const bf16_t* kg = KS + (size_t)bk * TP * 64; const bf16_t* vg = VST + (size_t)bk * TP * 64;
              unsigned long long rem = uni; int s = __builtin_ctzll(rem); rem &= rem - 1; int par = 0;
              tile_dma(kg + (size_t)s * 4096, vg + (size_t)s * 4096, lds, w, lane); TILE_SYNC();
              for (;;) { const int sn = rem ? __builtin_ctzll(rem) : -1; LAS unsigned char* buf = lds + par * AP_BUF;
                  if (sn >= 0) tile_dma(kg + (size_t)sn * 4096, vg + (size_t)sn * 4096, lds + (par ^ 1) * AP_BUF, w, lane);
                  const float b0 = ((SELM[q] >> s) & 1ull) ? slope2 * (float)(64 * s - t0) : -1e30f;
                  if (s == i) ap_online<true>(st, buf, qf, slope2, b0, 0, tpos - 64 * s, ka0, h); else ap_online<false>(st, buf, qf, slope2, b0, 0, 63, ka0, h);
                  if (sn < 0) break;
                  TILE_SYNC(); par ^= 1; s = sn; rem &= rem - 1; }
              __syncthreads();
              const float sc1 = gsl[512] / st.l;
#pragma unroll
              for (int e = 0; e < 16; ++e) { park[e * 512] += st.o0[e] * sc1; park[(16 + e) * 512] += st.o1[e] * sc1; } }
            { ApSt st;
#pragma unroll
              for (int e = 0; e < 16; ++e) { st.o0[e] = 0.f; st.o1[e] = 0.f; }
              st.m = -1e30f; st.l = 0.f;
              const bf16_t* kg = KW + (size_t)bk * TP * 64; const bf16_t* vg = VWT + (size_t)bk * TP * 64;
              const int wb0 = i >= 8 ? i - 8 : 0;
              tile_dma(kg + (size_t)wb0 * 4096, vg + (size_t)wb0 * 4096, lds, w, lane); TILE_SYNC();
              for (int wb = wb0; wb <= i; ++wb) { LAS unsigned char* buf = lds + ((wb - wb0) & 1) * AP_BUF;
                  if (wb < i) tile_dma(kg + (size_t)(wb + 1) * 4096, vg + (size_t)(wb + 1) * 4096, lds + ((wb + 1 - wb0) & 1) * AP_BUF, w, lane);
                  const float b0 = slope2 * (float)(64 * wb - t0);
                  if (wb == i || wb == i - 8) ap_online<true>(st, buf, qf, slope2, b0, tpos - 512 - 64 * wb, tpos - 64 * wb, ka0, h); else ap_online<false>(st, buf, qf, slope2, b0, 0, 63, ka0, h);
                  TILE_SYNC(); }
              const float sc2 = gsl[1024] / st.l;
#pragma unroll
              for (int e = 0; e < 16; ++e) { st.o0[e] = park[e * 512] + st.o0[e] * sc2; st.o1[e] = park[(16 + e) * 512] + st.o1[e] * sc2; }
              int lane2; asm volatile("v_mbcnt_lo_u32_b32 %0, -1, 0\n\tv_mbcnt_hi_u32_b32 %0, -1, %0" : "=v"(lane2));
              const int h2 = lane2 >> 5; const size_t m2 = (size_t)b * TP + t0 + qh * 32 + (lane2 & 31);
              bf16_t* orow = AO + m2 * D + head * 64 + 4 * h2;
#pragma unroll
              for (int a = 0; a < 4; ++a) { u32x2 w0, w1; w0.x = cvtpk(st.o0[4 * a], st.o0[4 * a + 1]); w0.y = cvtpk(st.o0[4 * a + 2], st.o0[4 * a + 3]); w1.x = cvtpk(st.o1[4 * a], st.o1[4 * a + 1]); w1.y = cvtpk(st.o1[4 * a + 2], st.o1[4 * a + 3]);
                  *(u32x2*)(orow + 8 * a) = w0; *(u32x2*)(orow + 32 + 8 * a) = w1; } }
        }
    }
}

#define MFMA16(a, b, c) __builtin_amdgcn_mfma_f32_16x16x32_bf16((a), (b), (c), 0, 0, 0)
__device__ __forceinline__ bf16x8 cvt8(const f32x4 a, const f32x4 b) { u32x4 p; p.x = cvtpk(a.x, a.y); p.y = cvtpk(a.z, a.w); p.z = cvtpk(b.x, b.y); p.w = cvtpk(b.z, b.w); return __builtin_bit_cast(bf16x8, p); }
struct S2K { f32x4 a[4][2], b[4][2]; };
struct S2V { float v[2][4][8]; };
__device__ __forceinline__ void s2_ldk(S2K& K, const float* kb, int kp, int kmax, int r16, int g4) {
#pragma unroll
    for (int kt = 0; kt < 4; ++kt) { const int key = min(16 * kt + r16, kmax); const float* row = kb + (size_t)key * kp + 8 * g4;
#pragma unroll
        for (int ds = 0; ds < 2; ++ds) { K.a[kt][ds] = *(const f32x4*)(row + 32 * ds); K.b[kt][ds] = *(const f32x4*)(row + 32 * ds + 4); } }
}
__device__ __forceinline__ void s2_ldv(S2V& V, const float* vb, int kp, int kmax, int r16, int g4) {
#pragma unroll
    for (int pr = 0; pr < 2; ++pr)
#pragma unroll
        for (int j = 0; j < 8; ++j) { const int key = min(16 * (2 * pr + (j >> 2)) + 4 * g4 + (j & 3), kmax); const float* row = vb + (size_t)key * kp + r16;
#pragma unroll
            for (int dt = 0; dt < 4; ++dt) V.v[pr][dt][j] = row[16 * dt]; }
}
__device__ __forceinline__ void s2_scores_r(f32x4 (&sc)[4], const S2K& K, const bf16x8 (&qf)[2]) {
#pragma unroll
    for (int kt = 0; kt < 4; ++kt) { sc[kt] = (f32x4){0.f, 0.f, 0.f, 0.f};
#pragma unroll
        for (int ds = 0; ds < 2; ++ds) sc[kt] = MFMA16(cvt8(K.a[kt][ds], K.b[kt][ds]), qf[ds], sc[kt]); }
}
__device__ __forceinline__ void s2_pv_r(f32x4 (&o)[4], const f32x4 (&p)[4], const S2V& V) {
#pragma unroll
    for (int pr = 0; pr < 2; ++pr) { u32x4 pw; pw.x = cvtpk(p[2 * pr][0], p[2 * pr][1]); pw.y = cvtpk(p[2 * pr][2], p[2 * pr][3]); pw.z = cvtpk(p[2 * pr + 1][0], p[2 * pr + 1][1]); pw.w = cvtpk(p[2 * pr + 1][2], p[2 * pr + 1][3]);
        const bf16x8 pf = __builtin_bit_cast(bf16x8, pw);
#pragma unroll
        for (int dt = 0; dt < 4; ++dt) { const float (&v)[8] = V.v[pr][dt];
            u32x4 vw; vw.x = cvtpk(v[0], v[1]); vw.y = cvtpk(v[2], v[3]); vw.z = cvtpk(v[4], v[5]); vw.w = cvtpk(v[6], v[7]);
            o[dt] = MFMA16(__builtin_bit_cast(bf16x8, vw), pf, o[dt]); } }
}
struct S2St { f32x4 o[4]; float m, l; };
__device__ __forceinline__ void s2_online(S2St& st, const float* kb, const float* vb, int kp, int kmax, const bf16x8 (&qf)[2], float slope2, int pos0, bool rowok, int lo, int hi, int r16, int g4) {
    S2K K; S2V V; s2_ldk(K, kb, kp, kmax, r16, g4); s2_ldv(V, vb, kp, kmax, r16, g4); __builtin_amdgcn_sched_barrier(0);
    f32x4 sc[4]; s2_scores_r(sc, K, qf);
    float tm = -1e30f;
#pragma unroll
    for (int kt = 0; kt < 4; ++kt)
#pragma unroll
        for (int i = 0; i < 4; ++i) { const int pos = pos0 + 16 * kt + 4 * g4 + i; const bool ok = rowok && pos >= lo && pos <= hi; const float x = ok ? sc[kt][i] + slope2 * (float)(pos - PAST) : -1e30f; sc[kt][i] = x; tm = fmaxf(tm, x); }
    tm = fmaxf(tm, shflx(tm, 16)); tm = fmaxf(tm, shflx(tm, 32));
    const float mn = fmaxf(st.m, tm), mu = fmaxf(mn, -1e29f), corr = __builtin_amdgcn_exp2f(st.m - mn); float rs = 0.f;
#pragma unroll
    for (int kt = 0; kt < 4; ++kt)
#pragma unroll
        for (int i = 0; i < 4; ++i) { const float p = __builtin_amdgcn_exp2f(sc[kt][i] - mu); sc[kt][i] = p; rs += p; }
    rs += shflx(rs, 16); rs += shflx(rs, 32);
    st.l = st.l * corr + rs; st.m = mn;
#pragma unroll
    for (int dt = 0; dt < 4; ++dt) st.o[dt] = st.o[dt] * corr;
    s2_pv_r(st.o, sc, V);
}
__device__ __forceinline__ void atts2_phase(Frame& F, int l) {
    const float* QG = WSP(float, WS_QG); bf16_t* AO = WSP(bf16_t, WS_AO); const float* KC = WSP(float, WS_KCMP); const float* VC = KC + (size_t)CROWS * 64;
    const float* cache = INF(2); const float* cwin = INF(3); const int* pt = (const int*)F.in[6];
    const int team = F.wave >> 2, mem = F.wave & 3;
    LAS unsigned char* tl = F.lds + team * 49152;
    LAS float* GS = (LAS float*)tl; LAS float* LS = GS + 16 * 33; LAS unsigned long long* MS = (LAS unsigned long long*)(tl + 6144);
    LAS float* WINP = (LAS float*)(tl + 30720);
    LAS float* SLCP = (LAS float*)(tl + 12288);
    for (int item = F.bx * 2 + team; item < NBS * NKV; item += F.G * 2) { const int b = item >> 2, kvh = item & 3;
        int lane_; asm volatile("v_mbcnt_lo_u32_b32 %0, -1, 0\n\tv_mbcnt_hi_u32_b32 %0, -1, %0" : "=v"(lane_)); const int lane = lane_, r16 = lane & 15, g4 = lane >> 4, g = r16 >> 2, t = r16 & 3, head = kvh * 4 + g, tpos = PAST + t;
        const size_t mrow = (size_t)MP + b * TS + t; const float slope2 = exp2f(-0.5f * (float)(head + 1)) * LOG2E;
        bf16x8 qf[2];
#pragma unroll
        for (int ds = 0; ds < 2; ++ds) { const float* qp = QG + mrow * NQI + head * 64 + 32 * ds + 8 * g4; const f32x4 a = *(const f32x4*)qp * LOG2E, bq = *(const f32x4*)(qp + 4) * LOG2E; qf[ds] = cvt8(a, bq); }
        f32x4 oacc[4];
#pragma unroll
        for (int dt = 0; dt < 4; ++dt) oacc[dt] = (f32x4){0.f, 0.f, 0.f, 0.f};
        if (mem == 0) {
            const float* kc = KC + (size_t)(b * 4 + kvh) * 128 * 64; const float* vc = VC + (size_t)(b * 4 + kvh) * 128 * 64;
            float cm = -1e30f, cl = 0.f;
#pragma unroll 1
            for (int T = 0; T < 2; ++T) { f32x4 sc[4]; { S2K K; s2_ldk(K, kc + (size_t)T * 64 * 64, 64, 63, r16, g4); __builtin_amdgcn_sched_barrier(0); s2_scores_r(sc, K, qf); } float tm = -1e30f;
#pragma unroll
                for (int kt = 0; kt < 4; ++kt)
#pragma unroll
                    for (int i = 0; i < 4; ++i) { const int n = 64 * T + 16 * kt + 4 * g4 + i; const float x = n <= 126 ? sc[kt][i] + slope2 * (float)(16 * n + 31 - PAST) : -1e30f; sc[kt][i] = x; tm = fmaxf(tm, x); }
                tm = fmaxf(tm, shflx(tm, 16)); tm = fmaxf(tm, shflx(tm, 32)); const float mn = fmaxf(cm, tm); float rs = 0.f;
#pragma unroll
                for (int kt = 0; kt < 4; ++kt)
#pragma unroll
                    for (int i = 0; i < 4; ++i) rs += __builtin_amdgcn_exp2f(sc[kt][i] - mn);
                rs += shflx(rs, 16); rs += shflx(rs, 32); cl = cl * __builtin_amdgcn_exp2f(cm - mn) + rs; cm = mn; }
            const float cinv = 1.0f / cl;
#pragma unroll 1
            for (int T = 0; T < 2; ++T) { f32x4 sc[4]; S2V V; { S2K K; s2_ldk(K, kc + (size_t)T * 64 * 64, 64, 63, r16, g4); s2_ldv(V, vc + (size_t)T * 64 * 64, 64, 63, r16, g4); __builtin_amdgcn_sched_barrier(0); s2_scores_r(sc, K, qf); }
#pragma unroll
                for (int kt = 0; kt < 4; ++kt) { float gs = 0.f;
#pragma unroll
                    for (int i = 0; i < 4; ++i) { const int n = 64 * T + 16 * kt + 4 * g4 + i; const float p = n <= 126 ? __builtin_amdgcn_exp2f(sc[kt][i] + slope2 * (float)(16 * n + 31 - PAST) - cm) * cinv : 0.f; sc[kt][i] = p; gs += p; }
                    const int blk = 16 * T + 4 * kt + g4; GS[r16 * 33 + blk] = gs; LS[r16 * 33 + blk] = sc[kt][3]; }
                s2_pv_r(oacc, sc, V); }
            const float g0 = QG[mrow * NQI + 1024 + head * 3];
#pragma unroll
            for (int dt = 0; dt < 4; ++dt) oacc[dt] = oacc[dt] * g0;
            asm volatile("s_waitcnt lgkmcnt(0)" ::: "memory");
            unsigned long long uni = 0ull;
#pragma unroll 1
            for (int tq = 0; tq < 4; ++tq) { float imp = 0.f;
                if (lane < 33) {
#pragma unroll
                    for (int gg = 0; gg < 4; ++gg) { const int row = gg * 4 + tq; imp += (lane < 32 ? GS[row * 33 + lane] : 0.f) + (lane > 0 ? LS[row * 33 + lane - 1] : 0.f); } }
                const bool forced = lane == 0 || lane == 32 || lane == 31; const float val = lane >= 33 ? -2.f : (forced ? 1e4f : imp);
                int rank = 0;
                for (int s2 = 0; s2 < 64; ++s2) { const float v2 = __builtin_bit_cast(float, __builtin_amdgcn_readlane(__builtin_bit_cast(int, val), s2)); rank += (v2 > val || (v2 == val && s2 < lane)) ? 1 : 0; }
                const unsigned long long sm = __ballot(rank < 16 && lane < 33); uni |= sm; if (lane == 0) MS[tq] = sm; }
            if (lane == 0) MS[4] = uni;
        } else {
            S2St st; st.m = -1e30f; st.l = 0.f;
#pragma unroll
            for (int dt = 0; dt < 4; ++dt) st.o[dt] = (f32x4){0.f, 0.f, 0.f, 0.f};
#pragma unroll 1
            for (int wt = 3 * (mem - 1); wt < 3 * mem; ++wt) { const float* kb; int kmax;
                if (wt < 8) { kb = cwin + ((size_t)b * 512 + 64 * wt) * 512 + kvh * 64; kmax = 63; } else { kb = F.out + O_SWIN + ((size_t)b * 512 + 508) * 512 + kvh * 64; kmax = TS - 1; }
                s2_online(st, kb, kb + 256, 512, kmax, qf, slope2, PAST - 512 + 64 * wt, true, tpos - 512, tpos, r16, g4); }
            LAS float* wp = WINP + ((mem - 1) * 64 + lane) * 18;
#pragma unroll
            for (int dt = 0; dt < 4; ++dt)
#pragma unroll
                for (int i = 0; i < 4; ++i) wp[dt * 4 + i] = st.o[dt][i];
            wp[16] = st.m; wp[17] = st.l;
        }
        asm volatile("s_waitcnt lgkmcnt(0)" ::: "memory"); __syncthreads();
        { const int my = mem; const unsigned long long selq = MS[t]; unsigned long long uni = MS[4];
            uni = ((unsigned long long)__builtin_amdgcn_readfirstlane((unsigned)(uni >> 32)) << 32) | (unsigned)__builtin_amdgcn_readfirstlane((unsigned)uni);
            S2St st; st.m = -1e30f; st.l = 0.f;
#pragma unroll
            for (int dt = 0; dt < 4; ++dt) st.o[dt] = (f32x4){0.f, 0.f, 0.f, 0.f};
            int n = 0;
#pragma unroll 1
            for (unsigned long long rem = uni; rem; rem &= rem - 1, ++n) { if ((n & 3) != my) continue; const int s = __builtin_ctzll(rem); const float* kb; int kmax;
                if (s < 32) { const int page = pt[b * NPG + (s >> 1)]; kb = cache + (((size_t)page * PAGE + (s & 1) * 64) * 4 + 2) * 256 + kvh * 64; kmax = 63; }
                else { kb = F.out + O_SCS + (((size_t)b * TS) * 4 + 2) * 256 + kvh * 64; kmax = TS - 1; }
                s2_online(st, kb, kb + 256, 1024, kmax, qf, slope2, 64 * s, ((selq >> s) & 1ull) != 0ull, 0, tpos, r16, g4); }
            LAS float* sp = SLCP + (my * 64 + lane) * 18;
#pragma unroll
            for (int dt = 0; dt < 4; ++dt)
#pragma unroll
                for (int i = 0; i < 4; ++i) sp[dt * 4 + i] = st.o[dt][i];
            sp[16] = st.m; sp[17] = st.l; }
        asm volatile("s_waitcnt lgkmcnt(0)" ::: "memory"); __syncthreads();
        if (mem == 0) {
            float mm[4], ll[4]; float M = -1e30f;
#pragma unroll
            for (int x = 0; x < 4; ++x) { mm[x] = SLCP[(x * 64 + lane) * 18 + 16]; ll[x] = SLCP[(x * 64 + lane) * 18 + 17]; M = fmaxf(M, mm[x]); }
            float L = 0.f, sc[4];
#pragma unroll
            for (int x = 0; x < 4; ++x) { sc[x] = __builtin_amdgcn_exp2f(mm[x] - M); L += ll[x] * sc[x]; }
            const float g1 = QG[mrow * NQI + 1024 + head * 3 + 1] / L;
            float wm[3], wl[3]; float MW = -1e30f;
#pragma unroll
            for (int x = 0; x < 3; ++x) { wm[x] = WINP[(x * 64 + lane) * 18 + 16]; wl[x] = WINP[(x * 64 + lane) * 18 + 17]; MW = fmaxf(MW, wm[x]); }
            float LW = 0.f, wsc[3];
#pragma unroll
            for (int x = 0; x < 3; ++x) { wsc[x] = __builtin_amdgcn_exp2f(wm[x] - MW); LW += wl[x] * wsc[x]; }
            const float g2 = QG[mrow * NQI + 1024 + head * 3 + 2] / LW;
#pragma unroll
            for (int dt = 0; dt < 4; ++dt) { f32x4 acc = oacc[dt];
#pragma unroll
                for (int x = 0; x < 3; ++x) { const LAS float* wq = WINP + (x * 64 + lane) * 18 + dt * 4; acc = acc + (f32x4){wq[0], wq[1], wq[2], wq[3]} * (wsc[x] * g2); }
#pragma unroll
                for (int x = 0; x < 4; ++x) { const LAS float* sp = SLCP + (x * 64 + lane) * 18 + dt * 4; acc = acc + (f32x4){sp[0], sp[1], sp[2], sp[3]} * (sc[x] * g1); }
                u32x2 w; w.x = cvtpk(acc[0], acc[1]); w.y = cvtpk(acc[2], acc[3]); *(u32x2*)(AO + mrow * D + head * 64 + 16 * dt + 4 * g4) = w; } }
        asm volatile("s_waitcnt lgkmcnt(0)" ::: "memory"); __syncthreads();
    }
}

struct AttSt { float m[4], l[4], o[4]; };
__device__ __forceinline__ void att_init(AttSt& st) {
#pragma unroll
    for (int g = 0; g < 4; ++g) { st.m[g] = -1e30f; st.l[g] = 0.f; st.o[g] = 0.f; } }
__device__ __forceinline__ void att_tile(AttSt& st, const float* kp, const float* vp, bool valid, float dist, const float (&slope)[4], const LAS f32x4* qs4, LAS f32x4* pb, int lane) {
    f32x4 kv[16];
#pragma unroll
    for (int c = 0; c < 16; ++c) kv[c] = ((const f32x4*)kp)[c];
    float vv[32]; const unsigned long long vpa = (unsigned long long)vp;
#pragma unroll
    for (int k = 0; k < 32; ++k) { const unsigned lo = __builtin_amdgcn_readlane((unsigned)vpa, k), hi = __builtin_amdgcn_readlane((unsigned)(vpa >> 32), k); vv[k] = ((const float*)(((unsigned long long)hi << 32) | lo))[lane]; }
    float s[4] = {0.f, 0.f, 0.f, 0.f};
#pragma unroll
    for (int c = 0; c < 16; ++c) {
#pragma unroll
        for (int g = 0; g < 4; ++g) { const f32x4 q = qs4[g * 16 + c]; s[g] += (kv[c].x * q.x + kv[c].y * q.y) + (kv[c].z * q.z + kv[c].w * q.w); }
        if ((c & 3) == 3) __builtin_amdgcn_sched_barrier(0); }
    asm volatile("" : "+v"(s[0]), "+v"(s[1]), "+v"(s[2]), "+v"(s[3]));
    f32x4 pv;
#pragma unroll
    for (int g = 0; g < 4; ++g) { const float sc = valid ? s[g] - slope[g] * dist : -1e30f; const float tm = wave_max(sc); const float mn = fmaxf(st.m[g], tm);
        const float p = valid ? __expf(sc - mn) : 0.f; const float corr = __expf(st.m[g] - mn); st.l[g] = st.l[g] * corr + wave_sum(p); st.o[g] *= corr; st.m[g] = mn; pv[g] = p; }
    pb[lane] = pv; LDS_WAIT(); asm volatile("" ::: "memory");
    float v2[32];
#pragma unroll
    for (int k = 0; k < 32; ++k) { const unsigned lo = __builtin_amdgcn_readlane((unsigned)vpa, 32 + k), hi = __builtin_amdgcn_readlane((unsigned)(vpa >> 32), 32 + k); v2[k] = ((const float*)(((unsigned long long)hi << 32) | lo))[lane]; }
#pragma unroll
    for (int k = 0; k < 32; ++k) { const f32x4 p = pb[k]; st.o[0] += p.x * vv[k]; st.o[1] += p.y * vv[k]; st.o[2] += p.z * vv[k]; st.o[3] += p.w * vv[k]; if ((k & 7) == 7) __builtin_amdgcn_sched_barrier(0); }
#pragma unroll
    for (int k = 0; k < 32; ++k) { const f32x4 p = pb[32 + k]; st.o[0] += p.x * v2[k]; st.o[1] += p.y * v2[k]; st.o[2] += p.z * v2[k]; st.o[3] += p.w * v2[k]; if ((k & 7) == 7) __builtin_amdgcn_sched_barrier(0); }
    LDS_WAIT(); asm volatile("" ::: "memory");
}
__device__ __forceinline__ void att_phase(Frame& F, int l) {
    const float* QG = WSP(float, WS_QG); bf16_t* AO = WSP(bf16_t, WS_AO); const float* KC = WSP(float, WS_KCMP); const float* VC = KC + (size_t)CROWS * 64;
    const float* cache = INF(2); const float* cwin = INF(3); const int* pt = (const int*)F.in[6]; const float* winp = WSP(float, WS_WINP);
    LAS unsigned char* wl = F.lds + F.wave * 8192;
    LAS f32x4* qs4 = (LAS f32x4*)wl;
    LAS f32x4* pb = (LAS f32x4*)(wl + 1024);
    LAS float* psum = (LAS float*)(wl + 1024 + 4096);
    const int lane = F.lane;
    const int nitems = MS * NKV;
    for (int it = F.gw; it < nitems; it += F.NGW) {
        const int m = MP + (it >> 2); const int kvh = it & 3;
        const RowInfo ri = row_info(m); const int tpos = ri.stream == 0 ? ri.t : PAST + ri.t;
        float slope[4], gate[4][3];
#pragma unroll
        for (int g = 0; g < 4; ++g) { slope[g] = exp2f(-0.5f * (float)(kvh * 4 + g + 1));
#pragma unroll
            for (int c = 0; c < 3; ++c) gate[g][c] = QG[(size_t)m * NQI + 1024 + (kvh * 4 + g) * 3 + c]; }
        { const float* qrow = QG + (size_t)m * NQI + kvh * 256; LAS float* qs = (LAS float*)qs4;
#pragma unroll
          for (int g = 0; g < 4; ++g) qs[g * 64 + lane] = qrow[g * 64 + lane]; }
        LDS_WAIT(); asm volatile("" ::: "memory");
        const float* safe = QG + (size_t)m * NQI;
        float otot[4] = {0.f, 0.f, 0.f, 0.f};
        const int ncv = tpos >= 31 ? ((tpos - 31) >> 4) + 1 : 0;
        const size_t crow0 = ri.stream == 0 ? (size_t)CROWS_S + (size_t)(ri.b * 4 + kvh) * 256 : (size_t)(ri.b * 4 + kvh) * 128;
        const int ntile_c = (ncv + 63) >> 6;
#pragma unroll
        for (int q = 0; q < 5; ++q) { const int idx = lane + 64 * q; if (idx < 264) psum[idx] = 0.f; }
        if (ncv > 0) {
            float mx[4] = {-1e30f, -1e30f, -1e30f, -1e30f};
#pragma unroll 1
            for (int tl = 0; tl < ntile_c; ++tl) { const int n = tl * 64 + lane; const bool valid = n < ncv; const float* kp = valid ? KC + (crow0 + n) * 64 : safe; float s[4] = {0.f, 0.f, 0.f, 0.f};
#pragma unroll 4
                for (int c = 0; c < 16; ++c) { const f32x4 kv = ((const f32x4*)kp)[c];
#pragma unroll
                    for (int g = 0; g < 4; ++g) { const f32x4 q = qs4[g * 16 + c]; s[g] += (kv.x * q.x + kv.y * q.y) + (kv.z * q.z + kv.w * q.w); } }
                const float dist = (float)(tpos - (16 * n + 31)); f32x4 sv;
#pragma unroll
                for (int g = 0; g < 4; ++g) { sv[g] = valid ? s[g] - slope[g] * dist : -1e30f; mx[g] = fmaxf(mx[g], sv[g]); }
                pb[n] = sv; }
            float sm[4];
#pragma unroll
            for (int g = 0; g < 4; ++g) { mx[g] = wave_max(mx[g]); sm[g] = 0.f; }
            LDS_WAIT(); asm volatile("" ::: "memory");
#pragma unroll 1
            for (int tl = 0; tl < ntile_c; ++tl) { const int n = tl * 64 + lane; const f32x4 sv = pb[n]; f32x4 p;
#pragma unroll
                for (int g = 0; g < 4; ++g) { p[g] = n < ncv ? __expf(sv[g] - mx[g]) : 0.f; sm[g] += p[g]; }
                pb[n] = p; }
#pragma unroll
            for (int g = 0; g < 4; ++g) sm[g] = 1.0f / wave_sum(sm[g]);
            LDS_WAIT(); asm volatile("" ::: "memory");
#pragma unroll 1
            for (int tl = 0; tl < ntile_c; ++tl) { const int n = tl * 64 + lane; f32x4 p = pb[n]; p.x *= sm[0]; p.y *= sm[1]; p.z *= sm[2]; p.w *= sm[3]; pb[n] = p; psum[n + 1] = (p.x + p.y) + (p.z + p.w); }
            LDS_WAIT(); asm volatile("" ::: "memory");
            float oc[4] = {0.f, 0.f, 0.f, 0.f};
#pragma unroll 4
            for (int n = 0; n < ncv; ++n) { const float vv = VC[(crow0 + n) * 64 + lane]; const f32x4 p = pb[n]; oc[0] += p.x * vv; oc[1] += p.y * vv; oc[2] += p.z * vv; oc[3] += p.w * vv; }
#pragma unroll
            for (int g = 0; g < 4; ++g) otot[g] += gate[g][0] * oc[g];
        }
        LDS_WAIT(); asm volatile("" ::: "memory");
        const int cur = tpos >> 6; const int ns = ri.stream == 0 ? 64 : 33;
        float val;
        {
          float imp = 0.f; if (lane < ns) { imp = ((psum[4 * lane] + psum[4 * lane + 1]) + (psum[4 * lane + 2] + psum[4 * lane + 3])) + psum[4 * lane + 4]; }
          const bool forced = lane == 0 || lane == cur || lane == cur - 1;
          val = lane >= ns ? -2.f : (lane <= cur ? (forced ? 1e4f : imp) : -1.f); }
        int rank = 0;
        for (int s2 = 0; s2 < 64; ++s2) { const float v2 = __builtin_bit_cast(float, __builtin_amdgcn_readlane(__builtin_bit_cast(int, val), s2)); rank += (v2 > val || (v2 == val && s2 < lane)) ? 1 : 0; }
        const unsigned long long selmask = __ballot(rank < 16 && lane <= cur && lane < ns);
        { AttSt st; att_init(st);
          for (unsigned long long mm = selmask; mm; mm &= mm - 1) { const int s = __builtin_ctzll(mm); const int pos = s * 64 + lane; const bool valid = pos <= tpos;
              const float *kp = safe, *vp = safe;
              if (valid) { if (ri.stream == 0) { kp = F.out + O_PCS + (((size_t)ri.b * TP + pos) * 4 + 2) * 256 + kvh * 64; vp = kp + 256; }
                  else if (pos < PAST) { const int page = pt[ri.b * NPG + (pos >> 7)]; kp = cache + (((size_t)page * PAGE + (pos & 127)) * 4 + 2) * 256 + kvh * 64; vp = kp + 256; }
                  else { kp = F.out + O_SCS + (((size_t)ri.b * TS + (pos - PAST)) * 4 + 2) * 256 + kvh * 64; vp = kp + 256; } }
              att_tile(st, kp, vp, valid, (float)(tpos - pos), slope, qs4, pb, lane); }
#pragma unroll
          for (int g = 0; g < 4; ++g) otot[g] += gate[g][1] * st.o[g] / st.l[g]; }
        { AttSt st; att_init(st); const int wpos0 = ri.stream == 0 ? 0 : PAST + TS - 516; const int lo = max(tpos - 512, wpos0);
          for (int p0 = lo; p0 <= tpos; p0 += 64) { const int pos = p0 + lane; const bool valid = pos <= tpos; const float *kp = safe, *vp = safe;
              if (valid) { if (ri.stream == 0) { kp = winp + (size_t)(ri.b * TP + pos) * 512 + kvh * 64; vp = kp + 256; }
                  else if (pos < PAST) { kp = cwin + ((size_t)ri.b * 512 + (pos - wpos0)) * 512 + kvh * 64; vp = kp + 256; }
                  else { kp = F.out + O_SWIN + ((size_t)ri.b * 512 + 508 + (pos - PAST)) * 512 + kvh * 64; vp = kp + 256; } }
              att_tile(st, kp, vp, valid, (float)(tpos - pos), slope, qs4, pb, lane); }
#pragma unroll
          for (int g = 0; g < 4; ++g) otot[g] += gate[g][2] * st.o[g] / st.l[g]; }
#pragma unroll
        for (int g = 0; g < 4; ++g) AO[(size_t)m * D + (kvh * 4 + g) * 64 + lane] = (bf16_t)f2bf(otot[g]);
        LDS_WAIT(); asm volatile("" ::: "memory");
    }
}

__device__ __forceinline__ void resid_reduce_phase(Frame& F, int npieces, float scale) {
    const float* part = WSP(float, WS_PART); float* H = WSP(float, WS_H); bf16_t* HB = WSP(bf16_t, WS_HB); float* RS = WSP(float, WS_RS);
    for (int it = F.gw; it < MS * 4; it += F.NGW) { const int r = it >> 2, c = (it & 3) * 256 + F.lane * 4; const size_t off = (size_t)(MP + r) * D + c;
        f32x4 pv[11];
#pragma unroll
        for (int pc = 0; pc < 11; ++pc) pv[pc] = *(const f32x4*)(part + ((size_t)pc * MS + r) * D + c);
        f32x4 acc = (f32x4){0.f, 0.f, 0.f, 0.f};
#pragma unroll
        for (int pc = 0; pc < 11; ++pc) acc = acc + pv[pc];
        f32x4 h = *(const f32x4*)(H + off); h = h + acc * scale; *(f32x4*)(H + off) = h; u32x2 w; w.x = pk2(h.x, h.y); w.y = pk2(h.z, h.w); *(u32x2*)(HB + off) = w;
        float ss = wave_sum((h.x * h.x + h.y * h.y) + (h.z * h.z + h.w * h.w));
        if (F.lane < 4) RS[(size_t)(MP + r) * 16 + (it & 3) * 4 + F.lane] = F.lane == 0 ? ss : 0.f; }
}
__device__ __forceinline__ void final_phase(Frame& F) {
    const float* H = WSP(float, WS_H); const float* g = INF(36);
    for (int grp = F.gw; grp < MT / 4; grp += F.NGW) { f32x4 x[4][4]; float ss[4];
#pragma unroll
        for (int q = 0; q < 4; ++q) { const int m = grp * 4 + q; ss[q] = 0.f;
#pragma unroll
            for (int j = 0; j < 4; ++j) { x[q][j] = *(const f32x4*)(H + (size_t)m * D + j * 256 + F.lane * 4); ss[q] += (x[q][j].x * x[q][j].x + x[q][j].y * x[q][j].y) + (x[q][j].z * x[q][j].z + x[q][j].w * x[q][j].w); } }
        f32x4 gg[4];
#pragma unroll
        for (int j = 0; j < 4; ++j) gg[j] = *(const f32x4*)(g + j * 256 + F.lane * 4);
#pragma unroll
        for (int q = 0; q < 4; ++q) { const float ir = 1.0f / sqrtf(wave_sum(ss[q]) * (1.0f / D) + RMS_EPS); const int m = grp * 4 + q;
#pragma unroll
            for (int j = 0; j < 4; ++j) { const int c = j * 256 + F.lane * 4; *(f32x4*)(F.out + O_Y + (size_t)m * D + c) = x[q][j] * ir * gg[j]; } } }
}

__global__ void __launch_bounds__(NTHREADS, 2) yoco_fwd(Args args) {
    extern __shared__ __attribute__((aligned(16))) unsigned char lds_raw[];
    Frame F; F.lds = (LAS unsigned char*)lds_raw; F.tid = threadIdx.x; F.lane = F.tid & 63; F.wave = __builtin_amdgcn_readfirstlane(F.tid >> 6);
    F.G = gridDim.x; F.gw = blockIdx.x * NWAVES + F.wave; F.NGW = F.G * NWAVES; F.in = args.in; F.out = args.out; F.ws = args.ws;
    volatile LAS unsigned* misc = (volatile LAS unsigned*)(F.lds + LDS_MISC + 16000);
    if (F.tid < 4) misc[F.tid] = 0u;
    __syncthreads();
    const bool single = (args.ph_hi - args.ph_lo) > 1;
    XcdBarrier bar; bar.bar = (unsigned*)(F.ws + WS_CTL); bar.x = 0; bar.st = misc;
    if (single) bar = xcd_barrier_post((unsigned*)(F.ws + WS_CTL), misc);
    int ph = 0;
#define PH_BEGIN if (args.ph_lo <= ph && ph < args.ph_hi) { { int ln_; asm volatile("v_mbcnt_lo_u32_b32 %0, -1, 0\n\tv_mbcnt_hi_u32_b32 %0, -1, %0" : "=v"(ln_)); F.lane = ln_; } \
    { int wv_ = F.wave; unsigned wl_ = (unsigned)(unsigned long long)args.ws, wh_ = (unsigned)((unsigned long long)args.ws >> 32), ol_ = (unsigned)(unsigned long long)args.out, oh_ = (unsigned)((unsigned long long)args.out >> 32); \
      asm volatile("" : "+v"(wv_), "+v"(wl_), "+v"(wh_), "+v"(ol_), "+v"(oh_));     \
      F.wave = __builtin_amdgcn_readfirstlane(wv_); { int bx_ = blockIdx.x; asm volatile("" : "+s"(bx_)); F.bx = bx_; } F.gw = F.bx * NWAVES + F.wave; F.tid = F.wave * 64 + F.lane; \
      F.ws = (unsigned char*)(((unsigned long long)(unsigned)__builtin_amdgcn_readfirstlane(wh_) << 32) | (unsigned)__builtin_amdgcn_readfirstlane(wl_)); \
      F.out = (float*)(((unsigned long long)(unsigned)__builtin_amdgcn_readfirstlane(oh_) << 32) | (unsigned)__builtin_amdgcn_readfirstlane(ol_)); }
#define PH_END   if (single) { int ln2_; asm volatile("v_mbcnt_lo_u32_b32 %0, -1, 0\n\tv_mbcnt_hi_u32_b32 %0, -1, %0" : "=v"(ln2_)); xcd_barrier(bar, F.wave == 0 && ln2_ == 0); } } ++ph;

    PH_BEGIN if (EN_P0) p0_part(F, 0); PH_END
    PH_BEGIN if (EN_P0) p0b_prologue(F); PH_END

    #define H WSP(float, WS_H)
#define HB WSP(bf16_t, WS_HB)
#define RSB WSP(float, WS_RS)
#define FFH WSP(bf16_t, WS_FFH)
#define RS_TBL ((const LAS float*)(F.lds + LDS_TBL))
#define TAIL_WORK(stmt_) if (EN_P0 && F.bx >= 8) { Frame F2 = F; F2.bx = F.bx - 8; F2.G = F.G - 8; F2.gw = F2.bx * NWAVES + F.wave; F2.NGW = F2.G * NWAVES; stmt_ }
#define FFN_PHASES(lf) \
    PH_BEGIN { pg8::StaticOrder S; S.init(MT, 2 * DFF, F.G, F.bx); PMSimple P{(const char*)HB, (const char*)(WSP(bf16_t, WS_WIN) + (size_t)(lf) * 2 * DFF * D), (size_t)256 * D * 2, (size_t)256 * D * 2}; \
        build_rs_table(F.lds, RSB, S, F.tid); EpiFFN1 E{FFH, RS_TBL, 0}; if (EN_GEMM) pg8::gemm_phase(F.lds, F.tid, D, D, D, S, P, E); } PH_END \
    PH_BEGIN { pg8::OrderSplit S; S.init(DFF, F.G, F.bx); PMSimple P{(const char*)FFH, (const char*)(WSP(bf16_t, WS_WOUT) + (size_t)(lf) * D * DFF), (size_t)256 * DFF * 2, (size_t)256 * DFF * 2}; \
        EpiResid E{H, HB, RSB, 0.5f, WSP(float, WS_PART)}; if (EN_GEMM) pg8::gemm_phase(F.lds, F.tid, DFF, DFF, DFF, S, P, E); } PH_END \
    PH_BEGIN resid_reduce_phase(F, DFF / 256, 0.5f); PH_END

    for (int l = 0; l < 2; ++l) {
        FFN_PHASES(l * 2)
        PH_BEGIN if (EN_ELT) r1_phase(F, l); PH_END
        PH_BEGIN { pg8::StaticOrder S; S.init(MT, l == 0 ? NR2 - 256 : NR2, F.G, F.bx);        PMR2 P{(const char*)WSP(bf16_t, WS_XS), (const char*)(WSP(bf16_t, WS_WR2) + (size_t)l * NR2 * D)};
            EpiR2 E{WSP(float, WS_RKV), 2 + l, WSP(bf16_t, WS_LH), WSP(bf16_t, WS_SCN) + (size_t)l * SCN_L}; if (EN_GEMM) pg8::gemm_phase(F.lds, F.tid, D, D, D, S, P, E); } PH_END
        PH_BEGIN { pg8::StaticOrder S; S.init(MT, l == 0 ? NR3 - 1024 : NR3, F.G, F.bx);        PMSimple P{(const char*)WSP(bf16_t, WS_LH), (const char*)(WSP(bf16_t, WS_WR3) + (size_t)l * NR3 * KR3), (size_t)256 * KR3 * 2, (size_t)256 * KR3 * 2};
            EpiR3 E{WSP(float, WS_LU), WSP(bf16_t, WS_SCN) + (size_t)l * SCN_L}; if (EN_GEMM) pg8::gemm_phase(F.lds, F.tid, KR3, KR3, KR3, S, P, E); } PH_END
        PH_BEGIN if (EN_SCAN) { r4_phase(F, l); scanA_phase(F, l); } PH_END
        PH_BEGIN if (EN_SCAN) scanB_phase(F, l); PH_END
        PH_BEGIN if (EN_SCAN) { scanC_phase(F, l); r5b_phase(F, l); } PH_END
        PH_BEGIN { pg8::StaticOrder S; S.init(MT, D, F.G, F.bx); PMSimple P{(const char*)WSP(bf16_t, WS_YG), (const char*)(WSP(bf16_t, WS_WRO) + (size_t)l * D * D), (size_t)256 * D * 2, (size_t)256 * D * 2};
            EpiResid E{H, HB, RSB, 1.0f, nullptr}; if (EN_GEMM) pg8::gemm_phase(F.lds, F.tid, D, D, D, S, P, E);
            TAIL_WORK({ LAS float* scr_ = (LAS float*)(F.lds + F.wave * 16384); p0_ffn(F2, 6 + l, scr_); }) } PH_END
        FFN_PHASES(l * 2 + 1)
    }
    PH_BEGIN { pg8::StaticOrder S; S.init(MT, NKVW, F.G, F.bx); PMSimple P{(const char*)HB, (const char*)WSP(bf16_t, WS_WKV), (size_t)256 * D * 2, (size_t)256 * D * 2};
        build_rs_table(F.lds, RSB, S, F.tid); EpiKV E{F.out, WSP(float, WS_WINP), RS_TBL, 0}; if (EN_GEMM) pg8::gemm_phase(F.lds, F.tid, D, D, D, S, P, E); } PH_END
    PH_BEGIN if (EN_ELT) { cst_phase(F); kvstage_phase(F); } PH_END
    PH_BEGIN { OrderC1 S{F.G, F.bx}; PMC1 P{(const char*)WSP(bf16_t, WS_CST), (const char*)WSP(bf16_t, WS_WC1)}; EpiC1 E{WSP(float, WS_CH)}; if (EN_GEMM) pg8::gemm_phase(F.lds, F.tid, 1024, 1024, 1024, S, P, E); } PH_END
    PH_BEGIN if (EN_ELT) c2_phase(F); PH_END
    for (int l = 0; l < 2; ++l) {
        FFN_PHASES(4 + l * 2)
        PH_BEGIN { pg8::StaticOrder S; S.init(MT, NQI, F.G, F.bx); PMSimple P{(const char*)HB, (const char*)(WSP(bf16_t, WS_WQI) + (size_t)l * NQI * D), (size_t)256 * D * 2, (size_t)256 * D * 2};
            build_rs_table(F.lds, RSB, S, F.tid); EpiQI E{WSP(float, WS_QG), WSP(bf16_t, WS_QB), RS_TBL, 0}; if (EN_GEMM) pg8::gemm_phase(F.lds, F.tid, D, D, D, S, P, E); } PH_END
        PH_BEGIN if (EN_ATT) { attp_phase(F, l); __syncthreads(); atts2_phase(F, l); } PH_END
        PH_BEGIN { pg8::StaticOrder S; S.init(MT, D, F.G, F.bx); PMSimple P{(const char*)WSP(bf16_t, WS_AO), (const char*)(WSP(bf16_t, WS_WBO) + (size_t)l * D * D), (size_t)256 * D * 2, (size_t)256 * D * 2};
            EpiResid E{H, HB, RSB, 1.0f, nullptr}; if (EN_GEMM) pg8::gemm_phase(F.lds, F.tid, D, D, D, S, P, E);
            TAIL_WORK({ swin_copy(F2, 64 + 32 * l, 96 + 32 * l); }) } PH_END
        FFN_PHASES(4 + l * 2 + 1)
    }
    PH_BEGIN if (EN_ELT) final_phase(F); PH_END
}
constexpr int N_PHASES = 2 + 2 * 13 + 4 + 2 * 9 + 1;

extern "C" void kernel_launch(void* const* d_in, const int* in_sizes, int n_in, void* d_out, int out_size, void* d_ws, size_t ws_size, hipStream_t stream) {
    static int grid = 0;
    if (grid == 0) {
        if (n_in != 37 || ws_size < WS_END) { fprintf(stderr, "kernel_launch: expected 37 inputs and >= %zu bytes of workspace (got %d, %zu)\n", (size_t)WS_END, n_in, ws_size); grid = -1; return; }
        int dev = 0, cus = 0, per_cu = 0;
        if (hipGetDevice(&dev) != hipSuccess || hipDeviceGetAttribute(&cus, hipDeviceAttributeMultiprocessorCount, dev) != hipSuccess) { grid = -1; return; }
        if (hipFuncSetAttribute((const void*)yoco_fwd, hipFuncAttributeMaxDynamicSharedMemorySize, LDS_BYTES) != hipSuccess) { fprintf(stderr, "kernel_launch: hipFuncSetAttribute failed\n"); grid = -1; return; }
        if (hipOccupancyMaxActiveBlocksPerMultiprocessor(&per_cu, (const void*)yoco_fwd, NTHREADS, LDS_BYTES) != hipSuccess || per_cu < 1) fprintf(stderr, "kernel_launch: occupancy query says %d\n", per_cu);
        (void)hipGetLastError();
        grid = cus;
    }
    if (grid < 0) return;
    (void)hipMemsetAsync((char*)d_ws + WS_CTL, 0, CTL_BYTES, stream);
    Args a{};
    for (int i = 0; i < 37; ++i) a.in[i] = d_in[i];
    a.out = (float*)d_out; a.ws = (unsigned char*)d_ws;
#if MK_MULTI
    for (int p = 0; p < N_PHASES; ++p) { a.ph_lo = p; a.ph_hi = p + 1; hipLaunchKernelGGL(yoco_fwd, dim3(grid), dim3(NTHREADS), LDS_BYTES, stream, a); }
#else
    a.ph_lo = 0; a.ph_hi = N_PHASES;
    hipLaunchKernelGGL(yoco_fwd, dim3(grid), dim3(NTHREADS), LDS_BYTES, stream, a);
#endif
    const hipError_t le = hipPeekAtLastError();
    if (le != hipSuccess) fprintf(stderr, "kernel_launch: launch failed: %s\n", hipGetErrorName(le));
}
```

```cpp
#include <hip/hip_runtime.h>
#include <cstdio>
#include <cstdint>

#ifndef MK_MULTI
#define MK_MULTI 0
#endif

#define LAS __attribute__((address_space(3)))
#define GAS __attribute__((address_space(1)))
#define CAS __attribute__((address_space(4)))
typedef unsigned short bf16_t;
typedef short bf16x8 __attribute__((ext_vector_type(8)));
typedef float f32x4 __attribute__((ext_vector_type(4)));
typedef float f32x2 __attribute__((ext_vector_type(2)));
typedef unsigned u32x4 __attribute__((ext_vector_type(4)));
typedef unsigned u32x2 __attribute__((ext_vector_type(2)));

constexpr int D = 1024, NBP = 4, TP = 4096, MP = NBP * TP, NBS = 128, TS = 4, MS = NBS * TS, MT = MP + MS;
constexpr int PAST = 2048, PAGE = 128, NPG = 16;
constexpr int DFF = 2816, NH = 16, HD = 64, NKV = 4;
constexpr int NR2 = 4096, KR3 = 384, NR3 = 4096, NKVW = 1536, NQI = 1280;
constexpr int CROWS_S = NBS * NKV * 128, CROWS_P = NBP * NKV * 256, CROWS = CROWS_S + CROWS_P;
constexpr int NCH_P = 64, NCH_S = NBS * NH, SIW = 320;
constexpr float RMS_EPS = 1e-6f, GN_EPS = 64e-5f;

constexpr size_t O_Y = 0, O_PSHIFT = (size_t)MT * D, O_PWKV = O_PSHIFT + 2 * NBP * D, O_PCS = O_PWKV + (size_t)2 * NBP * NH * 64 * 64, O_PWIN = O_PCS + (size_t)MP * 1024,
                 O_SSHIFT = O_PWIN + (size_t)NBP * 512 * 512, O_SWKV = O_SSHIFT + (size_t)2 * NBS * D, O_SCS = O_SWKV + (size_t)2 * NBS * NH * 64 * 64, O_SWIN = O_SCS + (size_t)MS * 1024;

constexpr size_t al256(size_t x) { return (x + 255) & ~(size_t)255; }
constexpr size_t WS_CTL = 0, CTL_BYTES = 1u << 20;
constexpr size_t SZ_WIN1 = (size_t)2 * DFF * D * 2, SZ_WOUT1 = (size_t)D * DFF * 2;
constexpr size_t WS_WIN = WS_CTL + CTL_BYTES;
constexpr size_t WS_WOUT = WS_WIN + 8 * SZ_WIN1;
constexpr size_t WS_WR2 = WS_WOUT + 8 * SZ_WOUT1;
constexpr size_t WS_WR3 = WS_WR2 + (size_t)2 * NR2 * D * 2;
constexpr size_t WS_WRO = WS_WR3 + (size_t)2 * NR3 * KR3 * 2;
constexpr size_t WS_WKV = WS_WRO + (size_t)2 * D * D * 2;
constexpr size_t WS_WQI = WS_WKV + (size_t)NKVW * D * 2;
constexpr size_t WS_WBO = WS_WQI + (size_t)2 * NQI * D * 2;
constexpr size_t WS_WC1 = WS_WBO + (size_t)2 * D * D * 2;
constexpr size_t WS_POSB = WS_WC1 + (size_t)2 * 256 * 1024 * 2;
constexpr size_t WS_H = al256(WS_POSB + 2 * 128 * 4);
constexpr size_t WS_HB = WS_H + (size_t)MT * D * 4;
constexpr size_t WS_RS = WS_HB + (size_t)MT * D * 2;
constexpr size_t WS_FFH = WS_RS + (size_t)MT * 16 * 4;
constexpr size_t WS_XS = WS_FFH + (size_t)MT * DFF * 2;
constexpr size_t WS_RKV = WS_XS + (size_t)6 * MT * D * 2;
constexpr size_t WS_LH = WS_RKV + (size_t)4 * MT * D * 4;
constexpr size_t WS_LU = WS_LH + (size_t)MT * KR3 * 2;
constexpr size_t WS_SIP = WS_LU + (size_t)MT * NR3 * 4;
constexpr size_t SIP_L = (size_t)NCH_P * TP * SIW, SIS_L = (size_t)NCH_S * TS * SIW;
constexpr size_t WS_SIS = WS_SIP + 2 * SIP_L * 4;
constexpr size_t WS_SV = WS_SIS + 2 * SIS_L * 4;
constexpr size_t WS_YS = WS_SV + (size_t)MT * D * 4;
constexpr size_t WS_YG = WS_YS + (size_t)MT * D * 4;
constexpr size_t WS_WINP = WS_YG + (size_t)MT * D * 2;
constexpr size_t WS_CST = WS_WINP + (size_t)MP * 512 * 4;
constexpr size_t WS_CH = WS_CST + (size_t)2 * CROWS * 1024 * 2;
constexpr size_t WS_KCMP = WS_CH + (size_t)2 * CROWS * 256 * 4;
constexpr size_t WS_QG = WS_KCMP + (size_t)2 * CROWS * 64 * 4;
constexpr size_t WS_AO = WS_QG + (size_t)MT * NQI * 4;
constexpr size_t WS_QB = WS_AO + (size_t)MT * D * 2;
constexpr size_t WS_KVS = WS_QB + (size_t)MT * D * 2;
constexpr size_t WS_KCB = WS_KVS + (size_t)4 * 16 * TP * 64 * 2;
constexpr size_t WS_TG = WS_KCB + (size_t)2 * 16 * 256 * 64 * 2;
constexpr size_t WS_SS = WS_TG + (size_t)NCH_P * 64 * 8192 * 4;
constexpr size_t WS_PART = WS_SS + (size_t)NCH_P * 64 * 4096 * 4;
constexpr size_t WS_YQ = WS_PART + (size_t)11 * MS * D * 4;
constexpr size_t SCN_L = (size_t)MP * NH * 7 * 64;
constexpr size_t WS_SCN = WS_YQ + (size_t)NCH_P * 64 * 12288 * 4;
constexpr size_t WS_END = WS_SCN + 2 * SCN_L * 2;

constexpr int NWAVES = 8, NTHREADS = 512;
constexpr int LDS_STAGE = 131072, LDS_MISC = LDS_STAGE, LDS_BYTES = LDS_STAGE + 16384;

__device__ __forceinline__ unsigned f2bf(float f) { unsigned u = __builtin_bit_cast(unsigned, f); return (u + 0x7fffu + ((u >> 16) & 1u)) >> 16; }
__device__ __forceinline__ unsigned pk2(float lo, float hi) { return f2bf(lo) | (f2bf(hi) << 16); }
__device__ __forceinline__ int lane_id_() { int l; asm volatile("v_mbcnt_lo_u32_b32 %0, -1, 0\n\tv_mbcnt_hi_u32_b32 %0, -1, %0" : "=v"(l)); return l; }
__device__ __forceinline__ float shflx_l(float v, int mask, int lane) { return __builtin_bit_cast(float, __builtin_amdgcn_ds_bpermute((lane ^ mask) << 2, __builtin_bit_cast(int, v))); }
__device__ __forceinline__ float shflx(float v, int mask) { return shflx_l(v, mask, lane_id_()); }
__device__ __forceinline__ float wave_sum(float v) { const int l = lane_id_();
#pragma unroll
    for (int o = 1; o < 64; o <<= 1) v += shflx_l(v, o, l);
    return v;
}
__device__ __forceinline__ float wave_max(float v) { const int l = lane_id_();
#pragma unroll
    for (int o = 1; o < 64; o <<= 1) v = fmaxf(v, shflx_l(v, o, l));
    return v;
}
__device__ __forceinline__ float sigmoidf_(float x) { return __builtin_amdgcn_rcpf(1.0f + __expf(-x)); }
__device__ __forceinline__ float tanh_fast(float x) { const float e = __expf(-2.0f * fabsf(x)); const float t = (1.0f - e) * __builtin_amdgcn_rcpf(1.0f + e); return x < 0.f ? -t : t; }
#define LDS_WAIT() asm volatile("s_waitcnt lgkmcnt(0)" ::: "memory")

#define XB_TMO      128
#define XB_XCNT(j)  (256  + 64 * (j))
#define XB_XSUB(j)  (1280 + 64 * (j))
#define XB_XGEN(j)  (2304 + 64 * (j))
#define XB_TOP      3328
#define XB_TOPGEN   3392
#define XCD_BAR_WORDS 3456
#define XB_SPIN_CAP (1u << 18)
__device__ __forceinline__ unsigned xb_ld(unsigned* p)              { return __hip_atomic_load(p, __ATOMIC_RELAXED, __HIP_MEMORY_SCOPE_AGENT); }
__device__ __forceinline__ unsigned xb_add(unsigned* p, unsigned v) { return __hip_atomic_fetch_add(p, v, __ATOMIC_RELAXED, __HIP_MEMORY_SCOPE_AGENT); }
__device__ __forceinline__ unsigned xb_xcc_id() { return (unsigned)__builtin_amdgcn_s_getreg((3 << 11) | 20) & 0xFu; }
#define XB_SPIN(cond, bar) do { unsigned _sp = 0; while (cond) { __builtin_amdgcn_s_sleep(1); \
    if ((++_sp & 255u) == 0u) { if (xb_ld(&(bar)[XB_TMO])) break; if (_sp > XB_SPIN_CAP) { atomicAdd(&(bar)[XB_TMO], 1u); break; } } } } while (0)
struct XcdBarrier { unsigned* bar; unsigned x; volatile LAS unsigned* st; };
__device__ __forceinline__ XcdBarrier xcd_barrier_post(unsigned* bar, volatile LAS unsigned* st) {
    XcdBarrier b; b.bar = bar; b.x = xb_xcc_id(); b.st = st;
    if (threadIdx.x == 0) (void)xb_add(&bar[XB_XCNT(b.x)], 1u);
    return b;
}
__device__ __forceinline__ void xcd_barrier_complete(unsigned* bar, unsigned x, unsigned& nloc, unsigned& nx) {
    const unsigned G = gridDim.x * gridDim.y * gridDim.z;
    unsigned sum, cnt, mine, sp = 0u;
    for (;;) {
        sum = 0u; cnt = 0u; mine = 0u;
#pragma unroll
        for (unsigned j = 0; j < 16; ++j) { const unsigned c = xb_ld(&bar[XB_XCNT(j)]); sum += c; cnt += (c > 0u) ? 1u : 0u; }
        if (sum == G) { mine = xb_ld(&bar[XB_XCNT(x)]); break; }
        __builtin_amdgcn_s_sleep(1);
        if ((++sp & 255u) == 0u) { if (xb_ld(&bar[XB_TMO])) break; if (sp > XB_SPIN_CAP) { atomicAdd(&bar[XB_TMO], 1u); break; } }
    }
    nloc = mine > 0u ? mine : 1u; nx = cnt > 0u ? cnt : 1u;
}
__device__ __forceinline__ void xcd_barrier(const XcdBarrier& b, const bool leader_thread) {
    asm volatile("s_waitcnt vmcnt(0)" ::: "memory");
    __syncthreads();
    if (leader_thread) {
        unsigned* bar = b.bar;
        __builtin_amdgcn_s_waitcnt(0);
        unsigned nloc = b.st[0], nx = b.st[1];
        if (nloc == 0u) { xcd_barrier_complete(bar, b.x, nloc, nx); b.st[0] = nloc; b.st[1] = nx; }
        const unsigned old = xb_add(&bar[XB_XSUB(b.x)], 1u);
        const unsigned gen = old / nloc;
        if (old + 1u == (gen + 1u) * nloc) {
            __builtin_amdgcn_fence(__ATOMIC_RELEASE, "agent");
            asm volatile("s_waitcnt vmcnt(0)" ::: "memory");
            const unsigned og = xb_add(&bar[XB_TOP], 1u);
            const unsigned tg = og / nx;
            if (og + 1u == (tg + 1u) * nx) xb_add(&bar[XB_TOPGEN], 1u);
            else XB_SPIN(xb_ld(&bar[XB_TOPGEN]) == tg, bar);
            __builtin_amdgcn_fence(__ATOMIC_ACQUIRE, "agent");
            xb_add(&bar[XB_XGEN(b.x)], 1u);
            asm volatile("s_waitcnt vmcnt(0)" ::: "memory");
        } else {
            XB_SPIN(xb_ld(&bar[XB_XGEN(b.x)]) == gen, bar);
            __builtin_amdgcn_fence(__ATOMIC_ACQUIRE, "agent");
            asm volatile("s_waitcnt vmcnt(0)" ::: "memory");
        }
    }
    __syncthreads();
}

namespace pg8 {
constexpr int BM = 256, BK = 64, HALF = 128, HTB = HALF * BK * 2, STAGE_BYTES = 8 * HTB, NXCD = 8, WGM = 8;
__host__ __device__ __forceinline__ int lds_byte(int r, int c) { const int st = (r >> 4) * 2 + (c >> 5), rr = r & 15, cc = c & 31, ob = rr * 64 + cc * 2; return st * 1024 + (ob ^ (((ob >> 9) & 1) << 5)); }
__host__ __device__ __forceinline__ void stage_rc(int b, int& R, int& C) { const int st = b / 1024, sb = b % 1024, swz = sb ^ (((sb >> 9) & 1) << 5); R = (st >> 1) * 16 + swz / 64; C = (st & 1) * 32 + (swz % 64) / 2; }
__host__ __device__ __forceinline__ int perm32(int rho) { const int n = rho >> 4, i = rho & 15; return 8 * (i >> 2) + 4 * n + (i & 3); }
struct Unit { int pm, pn, k0, nk; };
struct StaticOrder {
    int nM, nN, nwg, G, c;
    __device__ void init(int M, int N, int G_, int c_) { nM = M / BM; nN = N / BM; nwg = nM * nN; G = G_; c = c_; }
    __device__ bool next(int i, Unit& u) const {
        const long L = (long)i * G + c; if (L >= nwg) return false;
        int wgid = (int)L; { const int q = nwg / NXCD, r = nwg % NXCD, xcd = wgid % NXCD, off = wgid / NXCD; wgid = (xcd < r ? xcd * (q + 1) : r * (q + 1) + (xcd - r) * q) + off; }
        const int nig = WGM * nN, gid = wgid / nig, fm = gid * WGM, gsz = (nM - fm) < WGM ? (nM - fm) : WGM;
        u.pm = fm + ((wgid % nig) % gsz); u.pn = (wgid % nig) / gsz; u.k0 = 0; u.nk = 0; return true;
    }
};
struct OrderSplit { StaticOrder so; int G, c, npieces;
    __device__ void init(int K, int G_, int c_) { so.init(MP, D, G_, c_); G = G_; c = c_; npieces = K / (4 * BK); }
    __device__ bool next(int i, Unit& u) const { const int L = i * G + c; if (L < 256) { const int i0 = L / G; StaticOrder s2 = so; s2.c = L - i0 * G; return s2.next(i0, u); }
        const int idx = L - 256; if (idx >= 8 * npieces) return false; const int u8 = idx / npieces, pc = idx % npieces; u.pm = MP / 256 + (u8 >> 2); u.pn = u8 & 3; u.k0 = pc * 4; u.nk = 4; return true; } };
template <class Epi, class Sched, class PM>
__device__ __forceinline__ void gemm_phase(LAS unsigned char* lds, const int tid_in, const int K, const int lda, const int ldb, const Sched& S, const PM& P, const Epi& E) {
    int tid_ = tid_in; asm volatile("" : "+v"(tid_));
    const int tid = tid_, wid = __builtin_amdgcn_readfirstlane(tid >> 6), lane = tid & 63, wr = wid >> 2, wc = wid & 3, fr = lane & 15, fq = lane >> 4;
    const int nt = K / BK;
    unsigned voffA[2], voffB[2];
#pragma unroll
    for (int i = 0; i < 2; ++i) { int R, C; stage_rc(tid * 16 + i * 8192, R, C); const int Rb = Epi::PERM ? ((R & ~31) + perm32(R & 31)) : R;
        voffA[i] = (unsigned)(R * lda + C) * 2u; voffB[i] = (unsigned)(Rb * ldb + C) * 2u; }
    const size_t kstep = (size_t)(BK * 2);
    const size_t hstepA = (size_t)HALF * lda * 2, hstepB = (size_t)HALF * ldb * 2;
    const unsigned ldsw = (unsigned)wid * 1024u;
    const int aoff = lds_byte(wr * 64 + fr, fq * 8), boff = lds_byte(wc * 32 + fr, fq * 8);
#define PG8_SA(b, h) (((b) * 2 + (h)) * HTB)
#define PG8_SB(b, h) ((4 + (b) * 2 + (h)) * HTB)
#define PG8_STAGE(bufoff, gbase, voff) do { _Pragma("unroll") for (int _i = 0; _i < 2; ++_i) \
        __builtin_amdgcn_global_load_lds((const unsigned*)((const char*)(gbase) + (voff)[_i]), (LAS unsigned*)(lds + (bufoff) + ldsw + _i * 8192), 16, 0, 0); } while (0)
#define PG8_LDA(dst, b, h) do { _Pragma("unroll") for (int m = 0; m < 4; ++m) _Pragma("unroll") for (int k = 0; k < 2; ++k) dst[m][k] = *(const LAS bf16x8*)(lds + PG8_SA(b, h) + aoff + m * 2048 + k * 1024); } while (0)
#define PG8_LDB(dst, b, h) do { _Pragma("unroll") for (int n = 0; n < 2; ++n) _Pragma("unroll") for (int k = 0; k < 2; ++k) dst[n][k] = *(const LAS bf16x8*)(lds + PG8_SB(b, h) + boff + n * 2048 + k * 1024); } while (0)
#define PG8_MMA(ai, bj, At, Bt) do { __builtin_amdgcn_s_setprio(1); _Pragma("unroll") for (int m = 0; m < 4; ++m) _Pragma("unroll") for (int n = 0; n < 2; ++n) _Pragma("unroll") for (int k = 0; k < 2; ++k) \
        acc[ai][bj][m][n] = __builtin_amdgcn_mfma_f32_16x16x32_bf16(Bt[n][k], At[m][k], acc[ai][bj][m][n], 0, 0, 0); __builtin_amdgcn_s_setprio(0); } while (0)
#define PG8_WAIT_V(n) asm volatile("s_waitcnt vmcnt(" #n ")" ::: "memory")
#define PG8_WAIT_L(n) asm volatile("s_waitcnt lgkmcnt(" #n ")" ::: "memory")
#define PG8_BAR __builtin_amdgcn_s_barrier()
#define PG8_SCHED __builtin_amdgcn_sched_barrier(0)
    Unit cur, nxt; int ui = 0;
    if (!S.next(0, cur)) return;
    f32x4 acc[2][2][4][2];
#pragma unroll
    for (int a = 0; a < 2; ++a)
#pragma unroll
        for (int b = 0; b < 2; ++b)
#pragma unroll
            for (int m = 0; m < 4; ++m)
#pragma unroll
                for (int n = 0; n < 2; ++n) acc[a][b][m][n] = (f32x4){0.f, 0.f, 0.f, 0.f};
    bf16x8 At[4][2], B0[2][2], B1[2][2];
    const char* cA = P.a(cur) + (size_t)cur.k0 * (BK * 2); const char* cB = P.b(cur) + (size_t)cur.k0 * (BK * 2);
    PG8_STAGE(PG8_SB(0, 0), cB, voffB); PG8_STAGE(PG8_SB(0, 1), cB + hstepB, voffB); PG8_STAGE(PG8_SA(0, 0), cA, voffA); PG8_STAGE(PG8_SA(0, 1), cA + hstepA, voffA);
    if (wr == 1) PG8_BAR;
    PG8_WAIT_V(2); PG8_BAR;
    PG8_STAGE(PG8_SB(1, 0), cB + kstep, voffB); PG8_STAGE(PG8_SA(1, 0), cA + kstep, voffA); PG8_STAGE(PG8_SB(1, 1), cB + hstepB + kstep, voffB);
    PG8_WAIT_V(6); PG8_BAR;
    for (;;) {
        const bool has_next = S.next(ui + 1, nxt);
        const char* nA = has_next ? P.a(nxt) + (size_t)nxt.k0 * (BK * 2) : cA; const char* nB = has_next ? P.b(nxt) + (size_t)nxt.k0 * (BK * 2) : cB;
        const int ntc = cur.nk ? cur.nk : nt;
        for (int t = 0; t < ntc; t += 2) {
            const bool last = (t == ntc - 2);
            const char* a1 = cA + (size_t)(t + 1) * kstep;
            const char* a2 = last ? nA : cA + (size_t)(t + 2) * kstep; const char* b2 = last ? nB : cB + (size_t)(t + 2) * kstep;
            const char* a3 = a2 + kstep; const char* b3 = b2 + kstep;
            PG8_LDB(B0, 0, 0); PG8_LDB(B1, 0, 1); PG8_SCHED; PG8_LDA(At, 0, 0); PG8_STAGE(PG8_SA(1, 1), a1 + hstepA, voffA);
            PG8_WAIT_V(8); PG8_WAIT_L(0); PG8_BAR; PG8_MMA(0, 0, At, B0); PG8_MMA(0, 1, At, B1); PG8_BAR; PG8_SCHED;
            PG8_LDA(At, 0, 1); PG8_STAGE(PG8_SB(0, 0), b2, voffB); PG8_STAGE(PG8_SB(0, 1), b2 + hstepB, voffB); PG8_STAGE(PG8_SA(0, 0), a2, voffA);
            PG8_WAIT_V(8); PG8_WAIT_L(0); PG8_BAR; PG8_MMA(1, 0, At, B0); PG8_MMA(1, 1, At, B1); PG8_BAR; PG8_SCHED;
            PG8_LDB(B0, 1, 0); PG8_LDB(B1, 1, 1); PG8_SCHED; PG8_LDA(At, 1, 0); PG8_STAGE(PG8_SA(0, 1), a2 + hstepA, voffA);
            PG8_WAIT_V(8); PG8_WAIT_L(0); PG8_BAR; PG8_MMA(0, 0, At, B0); PG8_MMA(0, 1, At, B1); PG8_BAR; PG8_SCHED;
            PG8_LDA(At, 1, 1); PG8_STAGE(PG8_SB(1, 0), b3, voffB); PG8_STAGE(PG8_SB(1, 1), b3 + hstepB, voffB); PG8_STAGE(PG8_SA(1, 0), a3, voffA);
            PG8_WAIT_V(8); PG8_WAIT_L(0); PG8_BAR; PG8_MMA(1, 0, At, B0); PG8_MMA(1, 1, At, B1); PG8_BAR; PG8_SCHED;
        }
        if (wr == 0) PG8_BAR;
        { int le_; asm volatile("v_mbcnt_lo_u32_b32 %0, -1, 0\n\tv_mbcnt_hi_u32_b32 %0, -1, %0" : "=v"(le_));
          E(acc, cur, wr, wc, le_ & 15, le_ >> 4); }
        if (!has_next) break;
#pragma unroll
        for (int a = 0; a < 2; ++a)
#pragma unroll
            for (int b = 0; b < 2; ++b)
#pragma unroll
                for (int m = 0; m < 4; ++m)
#pragma unroll
                    for (int n = 0; n < 2; ++n) acc[a][b][m][n] = (f32x4){0.f, 0.f, 0.f, 0.f};
        cur = nxt; cA = nA; cB = nB; ++ui;
        if (wr == 1) PG8_BAR;
    }
    PG8_WAIT_V(0);
    PG8_BAR;
#undef PG8_SA
#undef PG8_SB
#undef PG8_STAGE
#undef PG8_LDA
#undef PG8_LDB
#undef PG8_MMA
#undef PG8_WAIT_V
#undef PG8_WAIT_L
#undef PG8_BAR
#undef PG8_SCHED
}
}
using pg8::Unit;

struct Args { const void* in[37]; float* out; unsigned char* ws; int ph_lo, ph_hi; };
struct Frame {
    LAS unsigned char* lds; int tid, lane, wave, gw, NGW, G, bx, rot;
    const void* const* in; float* out; unsigned char* ws;
};
#define INF(i) ((const float*)F.in[i])
#define WSP(T, off) ((T*)(F.ws + (off)))

constexpr int LDS_TBL = LDS_STAGE;
template <class Sched> __device__ __forceinline__ void build_rs_table(LAS unsigned char* lds, const float* rs, const Sched& S, int t) {
    LAS float* tbl = (LAS float*)(lds + LDS_TBL); const int half = __builtin_amdgcn_readfirstlane(t >> 8), r = t & 255;
    f32x4 v[4][4]; bool ok[4];
#pragma unroll
    for (int j = 0; j < 4; ++j) { Unit u; ok[j] = S.next(2 * j + half, u);
        if (ok[j]) { const f32x4* p = (const f32x4*)(rs + (size_t)(u.pm * 256 + r) * 16); v[j][0] = p[0]; v[j][1] = p[1]; v[j][2] = p[2]; v[j][3] = p[3]; } }
#pragma unroll
    for (int j = 0; j < 4; ++j) if (ok[j]) { const f32x4 a = v[j][0], b = v[j][1], c = v[j][2], d = v[j][3];
        const float s = (((a.x + a.y) + (a.z + a.w)) + ((b.x + b.y) + (b.z + b.w))) + (((c.x + c.y) + (c.z + c.w)) + ((d.x + d.y) + (d.z + d.w)));
        tbl[(2 * j + half) * 256 + r] = 1.0f / sqrtf(s * (1.0f / D) + RMS_EPS); }
    __syncthreads();
}

struct PMSimple { const char* A; const char* B; size_t at, bt;
    __device__ __forceinline__ const char* a(const Unit& u) const { return A + (size_t)u.pm * at; }
    __device__ __forceinline__ const char* b(const Unit& u) const { return B + (size_t)u.pn * bt; } };

struct EpiFFN1 {
    static constexpr bool PERM = true;
    bf16_t* O; const LAS float* tbl; mutable int k;
    __device__ __forceinline__ void operator()(const f32x4 (&acc)[2][2][4][2], const Unit& u, int wr, int wc, int fr, int fq) const {
        const int row0 = u.pm * 256 + wr * 64 + fr, col0 = u.pn * 128 + wc * 32 + 8 * fq; const LAS float* tk = tbl + k * 256 + wr * 64 + fr; ++k;
#pragma unroll
        for (int ai = 0; ai < 2; ++ai)
#pragma unroll
            for (int m = 0; m < 4; ++m) { const int row = row0 + ai * 128 + m * 16; const float ir = tk[ai * 128 + m * 16];
                float o[8];
#pragma unroll
                for (int n = 0; n < 2; ++n)
#pragma unroll
                    for (int j = 0; j < 4; ++j) { const float g = acc[ai][0][m][n][j] * ir, up = acc[ai][1][m][n][j] * ir; o[n * 4 + j] = g * sigmoidf_(g) * up; }
                u32x4 w; w.x = pk2(o[0], o[1]); w.y = pk2(o[2], o[3]); w.z = pk2(o[4], o[5]); w.w = pk2(o[6], o[7]);
                *(u32x4*)(O + (size_t)row * DFF + col0) = w; }
    }
};
struct EpiResid {
    static constexpr bool PERM = false;
    float* H; bf16_t* HB; float* rs; float scale; float* part;
    __device__ __forceinline__ void operator()(const f32x4 (&acc)[2][2][4][2], const Unit& u, int wr, int wc, int fr, int fq) const {
        const int row0 = u.pm * 256 + wr * 64 + fr, col0 = u.pn * 256 + wc * 32 + 4 * fq;
        if (u.nk) { float* dst = part + (size_t)(u.k0 / u.nk) * MS * D;
#pragma unroll
            for (int ai = 0; ai < 2; ++ai)
#pragma unroll
                for (int m = 0; m < 4; ++m) { const int row = row0 + ai * 128 + m * 16 - MP;
#pragma unroll
                    for (int bj = 0; bj < 2; ++bj)
#pragma unroll
                        for (int n = 0; n < 2; ++n) *(f32x4*)(dst + (size_t)row * D + col0 + bj * 128 + n * 16) = acc[ai][bj][m][n]; }
            return; }
#pragma unroll
        for (int ai = 0; ai < 2; ++ai) {
            f32x4 hv[4][2][2];
#pragma unroll
            for (int m = 0; m < 4; ++m)
#pragma unroll
                for (int bj = 0; bj < 2; ++bj)
#pragma unroll
                    for (int n = 0; n < 2; ++n) hv[m][bj][n] = *(const f32x4*)(H + (size_t)(row0 + ai * 128 + m * 16) * D + col0 + bj * 128 + n * 16);
            __builtin_amdgcn_sched_barrier(0);
#pragma unroll
            for (int m = 0; m < 4; ++m) { const int row = row0 + ai * 128 + m * 16; float ss = 0.f;
#pragma unroll
                for (int bj = 0; bj < 2; ++bj)
#pragma unroll
                    for (int n = 0; n < 2; ++n) { const size_t off = (size_t)row * D + col0 + bj * 128 + n * 16;
                        f32x4 h = hv[m][bj][n]; h = h + acc[ai][bj][m][n] * scale; *(f32x4*)(H + off) = h;
                        u32x2 w; w.x = pk2(h.x, h.y); w.y = pk2(h.z, h.w); *(u32x2*)(HB + off) = w;
                        ss += (h.x * h.x + h.y * h.y) + (h.z * h.z + h.w * h.w); }
                ss += shflx(ss, 16); ss += shflx(ss, 32);
                if (fq == 0) rs[(size_t)row * 16 + u.pn * 4 + wc] = ss; }
            __builtin_amdgcn_sched_barrier(0); }
    }
};
struct EpiR2 {
    static constexpr bool PERM = false;
    float* RKV; int vslot; bf16_t* LH; bf16_t* SCN;
    __device__ __forceinline__ void operator()(const f32x4 (&acc)[2][2][4][2], const Unit& u, int wr, int wc, int fr, int fq) const {
        const int row0 = u.pm * 256 + wr * 64 + fr, cl0 = wc * 32 + 4 * fq;
        if (u.pn < 12 && u.pm < MP / 256) {
            const int q = u.pn >> 2;
#pragma unroll
            for (int ai = 0; ai < 2; ++ai)
#pragma unroll
                for (int m = 0; m < 4; ++m) { const int row = row0 + ai * 128 + m * 16, b = row >> 12, t = row & (TP - 1);
#pragma unroll
                    for (int bj = 0; bj < 2; ++bj)
#pragma unroll
                        for (int n = 0; n < 2; ++n) { const int head = (u.pn & 3) * 4 + 2 * bj + (wc >> 1), ch = 32 * (wc & 1) + 16 * n + 4 * fq; const f32x4 v = acc[ai][bj][m][n];
                            u32x2 w; w.x = pk2(v.x, v.y); w.y = pk2(v.z, v.w); *(u32x2*)(SCN + ((size_t)(b * NH + head) * TP + t) * 448 + q * 64 + ch) = w; } }
        } else if (u.pn < 12) { const int slot = u.pn < 4 ? 0 : (u.pn < 8 ? 1 : vslot); float* dst = RKV + (size_t)slot * MT * D; const int cb = (u.pn & 3) * 256;
#pragma unroll
            for (int ai = 0; ai < 2; ++ai)
#pragma unroll
                for (int m = 0; m < 4; ++m) { const int row = row0 + ai * 128 + m * 16;
#pragma unroll
                    for (int bj = 0; bj < 2; ++bj)
#pragma unroll
                        for (int n = 0; n < 2; ++n) *(f32x4*)(dst + (size_t)row * D + cb + cl0 + bj * 128 + n * 16) = acc[ai][bj][m][n]; }
        } else {
            const int q = u.pn - 12; const int lim = q == 0 ? 64 : (q == 1 ? 64 : (q == 2 ? 160 : 96)); const int base = q == 0 ? 0 : (q == 1 ? 64 : (q == 2 ? 128 : 288));
#pragma unroll
            for (int ai = 0; ai < 2; ++ai)
#pragma unroll
                for (int m = 0; m < 4; ++m) { const int row = row0 + ai * 128 + m * 16;
#pragma unroll
                    for (int bj = 0; bj < 2; ++bj)
#pragma unroll
                        for (int n = 0; n < 2; ++n) { const int c = cl0 + bj * 128 + n * 16; if (c < lim) { f32x4 v = acc[ai][bj][m][n];
                            if (q == 0) { v.x = tanh_fast(v.x); v.y = tanh_fast(v.y); v.z = tanh_fast(v.z); v.w = tanh_fast(v.w); }
                            if (q == 2) { v.x = sigmoidf_(v.x); v.y = sigmoidf_(v.y); v.z = sigmoidf_(v.z); v.w = sigmoidf_(v.w); }
                            if (q == 3 && c >= 32) v = (f32x4){0.f, 0.f, 0.f, 0.f};
                            u32x2 w; w.x = pk2(v.x, v.y); w.y = pk2(v.z, v.w); *(u32x2*)(LH + (size_t)row * KR3 + base + c) = w; } } }
        }
    }
};
struct PMR2 { const char* XS; const char* B;
    __device__ __forceinline__ const char* a(const Unit& u) const { const int s = u.pn < 4 ? 0 : (u.pn < 8 ? 1 : (u.pn < 12 ? 2 : (u.pn == 15 ? 2 : u.pn - 9))); return XS + ((size_t)s * MT + (size_t)u.pm * 256) * D * 2; }
    __device__ __forceinline__ const char* b(const Unit& u) const { return B + (size_t)u.pn * 256 * D * 2; } };
struct EpiR3 {
    static constexpr bool PERM = false;
    float* LU; bf16_t* SCN;
    __device__ __forceinline__ void operator()(const f32x4 (&acc)[2][2][4][2], const Unit& u, int wr, int wc, int fr, int fq) const {
        const int row0 = u.pm * 256 + wr * 64 + fr, col0 = u.pn * 256 + wc * 32 + 4 * fq;
        if (u.pm < MP / 256) { const int q = 3 + (u.pn >> 2);
#pragma unroll
            for (int ai = 0; ai < 2; ++ai)
#pragma unroll
                for (int m = 0; m < 4; ++m) { const int row = row0 + ai * 128 + m * 16, b = row >> 12, t = row & (TP - 1);
#pragma unroll
                    for (int bj = 0; bj < 2; ++bj)
#pragma unroll
                        for (int n = 0; n < 2; ++n) { const int head = (u.pn & 3) * 4 + 2 * bj + (wc >> 1), ch = 32 * (wc & 1) + 16 * n + 4 * fq; const f32x4 v = acc[ai][bj][m][n];
                            u32x2 w; w.x = pk2(v.x, v.y); w.y = pk2(v.z, v.w); *(u32x2*)(SCN + ((size_t)(b * NH + head) * TP + t) * 448 + q * 64 + ch) = w; } }
        } else {
#pragma unroll
            for (int ai = 0; ai < 2; ++ai)
#pragma unroll
                for (int m = 0; m < 4; ++m) { float* rowp = LU + (size_t)(row0 + ai * 128 + m * 16) * NR3 + col0;
#pragma unroll
                    for (int bj = 0; bj < 2; ++bj)
#pragma unroll
                        for (int n = 0; n < 2; ++n) *(f32x4*)(rowp + bj * 128 + n * 16) = acc[ai][bj][m][n]; } }
    }
};
struct EpiF32 {
    static constexpr bool PERM = false;
    float* C; int ldc;
    __device__ __forceinline__ void operator()(const f32x4 (&acc)[2][2][4][2], const Unit& u, int wr, int wc, int fr, int fq) const {
        const int row0 = u.pm * 256 + wr * 64 + fr, col0 = u.pn * 256 + wc * 32 + 4 * fq;
#pragma unroll
        for (int ai = 0; ai < 2; ++ai)
#pragma unroll
            for (int m = 0; m < 4; ++m) { float* rowp = C + (size_t)(row0 + ai * 128 + m * 16) * ldc + col0;
#pragma unroll
                for (int bj = 0; bj < 2; ++bj)
#pragma unroll
                    for (int n = 0; n < 2; ++n) *(f32x4*)(rowp + bj * 128 + n * 16) = acc[ai][bj][m][n]; }
    }
};
struct EpiKV {
    static constexpr bool PERM = false;
    float* out; float* winp; const LAS float* tbl; mutable int k;
    __device__ __forceinline__ void operator()(const f32x4 (&acc)[2][2][4][2], const Unit& u, int wr, int wc, int fr, int fq) const {
        const int row0 = u.pm * 256 + wr * 64 + fr, col0 = u.pn * 256 + wc * 32 + 4 * fq; const LAS float* tk = tbl + k * 256 + wr * 64 + fr; ++k;
#pragma unroll
        for (int ai = 0; ai < 2; ++ai)
#pragma unroll
            for (int m = 0; m < 4; ++m) { const int row = row0 + ai * 128 + m * 16; const float ir = tk[ai * 128 + m * 16];
#pragma unroll
                for (int bj = 0; bj < 2; ++bj)
#pragma unroll
                    for (int n = 0; n < 2; ++n) { const int c = col0 + bj * 128 + n * 16; const f32x4 v = acc[ai][bj][m][n] * ir;
                        if (c < 1024) { float* dst = row < MP ? out + O_PCS + (size_t)row * 1024 + c : out + O_SCS + (size_t)(row - MP) * 1024 + c; *(f32x4*)dst = v; }
                        else { const int c2 = c - 1024;
                            if (row < MP) { *(f32x4*)(winp + (size_t)row * 512 + c2) = v; const int t = row & (TP - 1), b = row >> 12;
                                if (t >= TP - 512) *(f32x4*)(out + O_PWIN + ((size_t)b * 512 + (t - (TP - 512))) * 512 + c2) = v; }
                            else { const int ms = row - MP, b = ms >> 2, t = ms & 3; *(f32x4*)(out + O_SWIN + ((size_t)b * 512 + 508 + t) * 512 + c2) = v; } } } }
    }
};
struct EpiQI {
    static constexpr bool PERM = false;
    float* QG; bf16_t* QB; const LAS float* tbl; mutable int k;
    __device__ __forceinline__ void operator()(const f32x4 (&acc)[2][2][4][2], const Unit& u, int wr, int wc, int fr, int fq) const {
        const int row0 = u.pm * 256 + wr * 64 + fr, col0 = u.pn * 256 + wc * 32 + 4 * fq; const LAS float* tk = tbl + k * 256 + wr * 64 + fr; ++k;
#pragma unroll
        for (int ai = 0; ai < 2; ++ai)
#pragma unroll
            for (int m = 0; m < 4; ++m) { const int row = row0 + ai * 128 + m * 16; const float ir = tk[ai * 128 + m * 16];
#pragma unroll
                for (int bj = 0; bj < 2; ++bj)
#pragma unroll
                    for (int n = 0; n < 2; ++n) { const int c = col0 + bj * 128 + n * 16; f32x4 v = acc[ai][bj][m][n] * ir;
                        if (c < 1024) { v = v * 0.125f; const f32x4 v2 = v * 1.4426950408889634f; u32x2 w; w.x = pk2(v2.x, v2.y); w.y = pk2(v2.z, v2.w); *(u32x2*)(QB + (size_t)row * D + c) = w; }
                        else { v.x = sigmoidf_(v.x); v.y = sigmoidf_(v.y); v.z = sigmoidf_(v.z); v.w = sigmoidf_(v.w); }
                        *(f32x4*)(QG + (size_t)row * NQI + c) = v; } }
    }
};
struct OrderC1 { int G, c;
    __device__ bool next(int i, Unit& u) const { const int L = i * G + c; if (L >= 2 * (CROWS / 256)) return false; u.pn = L / (CROWS / 256); u.pm = L % (CROWS / 256); u.k0 = 0; u.nk = 0; return true; } };
struct PMC1 { const char* A; const char* B;
    __device__ __forceinline__ const char* a(const Unit& u) const { return A + ((size_t)u.pn * CROWS + (size_t)u.pm * 256) * 1024 * 2; }
    __device__ __forceinline__ const char* b(const Unit& u) const { return B + (size_t)u.pn * 256 * 1024 * 2; } };
struct EpiC1 {
    static constexpr bool PERM = false;
    float* C;
    __device__ __forceinline__ void operator()(const f32x4 (&acc)[2][2][4][2], const Unit& u, int wr, int wc, int fr, int fq) const {
        const int row0 = u.pm * 256 + wr * 64 + fr, col0 = wc * 32 + 4 * fq;
#pragma unroll
        for (int ai = 0; ai < 2; ++ai)
#pragma unroll
            for (int m = 0; m < 4; ++m) { float* rowp = C + ((size_t)u.pn * CROWS + row0 + ai * 128 + m * 16) * 256 + col0;
#pragma unroll
                for (int bj = 0; bj < 2; ++bj)
#pragma unroll
                    for (int n = 0; n < 2; ++n) *(f32x4*)(rowp + bj * 128 + n * 16) = acc[ai][bj][m][n]; }
    }
};


#ifndef EN_P0
#define EN_P0 1
#endif
#ifndef EN_GEMM
#define EN_GEMM 1
#endif
#ifndef EN_ELT
#define EN_ELT 1
#endif
#ifndef EN_SCAN
#define EN_SCAN 1
#endif
#ifndef EN_ATT
#define EN_ATT 1
#endif

__device__ __forceinline__ int vt_slot(int k) { const int kk = k & 15; return (k & ~15) + ((kk >> 2) & 1) * 8 + (kk & 3) + 4 * (kk >> 3); }
struct RowInfo { int stream, b, t, tlen; };
__device__ __forceinline__ RowInfo row_info(int m) { RowInfo r; if (m < MP) { r.stream = 0; r.b = m >> 12; r.t = m & (TP - 1); r.tlen = TP; } else { const int ms = m - MP; r.stream = 1; r.b = ms >> 2; r.t = ms & 3; r.tlen = TS; } return r; }

__device__ __forceinline__ void transpose_item(const float* W, int ldw, int nvalid, int k0, int n0, bf16_t* WT, int ldk, int drow0, const float* kscale, LAS float* scr, int lane) {
    float tv[32], kv[32];
#pragma unroll
    for (int i = 0; i < 32; ++i) { const int kk = 2 * i + (lane >> 5), col = n0 + (lane & 31); tv[i] = col < nvalid ? W[(size_t)(k0 + kk) * ldw + col] : 0.f; }
    if (kscale) {
#pragma unroll
        for (int i = 0; i < 32; ++i) kv[i] = kscale[k0 + 2 * i + (lane >> 5)]; }
#pragma unroll
    for (int i = 0; i < 32; ++i) { const int kk = 2 * i + (lane >> 5); float v = tv[i]; if (kscale) v *= kv[i]; scr[kk * 33 + (lane & 31)] = v; }
    LDS_WAIT(); asm volatile("" ::: "memory");
    const int c = lane & 7;
    float rv[4][8];
#pragma unroll
    for (int j = 0; j < 4; ++j) { const int n = (lane >> 3) + 8 * j; const LAS float* s = scr + (8 * c) * 33 + n;
#pragma unroll
        for (int e = 0; e < 8; ++e) rv[j][e] = s[e * 33]; }
    __builtin_amdgcn_sched_barrier(0);
#pragma unroll
    for (int j = 0; j < 4; ++j) { const int n = (lane >> 3) + 8 * j;
        u32x4 o; o.x = pk2(rv[j][0], rv[j][1]); o.y = pk2(rv[j][2], rv[j][3]); o.z = pk2(rv[j][4], rv[j][5]); o.w = pk2(rv[j][6], rv[j][7]);
        *(u32x4*)(WT + (size_t)(drow0 + n) * ldk + k0 + 8 * c) = o; }
    LDS_WAIT(); asm volatile("" ::: "memory");
}
__device__ __forceinline__ void transpose_matrix(Frame& F, const float* W, int K, int N, int nvalid, bf16_t* WT, int ldk, int drow_base, const float* kscale, LAS float* scr) {
    const int ng = (N + 31) / 32, nk = K / 64, nit = ng * nk;
    { const int st = F.gw - F.rot; for (int it = st < 0 ? st + F.NGW : st; it < nit; it += F.NGW) { const int kb = it / ng, nb = it % ng; transpose_item(W, N, nvalid, kb * 64, nb * 32, WT, ldk, drow_base + nb * 32, kscale, scr, F.lane); } }
    F.rot = (F.rot + nit) % F.NGW;
}
__device__ __forceinline__ void zero_bf16(Frame& F, bf16_t* p, size_t n8) {
    u32x4 z = (u32x4){0u, 0u, 0u, 0u};
    for (size_t i = (size_t)F.bx * NTHREADS + F.tid; i < n8; i += (size_t)F.G * NTHREADS) ((u32x4*)p)[i] = z;
}
__device__ __forceinline__ void p0_ffn(Frame& F, int lf, LAS float* scr) {
    const float* norm_g = INF(7);
    const float* Win = INF(8) + (size_t)lf * D * 2 * DFF; bf16_t* WT = WSP(bf16_t, WS_WIN) + (size_t)lf * 2 * DFF * D;
    const float* g = norm_g + (size_t)((lf >> 1) * 3 + ((lf & 1) ? 2 : 0)) * D;
    const int ng = 2 * DFF / 32, nit = ng * (D / 64);
    const int st0_ = F.gw - F.rot; F.rot = (F.rot + nit) % F.NGW;
    for (int it = st0_ < 0 ? st0_ + F.NGW : st0_; it < nit; it += F.NGW) { const int kb = it / ng, nb = it % ng; const int col = nb * 32; const int isup = col >= DFF, j = isup ? col - DFF : col;
        const int drow = (j >> 7) * 256 + isup * 128 + (j & 127);
        transpose_item(Win, 2 * DFF, 2 * DFF, kb * 64, col, WT, D, drow, g, scr, F.lane); }
    transpose_matrix(F, INF(9) + (size_t)lf * DFF * D, DFF, D, D, WSP(bf16_t, WS_WOUT) + (size_t)lf * D * DFF, DFF, 0, nullptr, scr);
}
__device__ __forceinline__ void p0_rwkv(Frame& F, int l, bool with_lora, LAS float* scr) {
    bf16_t* W2 = WSP(bf16_t, WS_WR2) + (size_t)l * NR2 * D;
    for (int c = 0; c < 3; ++c) transpose_matrix(F, INF(11) + ((size_t)l * 3 + c) * D * D, D, D, D, W2, D, c * 1024, nullptr, scr);
    if (!with_lora) zero_bf16(F, W2 + (size_t)3072 * D, (size_t)1024 * D * 2 / 16);
    else {
        zero_bf16(F, W2 + (size_t)3136 * D, (size_t)(3328 - 3136) * D * 2 / 16); zero_bf16(F, W2 + (size_t)3392 * D, (size_t)(3584 - 3392) * D * 2 / 16);
        zero_bf16(F, W2 + (size_t)3744 * D, (size_t)(3840 - 3744) * D * 2 / 16); zero_bf16(F, W2 + (size_t)3872 * D, (size_t)(4096 - 3872) * D * 2 / 16);
        transpose_matrix(F, INF(13) + (size_t)l * D * 64, D, 64, 64, W2, D, 3072, nullptr, scr);
        transpose_matrix(F, INF(16) + (size_t)l * D * 64, D, 64, 64, W2, D, 3328, nullptr, scr);
        transpose_matrix(F, INF(18) + (size_t)l * D * 160, D, 160, 160, W2, D, 3584, nullptr, scr);
        transpose_matrix(F, INF(27), D, 32, 32, W2, D, 3840, nullptr, scr); }
    transpose_matrix(F, INF(25) + (size_t)l * D * D, D, D, D, WSP(bf16_t, WS_WRO) + (size_t)l * D * D, D, 0, nullptr, scr);
    bf16_t* W3 = WSP(bf16_t, WS_WR3) + (size_t)l * NR3 * KR3;
    const size_t nth3 = (size_t)F.G * NTHREADS;
    for (size_t i0 = (size_t)F.bx * NTHREADS + F.tid; i0 < (size_t)NR3 * KR3; i0 += 4 * nth3) { float v[4];
#pragma unroll
        for (int e = 0; e < 4; ++e) { const size_t i = i0 + e * nth3; v[e] = 0.f; if (i < (size_t)NR3 * KR3) { const int n = (int)(i / KR3), k = (int)(i % KR3), q = n >> 10, ch = n & 1023;
            if (q == 0) { if (k < 64) v[e] = INF(14)[((size_t)l * 64 + k) * D + ch]; }
            else if (q == 1) { if (k >= 64 && k < 128) v[e] = INF(17)[((size_t)l * 64 + (k - 64)) * D + ch]; }
            else if (q == 2) { if (k >= 128 && k < 288) v[e] = INF(19)[((size_t)l * 160 + (k - 128)) * D + ch]; }
            else { if (l == 1 && k >= 288 && k < 320) v[e] = INF(28)[(size_t)(k - 288) * D + ch]; } } }
#pragma unroll
        for (int e = 0; e < 4; ++e) { const size_t i = i0 + e * nth3; if (i < (size_t)NR3 * KR3) W3[i] = (bf16_t)f2bf(v[e]); } }
}
constexpr int SWIN_SPLIT = 96;
__device__ __forceinline__ void swin_copy(Frame& F, int b_lo, int b_hi) {
    const size_t per = (size_t)508 * 512 / 4; const f32x4* cw = (const f32x4*)INF(3); f32x4* sw = (f32x4*)(F.out + O_SWIN);
    const size_t nth = (size_t)F.G * NTHREADS, tot = (size_t)(b_hi - b_lo) * per;
    for (size_t i0 = (size_t)F.bx * NTHREADS + F.tid; i0 < tot; i0 += 8 * nth) { f32x4 v[8];
#pragma unroll
        for (int q = 0; q < 8; ++q) { const size_t i = i0 + q * nth; if (i < tot) { const size_t b = b_lo + i / per, r = i % per; v[q] = cw[b * (512 * 512 / 4) + 4 * 512 / 4 + r]; } }
#pragma unroll
        for (int q = 0; q < 8; ++q) { const size_t i = i0 + q * nth; if (i < tot) { const size_t b = b_lo + i / per, r = i % per; sw[b * (512 * 512 / 4) + r] = v[q]; } } }
}
__device__ __forceinline__ void p0_part(Frame& F, int part) {
    LAS float* scr = (LAS float*)(F.lds + F.wave * 16384);
    F.rot = 0;
    if (part == 0) {
        p0_ffn(F, 0, scr); p0_ffn(F, 1, scr); p0_rwkv(F, 0, false, scr);
        for (int grp = F.gw; grp < MT / 4; grp += F.NGW) { f32x4 v[4][4];
#pragma unroll
            for (int q = 0; q < 4; ++q) { const int m = grp * 4 + q; const float* src = m < MP ? INF(0) + (size_t)m * D : INF(1) + (size_t)(m - MP) * D;
#pragma unroll
                for (int j = 0; j < 4; ++j) v[q][j] = *(const f32x4*)(src + j * 256 + F.lane * 4); }
#pragma unroll
            for (int q = 0; q < 4; ++q) { const int m = grp * 4 + q; float ss = 0.f;
#pragma unroll
                for (int j = 0; j < 4; ++j) { const f32x4 x = v[q][j]; *(f32x4*)(WSP(float, WS_H) + (size_t)m * D + j * 256 + F.lane * 4) = x;
                    u32x2 w; w.x = pk2(x.x, x.y); w.y = pk2(x.z, x.w); *(u32x2*)(WSP(bf16_t, WS_HB) + (size_t)m * D + j * 256 + F.lane * 4) = w; ss += (x.x * x.x + x.y * x.y) + (x.z * x.z + x.w * x.w); }
                ss = wave_sum(ss); if (F.lane < 16) WSP(float, WS_RS)[(size_t)m * 16 + F.lane] = F.lane == 0 ? ss : 0.f; } }
    } else if (part == 1) {
        p0_ffn(F, 2, scr); p0_ffn(F, 3, scr); p0_rwkv(F, 1, true, scr);
        swin_copy(F, 0, 64);
    } else {
        const float* norm_g = INF(7);
        for (int lf = 4; lf < 6; ++lf) p0_ffn(F, lf, scr);
        for (int l = 0; l < 2; ++l) {
            transpose_matrix(F, INF(34) + (size_t)l * D * 1072, D, 1072, 1072, WSP(bf16_t, WS_WQI) + (size_t)l * NQI * D, D, 0, norm_g + (size_t)((2 + l) * 3 + 1) * D, scr);
            zero_bf16(F, WSP(bf16_t, WS_WQI) + (size_t)l * NQI * D + (size_t)1088 * D, (size_t)(NQI - 1088) * D * 2 / 16);
            transpose_matrix(F, INF(35) + (size_t)l * D * D, D, D, D, WSP(bf16_t, WS_WBO) + (size_t)l * D * D, D, 0, nullptr, scr);
            transpose_matrix(F, INF(32) + (size_t)l * 2048 * 128, 1024, 128, 128, WSP(bf16_t, WS_WC1) + (size_t)l * 256 * 1024, 1024, 0, nullptr, scr);
            transpose_matrix(F, INF(32) + (size_t)l * 2048 * 128 + (size_t)1024 * 128, 1024, 128, 128, WSP(bf16_t, WS_WC1) + (size_t)l * 256 * 1024, 1024, 128, nullptr, scr); }
        transpose_matrix(F, INF(30), D, NKVW, NKVW, WSP(bf16_t, WS_WKV), D, 0, INF(29), scr);
        for (int o = F.gw; o < 256; o += F.NGW) { const int which = o >> 7, n = o & 127; float s = 0.f;
            for (int k = F.lane; k < 2048; k += 64) s += INF(31)[(size_t)which * 2048 + k] * INF(32)[((size_t)which * 2048 + k) * 128 + n];
            s = wave_sum(s); if (F.lane == 0) WSP(float, WS_POSB)[o] = s; }
    }
}
__device__ __forceinline__ void p0b_prologue(Frame& F) {
    LAS float* scr = (LAS float*)(F.lds + F.wave * 16384);
    F.rot = 0;
    bf16_t* W2 = WSP(bf16_t, WS_WR2);
    transpose_matrix(F, INF(13), D, 64, 64, W2, D, 3072, nullptr, scr);
    transpose_matrix(F, INF(16), D, 64, 64, W2, D, 3328, nullptr, scr);
    transpose_matrix(F, INF(18), D, 160, 160, W2, D, 3584, nullptr, scr);
}

__device__ __forceinline__ void r1_phase(Frame& F, int l) {
    const float* H = WSP(float, WS_H); const float* g = INF(7) + (size_t)(l * 3 + 1) * D; const float* mu = INF(10) + (size_t)l * 6 * D; bf16_t* XS = WSP(bf16_t, WS_XS);
    for (int grp = F.gw; grp < MT / 4; grp += F.NGW) { const int m0 = grp * 4; const RowInfo ri = row_info(m0);
        f32x4 x[5][4]; float ss[5];
#pragma unroll
        for (int q = 0; q < 5; ++q) { const int m = m0 - 1 + q;
            if (q > 0 || ri.t > 0) {
#pragma unroll
                for (int j = 0; j < 4; ++j) x[q][j] = *(const f32x4*)(H + (size_t)m * D + j * 256 + F.lane * 4); }
            else {
#pragma unroll
                for (int j = 0; j < 4; ++j) x[q][j] = (f32x4){0.f, 0.f, 0.f, 0.f}; } }
        __builtin_amdgcn_sched_barrier(0);
#pragma unroll
        for (int q = 0; q < 5; ++q) { ss[q] = 0.f;
#pragma unroll
            for (int j = 0; j < 4; ++j) ss[q] += (x[q][j].x * x[q][j].x + x[q][j].y * x[q][j].y) + (x[q][j].z * x[q][j].z + x[q][j].w * x[q][j].w); }
#pragma unroll
        for (int q = 0; q < 5; ++q) ss[q] = 1.0f / sqrtf(wave_sum(ss[q]) * (1.0f / D) + RMS_EPS);
#pragma unroll
        for (int j = 0; j < 4; ++j) { const int c = j * 256 + F.lane * 4; const f32x4 gg = *(const f32x4*)(g + c);
#pragma unroll
            for (int q = 0; q < 5; ++q) x[q][j] = x[q][j] * ss[q] * gg;
            if (ri.t == 0) x[0][j] = ri.stream == 1 ? *(const f32x4*)(INF(4) + ((size_t)l * NBS + ri.b) * D + c) : (f32x4){0.f, 0.f, 0.f, 0.f};
            f32x4 mm[6];
#pragma unroll
            for (int s6 = 0; s6 < 6; ++s6) mm[s6] = *(const f32x4*)(mu + (size_t)s6 * D + c);
#pragma unroll
            for (int q = 1; q < 5; ++q) { const int m = m0 - 1 + q; const f32x4 xx = x[q - 1][j] - x[q][j];
#pragma unroll
                for (int s6 = 0; s6 < 6; ++s6) { const f32x4 v = x[q][j] + xx * mm[s6]; u32x2 w; w.x = pk2(v.x, v.y); w.y = pk2(v.z, v.w); *(u32x2*)(XS + ((size_t)s6 * MT + m) * D + c) = w; } }
            if (ri.t + 4 == ri.tlen) { float* dst = ri.stream == 0 ? F.out + O_PSHIFT + ((size_t)l * NBP + ri.b) * D + c : F.out + O_SSHIFT + ((size_t)l * NBS + ri.b) * D + c; *(f32x4*)dst = x[4][j]; }
        }
    }
}

__device__ __forceinline__ float softplusf_(float x) { return fmaxf(x, 0.f) + log1pf(__expf(-fabsf(x))); }
__device__ __forceinline__ void r4_phase(Frame& F, int l) {
    const float* R = WSP(float, WS_RKV); const float* Kk = R + (size_t)MT * D; const float* V = R + (size_t)(2 + l) * MT * D; const float* VF = R + (size_t)2 * MT * D;
    const float* LU = WSP(float, WS_LU); float* SV = WSP(float, WS_SV);
    const float* w0 = INF(12) + (size_t)l * D; const float* a0 = INF(15) + (size_t)l * D; const float* k_k = INF(20) + (size_t)l * D; const float* k_a = INF(21) + (size_t)l * D; const float* v0 = INF(26);
    for (int m = MP + F.gw; m < MT; m += F.NGW) {
        const RowInfo ri = row_info(m); const int h = F.lane >> 2, j0 = (F.lane & 3) * 16, c0 = F.lane * 16;
        float* si = ri.stream == 0 ? WSP(float, WS_SIP) + (size_t)l * SIP_L + ((size_t)(ri.b * NH + h) * TP + ri.t) * SIW : WSP(float, WS_SIS) + (size_t)l * SIS_L + ((size_t)(ri.b * NH + h) * TS + ri.t) * SIW;
        float ss = 0.f;
#pragma unroll
        for (int q = 0; q < 4; ++q) { const f32x4 k = *(const f32x4*)(Kk + (size_t)m * D + c0 + q * 4), kk = *(const f32x4*)(k_k + c0 + q * 4); const f32x4 p = k * kk; ss += (p.x * p.x + p.y * p.y) + (p.z * p.z + p.w * p.w); }
        ss += shflx(ss, 1); ss += shflx(ss, 2);
        const float rn = 1.0f / sqrtf(fmaxf(ss, 1e-24f));
#pragma unroll
        for (int q = 0; q < 4; ++q) { const int c = c0 + q * 4, j = j0 + q * 4;
            const f32x4 r = *(const f32x4*)(R + (size_t)m * D + c), k = *(const f32x4*)(Kk + (size_t)m * D + c); f32x4 v = *(const f32x4*)(V + (size_t)m * D + c);
            const f32x4 wp = *(const f32x4*)(LU + (size_t)m * NR3 + c), ap = *(const f32x4*)(LU + (size_t)m * NR3 + 1024 + c);
            const f32x4 w0v = *(const f32x4*)(w0 + c), a0v = *(const f32x4*)(a0 + c), kkv = *(const f32x4*)(k_k + c), kav = *(const f32x4*)(k_a + c);
            f32x4 dec, a, km, an, bn;
#pragma unroll
            for (int e = 0; e < 4; ++e) { const float wl = -softplusf_(-(w0v[e] + wp[e])) - 0.5f; dec[e] = __expf(-__expf(wl)); a[e] = sigmoidf_(a0v[e] + ap[e]);
                const float kn = k[e] * kkv[e] * rn; an[e] = -kn; bn[e] = kn * a[e]; km[e] = k[e] * (1.0f + (a[e] - 1.0f) * kav[e]); }
            if (l == 1) { const f32x4 vg = *(const f32x4*)(LU + (size_t)m * NR3 + 3072 + c), v0v = *(const f32x4*)(v0 + c), vf = *(const f32x4*)(VF + (size_t)m * D + c);
#pragma unroll
                for (int e = 0; e < 4; ++e) v[e] = v[e] + (vf[e] - v[e]) * sigmoidf_(v0v[e] + vg[e]); }
            *(f32x4*)(si + 0 * 64 + j) = dec; *(f32x4*)(si + 1 * 64 + j) = km; *(f32x4*)(si + 2 * 64 + j) = an; *(f32x4*)(si + 3 * 64 + j) = bn; *(f32x4*)(si + 4 * 64 + j) = r;
            *(f32x4*)(SV + (size_t)m * D + c) = v; }
    }
}

__device__ __forceinline__ void scan_chain(const float* si_g, const float* v, float* y, int tlen, const float* s0, float* sT, int lane) {
    float s[64];
    if (s0) {
#pragma unroll
        for (int q = 0; q < 16; ++q) { const f32x4 t = *(const f32x4*)(s0 + (size_t)lane * 64 + q * 4); s[q * 4] = t.x; s[q * 4 + 1] = t.y; s[q * 4 + 2] = t.z; s[q * 4 + 3] = t.w; }
    } else {
#pragma unroll
        for (int j = 0; j < 64; ++j) s[j] = 0.f;
    }
    const CAS float* sp = (const CAS float*)(unsigned long long)si_g;
    for (int t = 0; t < tlen; ++t) {
        const float vi = v[(size_t)t * D + lane];
        float sa = 0.f;
#pragma unroll
        for (int j = 0; j < 64; ++j) sa += s[j] * sp[128 + j];
        float yy = 0.f;
#pragma unroll
        for (int j = 0; j < 64; ++j) { s[j] = s[j] * sp[j] + sa * sp[192 + j] + vi * sp[64 + j]; yy += s[j] * sp[256 + j]; }
        y[(size_t)t * D + lane] = yy;
        sp += SIW;
    }
#pragma unroll
    for (int q = 0; q < 16; ++q) *(f32x4*)(sT + (size_t)lane * 64 + q * 4) = (f32x4){s[q * 4], s[q * 4 + 1], s[q * 4 + 2], s[q * 4 + 3]};
}
__device__ __forceinline__ void r5_phase(Frame& F, int l) {
    const float* SV = WSP(float, WS_SV); float* YS = WSP(float, WS_YS);
    if (F.wave == 0 && F.bx < NCH_P) { const int ch = F.bx, b = ch >> 4, h = ch & 15;
        scan_chain(WSP(float, WS_SIP) + (size_t)l * SIP_L + (size_t)ch * TP * SIW, SV + (size_t)b * TP * D + h * 64, YS + (size_t)b * TP * D + h * 64, TP, nullptr, F.out + O_PWKV + ((size_t)(l * NBP + b) * NH + h) * 4096, F.lane);
    } else {
        const int nworkers = F.G * NWAVES - NCH_P; int widx = (F.wave == 0) ? F.bx - NCH_P : NCH_P * 0 + (F.G - NCH_P) + F.bx * (NWAVES - 1) + (F.wave - 1);
        for (int ch = widx; ch < NCH_S; ch += nworkers) { const int b = ch >> 4, h = ch & 15;
            scan_chain(WSP(float, WS_SIS) + (size_t)l * SIS_L + (size_t)ch * TS * SIW, SV + (size_t)(MP + b * TS) * D + h * 64, YS + (size_t)(MP + b * TS) * D + h * 64, TS,
                       INF(5) + ((size_t)(l * NBS + b) * NH + h) * 4096, F.out + O_SWKV + ((size_t)(l * NBS + b) * NH + h) * 4096, F.lane); }
        __syncthreads(); { Frame F2 = F; F2.bx = F.bx - NCH_P; F2.G = F.G - NCH_P; F2.gw = F2.bx * NWAVES + F.wave; F2.NGW = F2.G * NWAVES; p0_part(F2, 1 + l); }
    }
}


constexpr int NCHK = TP / 64;
#define RL(x, j) __builtin_bit_cast(float, __builtin_amdgcn_readlane(__builtin_bit_cast(int, (x)), (j)))
__device__ __forceinline__ float dpp_add(float v, const int ctrl_sel) {
    int r;
    if (ctrl_sel == 0) r = __builtin_amdgcn_update_dpp(0, __builtin_bit_cast(int, v), 0xB1, 0xF, 0xF, true);
    else if (ctrl_sel == 1) r = __builtin_amdgcn_update_dpp(0, __builtin_bit_cast(int, v), 0x4E, 0xF, 0xF, true);
    else if (ctrl_sel == 2) r = __builtin_amdgcn_update_dpp(0, __builtin_bit_cast(int, v), 0x141, 0xF, 0xF, true);
    else r = __builtin_amdgcn_update_dpp(0, __builtin_bit_cast(int, v), 0x140, 0xF, 0xF, true);
    return v + __builtin_bit_cast(float, r); }
__device__ __forceinline__ float wave_sum_dpp(float v) { v = dpp_add(v, 0); v = dpp_add(v, 1); v = dpp_add(v, 2); v = dpp_add(v, 3); return (RL(v, 0) + RL(v, 16)) + (RL(v, 32) + RL(v, 48)); }
struct StepIn { float w, k, a, b, r, v; };
struct RawIn { float r, k, v, wp, ap, vg, vf; };
struct ChanC { float w0, a0, kk, ka, v0; };
__device__ __forceinline__ float bf2f(bf16_t u) { return __builtin_bit_cast(float, (unsigned)u << 16); }
__device__ __forceinline__ void rawin_load(RawIn& x, const bf16_t* rec_, int lane, int l) {
    const GAS bf16_t* rec = (const GAS bf16_t*)rec_; const GAS bf16_t* rec0 = rec - (size_t)l * SCN_L; const unsigned o = (unsigned)lane;
    const GAS bf16_t* pl = rec + o;
    x.r = bf2f(pl[0]); x.k = bf2f(pl[64]); x.v = bf2f(pl[128]); x.wp = bf2f(pl[192]); x.ap = bf2f(pl[256]);
    if (l == 1) { x.vg = bf2f(pl[384]); x.vf = bf2f((rec0 + o)[128]); } else { x.vg = 0.f; x.vf = 0.f; } }
__device__ __forceinline__ void rawin_xform(StepIn& s, const RawIn& x, const LAS float* cb, int l) {
    ChanC cc; cc.w0 = cb[0]; cc.a0 = cb[64]; cc.kk = cb[128]; cc.ka = cb[192]; cc.v0 = cb[256];
    const float z = -(cc.w0 + x.wp); const float wl = -(fmaxf(z, 0.f) + __logf(1.0f + __expf(-fabsf(z)))) - 0.5f;
    s.w = __expf(-__expf(wl)); const float a = __builtin_amdgcn_rcpf(1.0f + __expf(-(cc.a0 + x.ap)));
    const float kk = x.k * cc.kk; const float ss = wave_sum_dpp(kk * kk); const float kn = kk * __builtin_amdgcn_rsqf(fmaxf(ss, 1e-24f));
    s.a = -kn; s.b = kn * a; s.k = x.k * (1.0f + (a - 1.0f) * cc.ka); s.r = x.r;
    s.v = (l == 1) ? x.v + (x.vf - x.v) * __builtin_amdgcn_rcpf(1.0f + __expf(-(cc.v0 + x.vg))) : x.v; }
struct SG8 { f32x4 bk[4], r4[2]; };
__device__ __forceinline__ f32x2 fma2(f32x2 a, f32x2 b, f32x2 c) { return __builtin_elementwise_fma(a, b, c); }
__device__ __forceinline__ void stepA(f32x2 (&g)[32], f32x2 (&tt)[32], const StepIn& s, LAS float* sb, int lane, float& y0, float& q) {
    { const int jp = (lane >> 1) * 4 + (lane & 1); sb[lane] = s.a; sb[64 + jp] = s.b; sb[64 + jp + 2] = s.k; sb[192 + lane] = s.r; }
    asm volatile("s_waitcnt lgkmcnt(0)" ::: "memory");
    f32x2 sga = (f32x2){0.f, 0.f}, sta = (f32x2){0.f, 0.f}; LAS float* pb = sb;
    f32x4 a4[16];
#pragma unroll
    for (int jq = 0; jq < 16; ++jq) a4[jq] = *(const LAS f32x4*)(pb + 4 * jq);
    SG8 d0, d1, d2;
#define SA_LD(gi, d) do { _Pragma("unroll") for (int e = 0; e < 4; ++e) d.bk[e] = *(const LAS f32x4*)(pb + 64 + 4 * (4 * (gi) + e)); \
        _Pragma("unroll") for (int e = 0; e < 2; ++e) d.r4[e] = *(const LAS f32x4*)(pb + 192 + 4 * (2 * (gi) + e)); } while (0)
#define SA_CP(gi, d) do { _Pragma("unroll") for (int e = 0; e < 4; ++e) { const int jp = 4 * (gi) + e; const f32x2 b2 = (f32x2){d.bk[e].x, d.bk[e].y}, k2 = (f32x2){d.bk[e].z, d.bk[e].w}; \
        const f32x2 r2 = (e & 1) ? (f32x2){d.r4[e >> 1].z, d.r4[e >> 1].w} : (f32x2){d.r4[e >> 1].x, d.r4[e >> 1].y}; \
        g[jp] = fma2(sv2, k2, fma2(sg2, b2, g[jp])); tt[jp] = fma2(st2, b2, tt[jp]); yab = fma2(g[jp], r2, yab); qab = fma2(tt[jp], r2, qab); } \
        asm volatile("" : "+v"(pb), "+v"(yab), "+v"(qab)); } while (0)
    SA_LD(0, d0);
#pragma unroll
    for (int jq = 0; jq < 16; ++jq) { const f32x2 lo = (f32x2){a4[jq].x, a4[jq].y}, hi = (f32x2){a4[jq].z, a4[jq].w};
        sga = fma2(g[2 * jq], lo, sga); sga = fma2(g[2 * jq + 1], hi, sga); sta = fma2(tt[2 * jq], lo, sta); sta = fma2(tt[2 * jq + 1], hi, sta); }
    const float sg = sga.x + sga.y, st = sta.x + sta.y; const f32x2 sg2 = (f32x2){sg, sg}, st2 = (f32x2){st, st}, sv2 = (f32x2){s.v, s.v}; f32x2 yab = (f32x2){0.f, 0.f}, qab = (f32x2){0.f, 0.f};
    asm volatile("" : "+v"(pb), "+v"(yab));
    SA_LD(1, d1); SA_LD(2, d2);
    SA_CP(0, d0); SA_LD(3, d0); SA_CP(1, d1); SA_LD(4, d1); SA_CP(2, d2); SA_LD(5, d2); SA_CP(3, d0); SA_LD(6, d0);
    SA_CP(4, d1); SA_LD(7, d1); SA_CP(5, d2); SA_CP(6, d0); SA_CP(7, d1);
#undef SA_LD
#undef SA_CP
    y0 = yab.x + yab.y; q = qab.x + qab.y;
    asm volatile("" ::: "memory");
}
__device__ __forceinline__ float stepC(float (&g)[64], const StepIn& s) {
    float sg0 = 0.f, sg1 = 0.f;
#pragma unroll
    for (int j = 0; j < 64; j += 2) { sg0 = fmaf(g[j], RL(s.a, j), sg0); sg1 = fmaf(g[j + 1], RL(s.a, j + 1), sg1); if ((j & 15) == 14) __builtin_amdgcn_sched_barrier(0); }
    const float sg = sg0 + sg1; float y0 = 0.f, y1 = 0.f;
#pragma unroll
    for (int j = 0; j < 64; j += 2) {
        g[j] = fmaf(s.v, RL(s.k, j), fmaf(sg, RL(s.b, j), g[j] * RL(s.w, j))); y0 = fmaf(g[j], RL(s.r, j), y0);
        g[j + 1] = fmaf(s.v, RL(s.k, j + 1), fmaf(sg, RL(s.b, j + 1), g[j + 1] * RL(s.w, j + 1))); y1 = fmaf(g[j + 1], RL(s.r, j + 1), y1);
        if ((j & 7) == 6) __builtin_amdgcn_sched_barrier(0); }
    return y0 + y1;
}
__device__ __forceinline__ void scanA_phase(Frame& F, int l) {
    const bf16_t* SCN = WSP(bf16_t, WS_SCN) + (size_t)l * SCN_L; float* TG = WSP(float, WS_TG);
    for (int job = F.gw; job < NCH_P * NCHK; job += F.NGW) { const int ch = job >> 6, c = job & 63, b = ch >> 4, h = ch & 15; const size_t m0 = (size_t)b * TP + c * 64;
        int lane_; asm volatile("v_mbcnt_lo_u32_b32 %0, -1, 0\n\tv_mbcnt_hi_u32_b32 %0, -1, %0" : "=v"(lane_)); const int lane = lane_, cn = h * 64 + lane;
        f32x2 g[32], tt[32]; LAS float* sb = (LAS float*)(F.lds + F.wave * 4096); LAS float* cb = sb + 320 + lane;
        cb[0] = INF(12)[(size_t)l * D + cn]; cb[64] = INF(15)[(size_t)l * D + cn]; cb[128] = INF(20)[(size_t)l * D + cn]; cb[192] = INF(21)[(size_t)l * D + cn]; cb[256] = INF(26)[cn]; cb[320] = INF(22)[(size_t)l * D + cn];
#pragma unroll
        for (int j = 0; j < 32; ++j) { g[j] = (f32x2){0.f, 0.f}; tt[j] = (f32x2){(2 * j == lane) ? 1.f : 0.f, (2 * j + 1 == lane) ? 1.f : 0.f}; }
        const size_t rbase = ((size_t)ch * TP + c * 64) * 448;
        StepIn s; float Pj = 1.0f; unsigned ur, uk, uv, uw, ua, ug = 0u, uf = 0u; const unsigned vo = (unsigned)lane * 2u;
#define GLD_U16(dst, base, OFF) asm volatile("global_load_ushort %0, %1, %2 offset:" #OFF : "=v"(dst) : "v"(vo), "s"(base) : "memory")
#define RAW_ISSUE(tt_) do { const unsigned long long a_ = (unsigned long long)(SCN + rbase + (size_t)(tt_) * 448); \
            const unsigned long long rb_ = ((unsigned long long)(unsigned)__builtin_amdgcn_readfirstlane((unsigned)(a_ >> 32)) << 32) | (unsigned)__builtin_amdgcn_readfirstlane((unsigned)a_); \
            GLD_U16(ur, rb_, 0); GLD_U16(uk, rb_, 128); GLD_U16(uv, rb_, 256); GLD_U16(uw, rb_, 384); GLD_U16(ua, rb_, 512); \
            if (l == 1) { GLD_U16(ug, rb_, 768); const unsigned long long r0_ = rb_ - (unsigned long long)SCN_L * 2ull; GLD_U16(uf, r0_, 256); } } while (0)
        RAW_ISSUE(0);
        GAS float* yq = (GAS float*)(WSP(float, WS_YQ) + (size_t)job * 12288);
        float py0 = 0.f, pq = 0.f, pvb = 0.f;
#pragma unroll 1
        for (int t = 0; t < 64; ++t) {
            asm volatile("s_waitcnt vmcnt(0)" : "+v"(ur), "+v"(uk), "+v"(uv), "+v"(uw), "+v"(ua), "+v"(ug), "+v"(uf) : : "memory");
            if (t > 0) { const unsigned o = (unsigned)((t - 1) * 64 + lane); yq[o] = py0; yq[4096 + o] = pq; yq[8192 + o] = pvb; }
            RawIn x0; x0.r = __builtin_bit_cast(float, ur << 16); x0.k = __builtin_bit_cast(float, uk << 16); x0.v = __builtin_bit_cast(float, uv << 16); x0.wp = __builtin_bit_cast(float, uw << 16); x0.ap = __builtin_bit_cast(float, ua << 16);
            x0.vg = __builtin_bit_cast(float, ug << 16); x0.vf = __builtin_bit_cast(float, uf << 16);
            asm volatile("" : "+v"(x0.r), "+v"(x0.k), "+v"(x0.v), "+v"(x0.wp), "+v"(x0.ap), "+v"(x0.vg), "+v"(x0.vf));
            if (t + 1 < 64) RAW_ISSUE(t + 1);
            rawin_xform(s, x0, cb, l);
            const float bon = wave_sum_dpp(s.r * s.k * cb[320]);
            { const float Pp = Pj; Pj *= s.w; const float iP = __builtin_amdgcn_rcpf(Pj); s.a *= Pp; s.b *= iP; s.k *= iP; s.r *= Pj; }
            float y0, q; stepA(g, tt, s, sb, lane, y0, q); py0 = y0; pq = q; pvb = s.v * bon; }
        { const unsigned o = (unsigned)(63 * 64 + lane); yq[o] = py0; yq[4096 + o] = pq; yq[8192 + o] = pvb; }
#undef RAW_ISSUE
#undef GLD_U16
        float* gt = TG + (size_t)job * 8192; float* tm = gt + 4096;
        sb[lane] = Pj; asm volatile("s_waitcnt lgkmcnt(0)" ::: "memory");
#pragma unroll
        for (int j = 0; j < 32; ++j) { const f32x2 p2 = *(const LAS f32x2*)(sb + 2 * j); g[j] = g[j] * p2; tt[j] = tt[j] * p2; }
#pragma unroll
        for (int j = 0; j < 32; ++j) { gt[(2 * j) * 64 + lane] = g[j].x; gt[(2 * j + 1) * 64 + lane] = g[j].y; }
#pragma unroll
        for (int q = 0; q < 16; ++q) *(f32x4*)(tm + lane * 64 + q * 4) = (f32x4){tt[2 * q].x, tt[2 * q].y, tt[2 * q + 1].x, tt[2 * q + 1].y};
    }
}
__device__ __forceinline__ void scanC_phase(Frame& F, int l) {
    const bf16_t* SCN = WSP(bf16_t, WS_SCN) + (size_t)l * SCN_L; bf16_t* YG = WSP(bf16_t, WS_YG); const float* SS = WSP(float, WS_SS);
    const int lane = F.lane, c16 = lane & 15, g4 = lane >> 4;
    for (int job = F.gw; job < NCH_P * NCHK; job += F.NGW) { const int ch = job >> 6, c = job & 63, b = ch >> 4, h = ch & 15; const size_t m0 = (size_t)b * TP + c * 64;
        const float* yq = WSP(float, WS_YQ) + (size_t)job * 12288; const float* sp = SS + (size_t)job * 4096;
        float lw[4], lb[4];
#pragma unroll
        for (int ct = 0; ct < 4; ++ct) { lw[ct] = INF(23)[(size_t)l * D + h * 64 + 16 * ct + c16]; lb[ct] = INF(24)[(size_t)l * D + h * 64 + 16 * ct + c16]; }
        float sv[16][4];
        if (c > 0) {
#pragma unroll
            for (int ks = 0; ks < 16; ++ks)
#pragma unroll
                for (int ct = 0; ct < 4; ++ct) sv[ks][ct] = sp[(16 * ct + c16) * 64 + 4 * ks + g4]; }
#pragma unroll 1
        for (int tt = 0; tt < 4; ++tt) {
            f32x4 acc[4]; float av[16], vbv[4][4], gtv[4][4];
#pragma unroll
            for (int ct = 0; ct < 4; ++ct)
#pragma unroll
                for (int rg = 0; rg < 4; ++rg) acc[ct][rg] = yq[(16 * tt + 4 * g4 + rg) * 64 + 16 * ct + c16];
#pragma unroll
            for (int ks = 0; ks < 16; ++ks) av[ks] = yq[4096 + (16 * tt + c16) * 64 + 4 * ks + g4];
#pragma unroll
            for (int rg = 0; rg < 4; ++rg)
#pragma unroll
                for (int ct = 0; ct < 4; ++ct) { const int t = 16 * tt + 4 * g4 + rg, i = 16 * ct + c16; vbv[rg][ct] = yq[8192 + t * 64 + i]; gtv[rg][ct] = bf2f(SCN[((size_t)ch * TP + c * 64 + t) * 448 + 320 + i]); }
            if (c > 0) {
#pragma unroll
                for (int ks = 0; ks < 16; ++ks)
#pragma unroll
                    for (int ct = 0; ct < 4; ++ct) acc[ct] = __builtin_amdgcn_mfma_f32_16x16x4f32(av[ks], sv[ks][ct], acc[ct], 0, 0, 0); }
#pragma unroll
            for (int rg = 0; rg < 4; ++rg) { const int t = 16 * tt + 4 * g4 + rg;
                float s1 = (acc[0][rg] + acc[1][rg]) + (acc[2][rg] + acc[3][rg]);
                s1 += shflx(s1, 1); s1 += shflx(s1, 2); s1 += shflx(s1, 4); s1 += shflx(s1, 8);
                const float mean = s1 * (1.0f / 64.0f); float d[4], s2 = 0.f;
#pragma unroll
                for (int ct = 0; ct < 4; ++ct) { d[ct] = acc[ct][rg] - mean; s2 += d[ct] * d[ct]; }
                s2 += shflx(s2, 1); s2 += shflx(s2, 2); s2 += shflx(s2, 4); s2 += shflx(s2, 8);
                const float rstd = 1.0f / sqrtf(s2 * (1.0f / 64.0f) + GN_EPS);
#pragma unroll
                for (int ct = 0; ct < 4; ++ct) { const int i = 16 * ct + c16;
                    YG[(m0 + t) * D + h * 64 + i] = (bf16_t)f2bf((d[ct] * rstd * lw[ct] + lb[ct] + vbv[rg][ct]) * gtv[rg][ct]); } }
        }
    }
}
__device__ __forceinline__ void scanB_phase(Frame& F, int l) {
    if (F.bx < NCH_P) {
        const int ch = F.bx, b = ch >> 4, h = ch & 15, w = F.wave, lane = F.lane, c16 = lane & 15, g4 = lane >> 4;
        const float* TG = WSP(float, WS_TG) + (size_t)ch * NCHK * 8192; float* SS = WSP(float, WS_SS) + (size_t)ch * NCHK * 4096;
        LAS float* TL = (LAS float*)F.lds;
        LAS float* SL = (LAS float*)(F.lds + 49152) + w * (16 * 68);
        LAS float* GL = (LAS float*)(F.lds + 81920);
        if (w < 4) { for (int e = lane; e < 16 * 68; e += 64) SL[e] = 0.f; }
#define SCANB_DMA(cc_) do { const char* src_ = (const char*)(TG + (size_t)(cc_) * 8192 + 4096); LAS char* dst_ = (LAS char*)TL + ((cc_) % 3) * 16384; \
        _Pragma("unroll") for (int i4 = 0; i4 < 4; ++i4) __builtin_amdgcn_global_load_lds((const unsigned*)(src_ + (i4 * 256 + (w - 4) * 64 + lane) * 16), (LAS unsigned*)(dst_ + (i4 * 256 + (w - 4) * 64) * 16), 16, 0, 0); \
        const char* srg_ = (const char*)(TG + (size_t)(cc_) * 8192); LAS char* dsg_ = (LAS char*)GL + ((cc_) % 3) * 16384; \
        _Pragma("unroll") for (int i4 = 0; i4 < 4; ++i4) { const int s_ = i4 * 256 + (w - 4) * 64 + lane, R_ = s_ >> 4; \
            __builtin_amdgcn_global_load_lds((const unsigned*)(srg_ + (R_ * 16 + ((s_ & 15) ^ (R_ & 15))) * 16), (LAS unsigned*)(dsg_ + (i4 * 256 + (w - 4) * 64) * 16), 16, 0, 0); } } while (0)
        if (w >= 4) { SCANB_DMA(0); SCANB_DMA(1); asm volatile("s_waitcnt vmcnt(8)" ::: "memory"); }
        asm volatile("s_waitcnt lgkmcnt(0)" ::: "memory"); __syncthreads();
        for (int c = 0; c < NCHK; ++c) {
            if (w >= 4 && c + 2 < NCHK) SCANB_DMA(c + 2);
            if (w < 4) { const LAS float* tl = TL + (c % 3) * 4096; const LAS float* gl = GL + (c % 3) * 4096; f32x4 acc[4], gv[4];
#pragma unroll
                for (int ct = 0; ct < 4; ++ct) acc[ct] = (f32x4){0.f, 0.f, 0.f, 0.f};
                float av[16], tv[2][4][4];
#pragma unroll
                for (int ks = 0; ks < 16; ++ks) av[ks] = SL[c16 * 68 + 4 * ks + g4];
#pragma unroll
                for (int ct = 0; ct < 4; ++ct) gv[ct] = *(const LAS f32x4*)(gl + (16 * ct + c16) * 64 + 4 * ((4 * w + g4) ^ c16));
#pragma unroll
                for (int k4 = 0; k4 < 4; ++k4)
#pragma unroll
                    for (int ct = 0; ct < 4; ++ct) tv[0][k4][ct] = tl[(4 * k4 + g4) * 64 + 16 * ct + c16];
                __builtin_amdgcn_sched_barrier(0);
#pragma unroll
                for (int grp = 0; grp < 4; ++grp) {
                    if (grp < 3) {
#pragma unroll
                        for (int k4 = 0; k4 < 4; ++k4)
#pragma unroll
                            for (int ct = 0; ct < 4; ++ct) tv[(grp + 1) & 1][k4][ct] = tl[(4 * (4 * (grp + 1) + k4) + g4) * 64 + 16 * ct + c16]; }
                    __builtin_amdgcn_sched_barrier(0);
#pragma unroll
                    for (int k4 = 0; k4 < 4; ++k4)
#pragma unroll
                        for (int ct = 0; ct < 4; ++ct) acc[ct] = __builtin_amdgcn_mfma_f32_16x16x4f32(av[4 * grp + k4], tv[grp & 1][k4][ct], acc[ct], 0, 0, 0);
                    __builtin_amdgcn_sched_barrier(0); }
#pragma unroll
                for (int ct = 0; ct < 4; ++ct) acc[ct] = acc[ct] + gv[ct];
                asm volatile("s_waitcnt lgkmcnt(0)" ::: "memory");
                GAS float* so = (GAS float*)((c + 1 < NCHK) ? SS + (size_t)(c + 1) * 4096 : F.out + O_PWKV + ((size_t)(l * NBP + b) * NH + h) * 4096);
#pragma unroll
                for (int ct = 0; ct < 4; ++ct)
#pragma unroll
                    for (int rg = 0; rg < 4; ++rg) { SL[(4 * g4 + rg) * 68 + 16 * ct + c16] = acc[ct][rg]; so[(16 * w + 4 * g4 + rg) * 64 + 16 * ct + c16] = acc[ct][rg]; }
                asm volatile("s_waitcnt lgkmcnt(0)" ::: "memory");
            }
            if (w >= 4) { if (c + 2 < NCHK) asm volatile("s_waitcnt vmcnt(8)" ::: "memory"); else asm volatile("s_waitcnt vmcnt(0)" ::: "memory"); }
            __syncthreads();
        }
#undef SCANB_DMA
    } else {
        const float* SV = WSP(float, WS_SV); float* YS = WSP(float, WS_YS);
        const int nworkers = (F.G - NCH_P) * NWAVES; const int widx = (F.bx - NCH_P) * NWAVES + F.wave;
        for (int ch = widx; ch < NCH_S; ch += nworkers) { const int b = ch >> 4, h = ch & 15;
            scan_chain(WSP(float, WS_SIS) + (size_t)l * SIS_L + (size_t)ch * TS * SIW, SV + (size_t)(MP + b * TS) * D + h * 64, YS + (size_t)(MP + b * TS) * D + h * 64, TS,
                       INF(5) + ((size_t)(l * NBS + b) * NH + h) * 4096, F.out + O_SWKV + ((size_t)(l * NBS + b) * NH + h) * 4096, F.lane); }
        __syncthreads(); { Frame F2 = F; F2.bx = F.bx - NCH_P; F2.G = F.G - NCH_P; F2.gw = F2.bx * NWAVES + F.wave; F2.NGW = F2.G * NWAVES; p0_part(F2, 1 + l); }
    }
}

__device__ __forceinline__ void r5b_phase(Frame& F, int l) {
    const float* YS = WSP(float, WS_YS); const float* SV = WSP(float, WS_SV); const float* LU = WSP(float, WS_LU); bf16_t* YG = WSP(bf16_t, WS_YG);
    const float* lw = INF(23) + (size_t)l * D; const float* lb = INF(24) + (size_t)l * D; const float* rk = INF(22) + (size_t)l * D;
    for (int m = MP + F.gw; m < MT; m += F.NGW) {
        const RowInfo ri = row_info(m); const int h = F.lane >> 2, j0 = (F.lane & 3) * 16, c0 = F.lane * 16;
        const float* si = ri.stream == 0 ? WSP(float, WS_SIP) + (size_t)l * SIP_L + ((size_t)(ri.b * NH + h) * TP + ri.t) * SIW : WSP(float, WS_SIS) + (size_t)l * SIS_L + ((size_t)(ri.b * NH + h) * TS + ri.t) * SIW;
        f32x4 y[4]; float s1 = 0.f, bon = 0.f;
#pragma unroll
        for (int q = 0; q < 4; ++q) { y[q] = *(const f32x4*)(YS + (size_t)m * D + c0 + q * 4); s1 += (y[q].x + y[q].y) + (y[q].z + y[q].w);
            const f32x4 k = *(const f32x4*)(si + 64 + j0 + q * 4), r = *(const f32x4*)(si + 256 + j0 + q * 4), rkv = *(const f32x4*)(rk + c0 + q * 4);
            bon += (r.x * k.x * rkv.x + r.y * k.y * rkv.y) + (r.z * k.z * rkv.z + r.w * k.w * rkv.w); }
        s1 += shflx(s1, 1); s1 += shflx(s1, 2); bon += shflx(bon, 1); bon += shflx(bon, 2);
        const float mean = s1 * (1.0f / 64.0f); float s2 = 0.f;
#pragma unroll
        for (int q = 0; q < 4; ++q) { const f32x4 d = y[q] - mean; s2 += (d.x * d.x + d.y * d.y) + (d.z * d.z + d.w * d.w); }
        s2 += shflx(s2, 1); s2 += shflx(s2, 2);
        const float rstd = 1.0f / sqrtf(s2 * (1.0f / 64.0f) + GN_EPS);
#pragma unroll
        for (int q = 0; q < 4; ++q) { const int c = c0 + q * 4; const f32x4 w = *(const f32x4*)(lw + c), b = *(const f32x4*)(lb + c), v = *(const f32x4*)(SV + (size_t)m * D + c), g = *(const f32x4*)(LU + (size_t)m * NR3 + 2048 + c);
            const f32x4 o = ((y[q] - mean) * rstd * w + b + v * bon) * g;
            u32x2 ww; ww.x = pk2(o.x, o.y); ww.y = pk2(o.z, o.w); *(u32x2*)(YG + (size_t)m * D + c) = ww; }
    }
}

__device__ __forceinline__ const float* cst_src(Frame& F, int it, int p, int d0) {
    const float* cache = INF(2); const int* pt = (const int*)F.in[6]; const int which = it / CROWS, row = it % CROWS;
    if (row < CROWS_S) { const int bk = row >> 7, n = row & 127, b = bk >> 2, kvh = bk & 3, pos = 16 * n + p; const int page = pt[b * NPG + (pos >> 7)];
        return cache + (((size_t)page * PAGE + (pos & 127)) * 4 + which) * 256 + kvh * 64 + d0; }
    const int r2 = row - CROWS_S, bk = r2 >> 8, n = r2 & 255, b = bk >> 2, kvh = bk & 3, pos = 16 * n + p;
    return F.out + O_PCS + (((size_t)b * TP + pos) * 4 + which) * 256 + kvh * 64 + d0; }
__device__ __forceinline__ void cst_phase(Frame& F) {
    bf16_t* CST = WSP(bf16_t, WS_CST);
    const int p = F.lane >> 2, d0 = (F.lane & 3) * 16;
    for (int it0 = F.gw; it0 < 2 * CROWS; it0 += 4 * F.NGW) { const float* src[4]; f32x4 v[4][4];
#pragma unroll
        for (int q = 0; q < 4; ++q) { const int it = it0 + q * F.NGW; src[q] = cst_src(F, it < 2 * CROWS ? it : it0, p, d0); }
#pragma unroll
        for (int q = 0; q < 4; ++q)
#pragma unroll
            for (int e = 0; e < 4; ++e) v[q][e] = *(const f32x4*)(src[q] + 4 * e);
#pragma unroll
        for (int q = 0; q < 4; ++q) { const int it = it0 + q * F.NGW; if (it < 2 * CROWS) { u32x4 w0, w1;
            w0.x = pk2(v[q][0].x, v[q][0].y); w0.y = pk2(v[q][0].z, v[q][0].w); w0.z = pk2(v[q][1].x, v[q][1].y); w0.w = pk2(v[q][1].z, v[q][1].w);
            w1.x = pk2(v[q][2].x, v[q][2].y); w1.y = pk2(v[q][2].z, v[q][2].w); w1.z = pk2(v[q][3].x, v[q][3].y); w1.w = pk2(v[q][3].z, v[q][3].w);
            bf16_t* dst = CST + (size_t)it * 1024 + p * 64 + d0; *(u32x4*)dst = w0; *(u32x4*)(dst + 8) = w1; } }
    }
}
__device__ __forceinline__ float gelu_tanh(float x) { const float u = 0.7978845608028654f * (x + 0.044715f * x * x * x); return 0.5f * x * (1.0f + tanh_fast(u)); }
__device__ __forceinline__ void c2_phase(Frame& F) {
    const float* CH = WSP(float, WS_CH); float* KC = WSP(float, WS_KCMP); const float* posb = WSP(float, WS_POSB); LAS float* hv = (LAS float*)(F.lds + F.wave * 2048);
    for (int it0 = F.gw * 4; it0 < 2 * CROWS; it0 += 4 * F.NGW) { const int which = it0 / CROWS, row0 = it0 % CROWS;
        const float* w2 = INF(33) + (size_t)which * 128 * 64;
        float xl[4][2], xh[4][2], pb[2];
#pragma unroll
        for (int e = 0; e < 2; ++e) pb[e] = posb[which * 128 + F.lane + 64 * e];
#pragma unroll
        for (int q = 0; q < 4; ++q) { const int row = row0 + q; bool has_hi; if (row < CROWS_S) has_hi = (row & 127) != 127; else has_hi = ((row - CROWS_S) & 255) != 255;
            const float* lo = CH + ((size_t)which * CROWS + row) * 256; const float* hi = has_hi ? lo + 256 + 128 : lo;
#pragma unroll
            for (int e = 0; e < 2; ++e) { const int c = F.lane + 64 * e; xl[q][e] = lo[c]; const float hval = hi[c]; xh[q][e] = has_hi ? hval : 0.f; } }
        __builtin_amdgcn_sched_barrier(0);
#pragma unroll
        for (int q = 0; q < 4; ++q)
#pragma unroll
            for (int e = 0; e < 2; ++e) { const int c = F.lane + 64 * e; const float x = xl[q][e] + xh[q][e] + pb[e]; hv[c * 4 + q] = gelu_tanh(x); }
        LDS_WAIT(); asm volatile("" ::: "memory");
        float o0 = 0.f, o1 = 0.f, o2 = 0.f, o3 = 0.f;
        const GAS float* w2g = (const GAS float*)w2 + F.lane;
#pragma unroll 32
        for (int c = 0; c < 128; ++c) { const float w = w2g[c * 64]; const f32x4 h4 = *(const LAS f32x4*)(hv + c * 4); o0 += h4.x * w; o1 += h4.y * w; o2 += h4.z * w; o3 += h4.w * w; }
#pragma unroll
        for (int q = 0; q < 4; ++q) { const int row = row0 + q; const float o = q == 0 ? o0 : (q == 1 ? o1 : (q == 2 ? o2 : o3));
            KC[((size_t)which * CROWS + row) * 64 + F.lane] = o;
            if (row >= CROWS_S) { const int r2 = row - CROWS_S, bkc = r2 >> 8, n = r2 & 255; bf16_t* KCB = WSP(bf16_t, WS_KCB);
                if (which == 0) KCB[(size_t)r2 * 64 + F.lane] = (bf16_t)f2bf(o);
                else KCB[(size_t)16 * 256 * 64 + ((size_t)(bkc * 4 + (n >> 6)) * 64 + F.lane) * 64 + vt_slot(n & 63)] = (bf16_t)f2bf(o); } }
        LDS_WAIT(); asm volatile("" ::: "memory"); }
}


constexpr size_t KVB = (size_t)16 * TP * 64;
__device__ __forceinline__ void kvstage_phase(Frame& F) {
    bf16_t* KS = WSP(bf16_t, WS_KVS); const float* winp = WSP(float, WS_WINP);
    for (int it = F.gw; it < 16 * 64 * 4; it += F.NGW) { const int which = it & 3, blk = (it >> 2) & 63, bk = it >> 8, b = bk >> 2, kvh = bk & 3;
        const float* src; size_t pitch;
        if (which < 2) { src = F.out + O_PCS + ((size_t)(b * TP + blk * 64) * 4 + 2 + which) * 256 + kvh * 64; pitch = 1024; }
        else { src = winp + (size_t)(b * TP + blk * 64) * 512 + (which - 2) * 256 + kvh * 64; pitch = 512; }
        bf16_t* dst = KS + (size_t)which * KVB + ((size_t)bk * TP + blk * 64) * 64;
        if ((which & 1) == 0) { const float* rp = src + (size_t)F.lane * pitch; u32x4 w[8];
#pragma unroll
            for (int c = 0; c < 8; ++c) { const f32x4 a = *(const f32x4*)(rp + c * 8), bq = *(const f32x4*)(rp + c * 8 + 4); w[c].x = pk2(a.x, a.y); w[c].y = pk2(a.z, a.w); w[c].z = pk2(bq.x, bq.y); w[c].w = pk2(bq.z, bq.w); }
#pragma unroll
            for (int c = 0; c < 8; ++c) *(u32x4*)(dst + (size_t)F.lane * 64 + c * 8) = w[c];
        } else { float v[64];
#pragma unroll
            for (int k = 0; k < 64; ++k) v[k] = src[(size_t)k * pitch + F.lane];
#pragma unroll
            for (int c = 0; c < 8; ++c) { u32x4 w;
                const int kb = 16 * (c >> 1) + 4 * (c & 1);
                w.x = pk2(v[kb + 0], v[kb + 1]); w.y = pk2(v[kb + 2], v[kb + 3]); w.z = pk2(v[kb + 8], v[kb + 9]); w.w = pk2(v[kb + 10], v[kb + 11]);
                *(u32x4*)(dst + (size_t)F.lane * 64 + c * 8) = w; } }
    }
}

typedef __bf16 bf16x2v __attribute__((ext_vector_type(2)));
typedef float f32x16 __attribute__((ext_vector_type(16)));
#define MFMA32(a, b, c) __builtin_amdgcn_mfma_f32_32x32x16_bf16((a), (b), (c), 0, 0, 0)
__device__ __forceinline__ unsigned cvtpk(float a, float b) { f32x2 v; v.x = a; v.y = b; return __builtin_bit_cast(unsigned, __builtin_convertvector(v, bf16x2v)); }
template <int S> __device__ __forceinline__ bf16x8 pack8(const f32x16& x) { u32x4 p; p.x = cvtpk(x[8 * S], x[8 * S + 1]); p.y = cvtpk(x[8 * S + 2], x[8 * S + 3]); p.z = cvtpk(x[8 * S + 4], x[8 * S + 5]); p.w = cvtpk(x[8 * S + 6], x[8 * S + 7]); return __builtin_bit_cast(bf16x8, p); }
__device__ __forceinline__ void xchg32(float v, float& lo, float& hi) { const auto r = __builtin_amdgcn_permlane32_swap(__builtin_bit_cast(unsigned, v), __builtin_bit_cast(unsigned, v), false, false); lo = __builtin_bit_cast(float, r[0]); hi = __builtin_bit_cast(float, r[1]); }
constexpr int AP_KB = 64 * 128, AP_BUF = 2 * AP_KB, AP_IMPG = 2 * AP_BUF, AP_SELM = AP_IMPG + 4 * 64 * 65 * 4, AP_UNI = AP_SELM + 512, AP_PARK = AP_IMPG, AP_QF = AP_UNI + 64, AP_GATE = 133120;
constexpr float LOG2E = 1.4426950408889634f;
__device__ __forceinline__ void tile_dma(const bf16_t* kg, const bf16_t* vg, LAS unsigned char* buf, int wave, int lane) {
    const int row = wave * 8 + (lane >> 3), cs = (lane & 7) ^ ((row >> 1) & 7), off = row * 128 + cs * 16;
    __builtin_amdgcn_global_load_lds((const unsigned*)((const char*)kg + off), (LAS unsigned*)(buf + wave * 1024), 16, 0, 0);
    __builtin_amdgcn_global_load_lds((const unsigned*)((const char*)vg + off), (LAS unsigned*)(buf + AP_KB + wave * 1024), 16, 0, 0);
}
#define TILE_SYNC() do { asm volatile("s_waitcnt vmcnt(0)" ::: "memory"); __syncthreads(); } while (0)
__device__ __forceinline__ void ap_scores(f32x16 (&sc)[2], const LAS unsigned char* kb, const LAS unsigned char* qf, const int ka0) {
    bf16x8 qv[4];
#pragma unroll
    for (int ds = 0; ds < 4; ++ds) qv[ds] = *(const LAS bf16x8*)(qf + ds * 1024);
#pragma unroll
    for (int kt = 0; kt < 2; ++kt) {
#pragma unroll
        for (int i = 0; i < 16; ++i) sc[kt][i] = 0.f;
#pragma unroll
        for (int ds = 0; ds < 4; ++ds) { const bf16x8 a = *(const LAS bf16x8*)(kb + kt * 4096 + (ka0 ^ (ds * 32))); sc[kt] = MFMA32(a, qv[ds], sc[kt]); }
        if (kt == 0) __builtin_amdgcn_sched_barrier(0); }
}
template <bool EDGE> __device__ __forceinline__ void ap_bias(f32x16 (&sc)[2], float bs, float b0, int lo, int hi, int h) {
    const float bh = bs * (float)(4 * h) + b0; const int lo2 = lo - 4 * h, hi2 = hi - 4 * h;
#pragma unroll
    for (int kt = 0; kt < 2; ++kt)
#pragma unroll
        for (int i = 0; i < 16; ++i) { const int c = 32 * kt + (i & 3) + 8 * (i >> 2); float x = sc[kt][i] + (bs * (float)c + bh);
            if (EDGE) x = (c >= lo2 && c <= hi2) ? x : -1e30f; sc[kt][i] = x; }
}
struct ApSt { f32x16 o0, o1; float m, l; };
__device__ __forceinline__ void ap_pv(f32x16& o0, f32x16& o1, const f32x16 (&p)[2], const LAS unsigned char* vb, const int ka0) {
    asm volatile("" ::: "memory");
    bf16x8 pf[4]; pf[0] = pack8<0>(p[0]); pf[1] = pack8<1>(p[0]); pf[2] = pack8<0>(p[1]); pf[3] = pack8<1>(p[1]);
#pragma unroll
    for (int ks = 0; ks < 4; ++ks) { const bf16x8 v0 = *(const LAS bf16x8*)(vb + (ka0 ^ (ks * 32))), v1 = *(const LAS bf16x8*)(vb + 4096 + (ka0 ^ (ks * 32)));
        o0 = MFMA32(v0, pf[ks], o0); o1 = MFMA32(v1, pf[ks], o1); }
}
template <bool EDGE> __device__ __forceinline__ void ap_online(ApSt& st, const LAS unsigned char* buf, const LAS unsigned char* qf, float bs, float b0, int lo, int hi, const int ka0, int h) {
    f32x16 sc[2]; ap_scores(sc, buf, qf, ka0); ap_bias<EDGE>(sc, bs, b0, lo, hi, h);
    float tm = -1e30f;
#pragma unroll
    for (int kt = 0; kt < 2; ++kt)
#pragma unroll
        for (int i = 0; i < 16; ++i) tm = fmaxf(tm, sc[kt][i]);
    tm = fmaxf(tm, shflx(tm, 32));
    const float mn = fmaxf(st.m, tm), mu = fmaxf(mn, -1e29f), corr = __builtin_amdgcn_exp2f(st.m - mn); float rs = 0.f;
#pragma unroll
    for (int kt = 0; kt < 2; ++kt)
#pragma unroll
        for (int i = 0; i < 16; ++i) { const float p = __builtin_amdgcn_exp2f(sc[kt][i] - mu); sc[kt][i] = p; rs += p; }
    rs += shflx(rs, 32);
    st.l = st.l * corr + rs; st.m = mn; st.o0 = st.o0 * corr; st.o1 = st.o1 * corr;
    ap_pv(st.o0, st.o1, sc, buf + AP_KB, ka0);
}
__device__ __forceinline__ void attp_phase(Frame& F, int l) {
    const bf16_t* QB = WSP(bf16_t, WS_QB); const float* QG = WSP(float, WS_QG); bf16_t* AO = WSP(bf16_t, WS_AO);
    const bf16_t* KS = WSP(bf16_t, WS_KVS); const bf16_t* VST = KS + KVB; const bf16_t* KW = KS + 2 * KVB; const bf16_t* VWT = KS + 3 * KVB;
    const bf16_t* KCB = WSP(bf16_t, WS_KCB); const bf16_t* VCT = KCB + (size_t)16 * 256 * 64;
    LAS unsigned char* lds = F.lds; LAS float* IMPG = (LAS float*)(lds + AP_IMPG); LAS unsigned long long* SELM = (LAS unsigned long long*)(lds + AP_SELM); LAS unsigned long long* UNI = (LAS unsigned long long*)(lds + AP_UNI);
    const int nun_ = F.G == 256 ? 2 : (512 + F.G - 1) / F.G;
    for (int r_ = 0; r_ < nun_; ++r_) { const int u = F.G == 256 ? (2 * (F.bx & 7) + r_) * 32 + (F.bx >> 3) : F.bx + r_ * F.G; if (u >= 512) break;
#pragma unroll 1
        for (int mem = 0; mem < 2; ++mem) {
            int wv_ = F.wave; asm volatile("" : "+v"(wv_)); const int w = __builtin_amdgcn_readfirstlane(wv_), g = w >> 1, qh = w & 1;
            int lane_; asm volatile("v_mbcnt_lo_u32_b32 %0, -1, 0\n\tv_mbcnt_hi_u32_b32 %0, -1, %0" : "=v"(lane_));
            const int lane = lane_, tid = w * 64 + lane, r = lane & 31, h = lane >> 5, q = qh * 32 + r;
            const int bk = u >> 5, ii = u & 31, i = mem ? 63 - ii : ii, b = bk >> 2, kvh = bk & 3, t0 = 64 * i, tpos = t0 + q, head = kvh * 4 + g; const size_t m = (size_t)b * TP + tpos;
            LAS unsigned char* qf = lds + AP_QF + w * 4096 + lane * 16;
#pragma unroll
            for (int ds = 0; ds < 4; ++ds) *(LAS bf16x8*)(qf + ds * 1024) = *(const bf16x8*)(QB + m * D + head * 64 + ds * 16 + h * 8);
            const float slope2 = exp2f(-0.5f * (float)(head + 1)) * LOG2E;
            const float gq0 = QG[m * NQI + 1024 + head * 3], gq1 = QG[m * NQI + 1024 + head * 3 + 1], gq2 = QG[m * NQI + 1024 + head * 3 + 2]; LAS float* gsl = (LAS float*)(lds + AP_GATE) + tid;
            LAS float* park = (LAS float*)(lds + AP_PARK) + tid;
            const int ka0 = r * 128 + ((h ^ ((r >> 1) & 7)) << 4);
            const int nct = (4 * i + 3 + 63) >> 6; const int hic = (tpos - 31) >> 4;
            const bf16_t* kc = KCB + (size_t)bk * 256 * 64; const bf16_t* vc = VCT + (size_t)bk * 256 * 64;
            float cm = -1e30f, cl = 0.f;
            tile_dma(kc, vc, lds, w, lane); TILE_SYNC();
            gsl[0] = gq0; gsl[512] = gq1; gsl[1024] = gq2;
            for (int T = 0; T < nct; ++T) { LAS unsigned char* buf = lds + (T & 1) * AP_BUF;
                if (T + 1 < nct) tile_dma(kc + (size_t)(T + 1) * 4096, vc + (size_t)(T + 1) * 4096, lds + ((T + 1) & 1) * AP_BUF, w, lane);
                f32x16 sc[2]; ap_scores(sc, buf, qf, ka0); ap_bias<true>(sc, slope2 * 16.f, slope2 * (float)(1024 * T + 31 - t0), 0, hic - 64 * T, h);
                float tm = -1e30f;
#pragma unroll
                for (int kt = 0; kt < 2; ++kt)
#pragma unroll
                    for (int e = 0; e < 16; ++e) tm = fmaxf(tm, sc[kt][e]);
                tm = fmaxf(tm, shflx(tm, 32));
                const float mn = fmaxf(cm, tm), mu = fmaxf(mn, -1e29f); float rs = 0.f;
#pragma unroll
                for (int kt = 0; kt < 2; ++kt)
#pragma unroll
                    for (int e = 0; e < 16; ++e) rs += __builtin_amdgcn_exp2f(sc[kt][e] - mu);
                rs += shflx(rs, 32);
                cl = cl * __builtin_amdgcn_exp2f(cm - mn) + rs; cm = mn;
                TILE_SYNC(); }
            f32x16 o0, o1;
            { const float cmu = fmaxf(cm, -1e29f), cinv = cl > 0.f ? 1.0f / cl : 0.f;
#pragma unroll
              for (int e = 0; e < 16; ++e) { o0[e] = 0.f; o1[e] = 0.f; }
              float carry = 0.f;
              tile_dma(kc, vc, lds, w, lane); TILE_SYNC();
              for (int T = 0; T < nct; ++T) { LAS unsigned char* buf = lds + (T & 1) * AP_BUF;
                  if (T + 1 < nct) tile_dma(kc + (size_t)(T + 1) * 4096, vc + (size_t)(T + 1) * 4096, lds + ((T + 1) & 1) * AP_BUF, w, lane);
                  f32x16 sc[2]; ap_scores(sc, buf, qf, ka0); ap_bias<true>(sc, slope2 * 16.f, slope2 * (float)(1024 * T + 31 - t0), 0, hic - 64 * T, h);
#pragma unroll
                  for (int kt = 0; kt < 2; ++kt)
#pragma unroll
                      for (int e = 0; e < 16; ++e) sc[kt][e] = __builtin_amdgcn_exp2f(sc[kt][e] - cmu) * cinv;
#pragma unroll
                  for (int kt = 0; kt < 2; ++kt) { float gs[4], xl[4];
#pragma unroll
                      for (int a = 0; a < 4; ++a) { gs[a] = (sc[kt][4 * a] + sc[kt][4 * a + 1]) + (sc[kt][4 * a + 2] + sc[kt][4 * a + 3]); xl[a] = shflx(sc[kt][4 * a + 3], 32); }
                      float val[4];
                      if (h) {
#pragma unroll
                          for (int a = 0; a < 4; ++a) val[a] = gs[a] + xl[a];
                      } else { val[0] = gs[0] + carry; val[1] = gs[1] + xl[0]; val[2] = gs[2] + xl[1]; val[3] = gs[3] + xl[2]; carry = xl[3]; }
#pragma unroll
                      for (int a = 0; a < 4; ++a) { const int blk = 16 * T + 8 * kt + 2 * a + h; IMPG[(g * 64 + q) * 65 + blk] = val[a]; } }
                  ap_pv(o0, o1, sc, buf + AP_KB, ka0);
                  TILE_SYNC(); }
            }
            { unsigned long long uni = 0ull;
#pragma unroll 1
              for (int qq = 0; qq < 8; ++qq) { const int q2 = w * 8 + qq; float val;
                  { const float imp = lane <= i ? ((IMPG[(0 * 64 + q2) * 65 + lane] + IMPG[(1 * 64 + q2) * 65 + lane]) + (IMPG[(2 * 64 + q2) * 65 + lane] + IMPG[(3 * 64 + q2) * 65 + lane])) : 0.f;
                    const bool forced = lane == 0 || lane == i || lane == i - 1; val = lane <= i ? (forced ? 1e4f : imp) : -1.f; }
                  int rank = 0;
                  for (int s2 = 0; s2 < 64; ++s2) { const float v2 = __builtin_bit_cast(float, __builtin_amdgcn_readlane(__builtin_bit_cast(int, val), s2)); rank += (v2 > val || (v2 == val && s2 < lane)) ? 1 : 0; }
                  const unsigned long long sm = __ballot(rank < 16 && lane <= i); uni |= sm; if (lane == 0) SELM[q2] = sm; }
              if (lane == 0) UNI[w] = uni; }
            __syncthreads();
            { const float g0 = gsl[0];
#pragma unroll
              for (int e = 0; e < 16; ++e) { park[e * 512] = o0[e] * g0; park[(16 + e) * 512] = o1[e] * g0; } }
            unsigned long long uni = 0ull;
#pragma unroll
            for (int ww = 0; ww < 8; ++ww) uni |= UNI[ww];
            uni = ((unsigned long long)__builtin_amdgcn_readfirstlane((unsigned)(uni >> 32)) << 32) | (unsigned)__builtin_amdgcn_readfirstlane((unsigned)uni);
            { ApSt st;
#pragma unroll
              for (int e = 0; e < 16; ++e) { st.o0[e] = 0.f; st.o1[e] = 0.f; }
              st.m = -1e30f; st.l = 0.f;
              const bf16_t* kg = KS + (size_t)bk * TP * 64; const bf16_t* vg = VST + (size_t)bk * TP * 64;
              unsigned long long rem = uni; int s = __builtin_ctzll(rem); rem &= rem - 1; int par = 0;
              tile_dma(kg + (size_t)s * 4096, vg + (size_t)s * 4096, lds, w, lane); TILE_SYNC();
              for (;;) { const int sn = rem ? __builtin_ctzll(rem) : -1; LAS unsigned char* buf = lds + par * AP_BUF;
                  if (sn >= 0) tile_dma(kg + (size_t)sn * 4096, vg + (size_t)sn * 4096, lds + (par ^ 1) * AP_BUF, w, lane);
                  const float b0 = ((SELM[q] >> s) & 1ull) ? slope2 * (float)(64 * s - t0) : -1e30f;
                  if (s == i) ap_online<true>(st, buf, qf, slope2, b0, 0, tpos - 64 * s, ka0, h); else ap_online<false>(st, buf, qf, slope2, b0, 0, 63, ka0, h);
                  if (sn < 0) break;
                  TILE_SYNC(); par ^= 1; s = sn; rem &= rem - 1; }
              __syncthreads();
              const float sc1 = gsl[512] / st.l;
#pragma unroll
              for (int e = 0; e < 16; ++e) { park[e * 512] += st.o0[e] * sc1; park[(16 + e) * 512] += st.o1[e] * sc1; } }
            { ApSt st;
#pragma unroll
              for (int e = 0; e < 16; ++e) { st.o0[e] = 0.f; st.o1[e] = 0.f; }
              st.m = -1e30f; st.l = 0.f;
              const bf16_t* kg = KW + (size_t)bk * TP * 64; const bf16_t* vg = VWT + (size_t)bk * TP * 64;
              const int wb0 = i >= 8 ? i - 8 : 0;
              tile_dma(kg + (size_t)wb0 * 4096, vg + (size_t)wb0 * 4096, lds, w, lane); TILE_SYNC();
              for (int wb = wb0; wb <= i; ++wb) { LAS unsigned char* buf = lds + ((wb - wb0) & 1) * AP_BUF;
                  if (wb < i) tile_dma(kg + (size_t)(wb + 1) * 4096, vg + (size_t)(wb + 1) * 4096, lds + ((wb + 1 - wb0) & 1) * AP_BUF, w, lane);
                  const float b0 = slope2 * (float)(64 * wb - t0);
                  if (wb == i || wb == i - 8) ap_online<true>(st, buf, qf, slope2, b0, tpos - 512 - 64 * wb, tpos - 64 * wb, ka0, h); else ap_online<false>(st, buf, qf, slope2, b0, 0, 63, ka0, h);
                  TILE_SYNC(); }
              const float sc2 = gsl[1024] / st.l;
#pragma unroll
              for (int e = 0; e < 16; ++e) { st.o0[e] = park[e * 512] + st.o0[e] * sc2; st.o1[e] = park[(16 + e) * 512] + st.o1[e] * sc2; }
              int lane2; asm volatile("v_mbcnt_lo_u32_b32 %0, -1, 0\n\tv_mbcnt_hi_u32_b32 %0, -1, %0" : "=v"(lane2));
              const int h2 = lane2 >> 5; const size_t m2 = (size_t)b * TP + t0 + qh * 32 + (lane2 & 31);
              bf16_t* orow = AO + m2 * D + head * 64 + 4 * h2;
#pragma unroll
              for (int a = 0; a < 4; ++a) { u32x2 w0, w1; w0.x = cvtpk(st.o0[4 * a], st.o0[4 * a + 1]); w0.y = cvtpk(st.o0[4 * a + 2], st.o0[4 * a + 3]); w1.x = cvtpk(st.o1[4 * a], st.o1[4 * a + 1]); w1.y = cvtpk(st.o1[4 * a + 2], st.o1[4 * a + 3]);
                  *(u32x2*)(orow + 8 * a) = w0; *(u32x2*)(orow + 32 + 8 * a) = w1; } }
        }
    }
}

#define MFMA16(a, b, c) __builtin_amdgcn_mfma_f32_16x16x32_bf16((a), (b), (c), 0, 0, 0)
__device__ __forceinline__ bf16x8 cvt8(const f32x4 a, const f32x4 b) { u32x4 p; p.x = cvtpk(a.x, a.y); p.y = cvtpk(a.z, a.w); p.z = cvtpk(b.x, b.y); p.w = cvtpk(b.z, b.w); return __builtin_bit_cast(bf16x8, p); }
struct S2K { f32x4 a[4][2], b[4][2]; };
struct S2V { float v[2][4][8]; };
__device__ __forceinline__ void s2_ldk(S2K& K, const float* kb, int kp, int kmax, int r16, int g4) {
#pragma unroll
    for (int kt = 0; kt < 4; ++kt) { const int key = min(16 * kt + r16, kmax); const float* row = kb + (size_t)key * kp + 8 * g4;
#pragma unroll
        for (int ds = 0; ds < 2; ++ds) { K.a[kt][ds] = *(const f32x4*)(row + 32 * ds); K.b[kt][ds] = *(const f32x4*)(row + 32 * ds + 4); } }
}
__device__ __forceinline__ void s2_ldv(S2V& V, const float* vb, int kp, int kmax, int r16, int g4) {
#pragma unroll
    for (int pr = 0; pr < 2; ++pr)
#pragma unroll
        for (int j = 0; j < 8; ++j) { const int key = min(16 * (2 * pr + (j >> 2)) + 4 * g4 + (j & 3), kmax); const float* row = vb + (size_t)key * kp + r16;
#pragma unroll
            for (int dt = 0; dt < 4; ++dt) V.v[pr][dt][j] = row[16 * dt]; }
}
__device__ __forceinline__ void s2_scores_r(f32x4 (&sc)[4], const S2K& K, const bf16x8 (&qf)[2]) {
#pragma unroll
    for (int kt = 0; kt < 4; ++kt) { sc[kt] = (f32x4){0.f, 0.f, 0.f, 0.f};
#pragma unroll
        for (int ds = 0; ds < 2; ++ds) sc[kt] = MFMA16(cvt8(K.a[kt][ds], K.b[kt][ds]), qf[ds], sc[kt]); }
}
__device__ __forceinline__ void s2_pv_r(f32x4 (&o)[4], const f32x4 (&p)[4], const S2V& V) {
#pragma unroll
    for (int pr = 0; pr < 2; ++pr) { u32x4 pw; pw.x = cvtpk(p[2 * pr][0], p[2 * pr][1]); pw.y = cvtpk(p[2 * pr][2], p[2 * pr][3]); pw.z = cvtpk(p[2 * pr + 1][0], p[2 * pr + 1][1]); pw.w = cvtpk(p[2 * pr + 1][2], p[2 * pr + 1][3]);
        const bf16x8 pf = __builtin_bit_cast(bf16x8, pw);
#pragma unroll
        for (int dt = 0; dt < 4; ++dt) { const float (&v)[8] = V.v[pr][dt];
            u32x4 vw; vw.x = cvtpk(v[0], v[1]); vw.y = cvtpk(v[2], v[3]); vw.z = cvtpk(v[4], v[5]); vw.w = cvtpk(v[6], v[7]);
            o[dt] = MFMA16(__builtin_bit_cast(bf16x8, vw), pf, o[dt]); } }
}
struct S2St { f32x4 o[4]; float m, l; };
__device__ __forceinline__ void s2_online(S2St& st, const float* kb, const float* vb, int kp, int kmax, const bf16x8 (&qf)[2], float slope2, int pos0, bool rowok, int lo, int hi, int r16, int g4) {
    S2K K; S2V V; s2_ldk(K, kb, kp, kmax, r16, g4); s2_ldv(V, vb, kp, kmax, r16, g4); __builtin_amdgcn_sched_barrier(0);
    f32x4 sc[4]; s2_scores_r(sc, K, qf);
    float tm = -1e30f;
#pragma unroll
    for (int kt = 0; kt < 4; ++kt)
#pragma unroll
        for (int i = 0; i < 4; ++i) { const int pos = pos0 + 16 * kt + 4 * g4 + i; const bool ok = rowok && pos >= lo && pos <= hi; const float x = ok ? sc[kt][i] + slope2 * (float)(pos - PAST) : -1e30f; sc[kt][i] = x; tm = fmaxf(tm, x); }
    tm = fmaxf(tm, shflx(tm, 16)); tm = fmaxf(tm, shflx(tm, 32));
    const float mn = fmaxf(st.m, tm), mu = fmaxf(mn, -1e29f), corr = __builtin_amdgcn_exp2f(st.m - mn); float rs = 0.f;
#pragma unroll
    for (int kt = 0; kt < 4; ++kt)
#pragma unroll
        for (int i = 0; i < 4; ++i) { const float p = __builtin_amdgcn_exp2f(sc[kt][i] - mu); sc[kt][i] = p; rs += p; }
    rs += shflx(rs, 16); rs += shflx(rs, 32);
    st.l = st.l * corr + rs; st.m = mn;
#pragma unroll
    for (int dt = 0; dt < 4; ++dt) st.o[dt] = st.o[dt] * corr;
    s2_pv_r(st.o, sc, V);
}
__device__ __forceinline__ void atts2_phase(Frame& F, int l) {
    const float* QG = WSP(float, WS_QG); bf16_t* AO = WSP(bf16_t, WS_AO); const float* KC = WSP(float, WS_KCMP); const float* VC = KC + (size_t)CROWS * 64;
    const float* cache = INF(2); const float* cwin = INF(3); const int* pt = (const int*)F.in[6];
    const int team = F.wave >> 2, mem = F.wave & 3;
    LAS unsigned char* tl = F.lds + team * 49152;
    LAS float* GS = (LAS float*)tl; LAS float* LS = GS + 16 * 33; LAS unsigned long long* MS = (LAS unsigned long long*)(tl + 6144);
    LAS float* WINP = (LAS float*)(tl + 30720);
    LAS float* SLCP = (LAS float*)(tl + 12288);
    for (int item = F.bx * 2 + team; item < NBS * NKV; item += F.G * 2) { const int b = item >> 2, kvh = item & 3;
        int lane_; asm volatile("v_mbcnt_lo_u32_b32 %0, -1, 0\n\tv_mbcnt_hi_u32_b32 %0, -1, %0" : "=v"(lane_)); const int lane = lane_, r16 = lane & 15, g4 = lane >> 4, g = r16 >> 2, t = r16 & 3, head = kvh * 4 + g, tpos = PAST + t;
        const size_t mrow = (size_t)MP + b * TS + t; const float slope2 = exp2f(-0.5f * (float)(head + 1)) * LOG2E;
        bf16x8 qf[2];
#pragma unroll
        for (int ds = 0; ds < 2; ++ds) { const float* qp = QG + mrow * NQI + head * 64 + 32 * ds + 8 * g4; const f32x4 a = *(const f32x4*)qp * LOG2E, bq = *(const f32x4*)(qp + 4) * LOG2E; qf[ds] = cvt8(a, bq); }
        f32x4 oacc[4];
#pragma unroll
        for (int dt = 0; dt < 4; ++dt) oacc[dt] = (f32x4){0.f, 0.f, 0.f, 0.f};
        if (mem == 0) {
            const float* kc = KC + (size_t)(b * 4 + kvh) * 128 * 64; const float* vc = VC + (size_t)(b * 4 + kvh) * 128 * 64;
            float cm = -1e30f, cl = 0.f;
#pragma unroll 1
            for (int T = 0; T < 2; ++T) { f32x4 sc[4]; { S2K K; s2_ldk(K, kc + (size_t)T * 64 * 64, 64, 63, r16, g4); __builtin_amdgcn_sched_barrier(0); s2_scores_r(sc, K, qf); } float tm = -1e30f;
#pragma unroll
                for (int kt = 0; kt < 4; ++kt)
#pragma unroll
                    for (int i = 0; i < 4; ++i) { const int n = 64 * T + 16 * kt + 4 * g4 + i; const float x = n <= 126 ? sc[kt][i] + slope2 * (float)(16 * n + 31 - PAST) : -1e30f; sc[kt][i] = x; tm = fmaxf(tm, x); }
                tm = fmaxf(tm, shflx(tm, 16)); tm = fmaxf(tm, shflx(tm, 32)); const float mn = fmaxf(cm, tm); float rs = 0.f;
#pragma unroll
                for (int kt = 0; kt < 4; ++kt)
#pragma unroll
                    for (int i = 0; i < 4; ++i) rs += __builtin_amdgcn_exp2f(sc[kt][i] - mn);
                rs += shflx(rs, 16); rs += shflx(rs, 32); cl = cl * __builtin_amdgcn_exp2f(cm - mn) + rs; cm = mn; }
            const float cinv = 1.0f / cl;
#pragma unroll 1
            for (int T = 0; T < 2; ++T) { f32x4 sc[4]; S2V V; { S2K K; s2_ldk(K, kc + (size_t)T * 64 * 64, 64, 63, r16, g4); s2_ldv(V, vc + (size_t)T * 64 * 64, 64, 63, r16, g4); __builtin_amdgcn_sched_barrier(0); s2_scores_r(sc, K, qf); }
#pragma unroll
                for (int kt = 0; kt < 4; ++kt) { float gs = 0.f;
#pragma unroll
                    for (int i = 0; i < 4; ++i) { const int n = 64 * T + 16 * kt + 4 * g4 + i; const float p = n <= 126 ? __builtin_amdgcn_exp2f(sc[kt][i] + slope2 * (float)(16 * n + 31 - PAST) - cm) * cinv : 0.f; sc[kt][i] = p; gs += p; }
                    const int blk = 16 * T + 4 * kt + g4; GS[r16 * 33 + blk] = gs; LS[r16 * 33 + blk] = sc[kt][3]; }
                s2_pv_r(oacc, sc, V); }
            const float g0 = QG[mrow * NQI + 1024 + head * 3];
#pragma unroll
            for (int dt = 0; dt < 4; ++dt) oacc[dt] = oacc[dt] * g0;
            asm volatile("s_waitcnt lgkmcnt(0)" ::: "memory");
            unsigned long long uni = 0ull;
#pragma unroll 1
            for (int tq = 0; tq < 4; ++tq) { float imp = 0.f;
                if (lane < 33) {
#pragma unroll
                    for (int gg = 0; gg < 4; ++gg) { const int row = gg * 4 + tq; imp += (lane < 32 ? GS[row * 33 + lane] : 0.f) + (lane > 0 ? LS[row * 33 + lane - 1] : 0.f); } }
                const bool forced = lane == 0 || lane == 32 || lane == 31; const float val = lane >= 33 ? -2.f : (forced ? 1e4f : imp);
                int rank = 0;
                for (int s2 = 0; s2 < 64; ++s2) { const float v2 = __builtin_bit_cast(float, __builtin_amdgcn_readlane(__builtin_bit_cast(int, val), s2)); rank += (v2 > val || (v2 == val && s2 < lane)) ? 1 : 0; }
                const unsigned long long sm = __ballot(rank < 16 && lane < 33); uni |= sm; if (lane == 0) MS[tq] = sm; }
            if (lane == 0) MS[4] = uni;
        } else {
            S2St st; st.m = -1e30f; st.l = 0.f;
#pragma unroll
            for (int dt = 0; dt < 4; ++dt) st.o[dt] = (f32x4){0.f, 0.f, 0.f, 0.f};
#pragma unroll 1
            for (int wt = 3 * (mem - 1); wt < 3 * mem; ++wt) { const float* kb; int kmax;
                if (wt < 8) { kb = cwin + ((size_t)b * 512 + 64 * wt) * 512 + kvh * 64; kmax = 63; } else { kb = F.out + O_SWIN + ((size_t)b * 512 + 508) * 512 + kvh * 64; kmax = TS - 1; }
                s2_online(st, kb, kb + 256, 512, kmax, qf, slope2, PAST - 512 + 64 * wt, true, tpos - 512, tpos, r16, g4); }
            LAS float* wp = WINP + ((mem - 1) * 64 + lane) * 18;
#pragma unroll
            for (int dt = 0; dt < 4; ++dt)
#pragma unroll
                for (int i = 0; i < 4; ++i) wp[dt * 4 + i] = st.o[dt][i];
            wp[16] = st.m; wp[17] = st.l;
        }
        asm volatile("s_waitcnt lgkmcnt(0)" ::: "memory"); __syncthreads();
        { const int my = mem; const unsigned long long selq = MS[t]; unsigned long long uni = MS[4];
            uni = ((unsigned long long)__builtin_amdgcn_readfirstlane((unsigned)(uni >> 32)) << 32) | (unsigned)__builtin_amdgcn_readfirstlane((unsigned)uni);
            S2St st; st.m = -1e30f; st.l = 0.f;
#pragma unroll
            for (int dt = 0; dt < 4; ++dt) st.o[dt] = (f32x4){0.f, 0.f, 0.f, 0.f};
            int n = 0;
#pragma unroll 1
            for (unsigned long long rem = uni; rem; rem &= rem - 1, ++n) { if ((n & 3) != my) continue; const int s = __builtin_ctzll(rem); const float* kb; int kmax;
                if (s < 32) { const int page = pt[b * NPG + (s >> 1)]; kb = cache + (((size_t)page * PAGE + (s & 1) * 64) * 4 + 2) * 256 + kvh * 64; kmax = 63; }
                else { kb = F.out + O_SCS + (((size_t)b * TS) * 4 + 2) * 256 + kvh * 64; kmax = TS - 1; }
                s2_online(st, kb, kb + 256, 1024, kmax, qf, slope2, 64 * s, ((selq >> s) & 1ull) != 0ull, 0, tpos, r16, g4); }
            LAS float* sp = SLCP + (my * 64 + lane) * 18;
#pragma unroll
            for (int dt = 0; dt < 4; ++dt)
#pragma unroll
                for (int i = 0; i < 4; ++i) sp[dt * 4 + i] = st.o[dt][i];
            sp[16] = st.m; sp[17] = st.l; }
        asm volatile("s_waitcnt lgkmcnt(0)" ::: "memory"); __syncthreads();
        if (mem == 0) {
            float mm[4], ll[4]; float M = -1e30f;
#pragma unroll
            for (int x = 0; x < 4; ++x) { mm[x] = SLCP[(x * 64 + lane) * 18 + 16]; ll[x] = SLCP[(x * 64 + lane) * 18 + 17]; M = fmaxf(M, mm[x]); }
            float L = 0.f, sc[4];
#pragma unroll
            for (int x = 0; x < 4; ++x) { sc[x] = __builtin_amdgcn_exp2f(mm[x] - M); L += ll[x] * sc[x]; }
            const float g1 = QG[mrow * NQI + 1024 + head * 3 + 1] / L;
            float wm[3], wl[3]; float MW = -1e30f;
#pragma unroll
            for (int x = 0; x < 3; ++x) { wm[x] = WINP[(x * 64 + lane) * 18 + 16]; wl[x] = WINP[(x * 64 + lane) * 18 + 17]; MW = fmaxf(MW, wm[x]); }
            float LW = 0.f, wsc[3];
#pragma unroll
            for (int x = 0; x < 3; ++x) { wsc[x] = __builtin_amdgcn_exp2f(wm[x] - MW); LW += wl[x] * wsc[x]; }
            const float g2 = QG[mrow * NQI + 1024 + head * 3 + 2] / LW;
#pragma unroll
            for (int dt = 0; dt < 4; ++dt) { f32x4 acc = oacc[dt];
#pragma unroll
                for (int x = 0; x < 3; ++x) { const LAS float* wq = WINP + (x * 64 + lane) * 18 + dt * 4; acc = acc + (f32x4){wq[0], wq[1], wq[2], wq[3]} * (wsc[x] * g2); }
#pragma unroll
                for (int x = 0; x < 4; ++x) { const LAS float* sp = SLCP + (x * 64 + lane) * 18 + dt * 4; acc = acc + (f32x4){sp[0], sp[1], sp[2], sp[3]} * (sc[x] * g1); }
                u32x2 w; w.x = cvtpk(acc[0], acc[1]); w.y = cvtpk(acc[2], acc[3]); *(u32x2*)(AO + mrow * D + head * 64 + 16 * dt + 4 * g4) = w; } }
        asm volatile("s_waitcnt lgkmcnt(0)" ::: "memory"); __syncthreads();
    }
}

struct AttSt { float m[4], l[4], o[4]; };
__device__ __forceinline__ void att_init(AttSt& st) {
#pragma unroll
    for (int g = 0; g < 4; ++g) { st.m[g] = -1e30f; st.l[g] = 0.f; st.o[g] = 0.f; } }
__device__ __forceinline__ void att_tile(AttSt& st, const float* kp, const float* vp, bool valid, float dist, const float (&slope)[4], const LAS f32x4* qs4, LAS f32x4* pb, int lane) {
    f32x4 kv[16];
#pragma unroll
    for (int c = 0; c < 16; ++c) kv[c] = ((const f32x4*)kp)[c];
    float vv[32]; const unsigned long long vpa = (unsigned long long)vp;
#pragma unroll
    for (int k = 0; k < 32; ++k) { const unsigned lo = __builtin_amdgcn_readlane((unsigned)vpa, k), hi = __builtin_amdgcn_readlane((unsigned)(vpa >> 32), k); vv[k] = ((const float*)(((unsigned long long)hi << 32) | lo))[lane]; }
    float s[4] = {0.f, 0.f, 0.f, 0.f};
#pragma unroll
    for (int c = 0; c < 16; ++c) {
#pragma unroll
        for (int g = 0; g < 4; ++g) { const f32x4 q = qs4[g * 16 + c]; s[g] += (kv[c].x * q.x + kv[c].y * q.y) + (kv[c].z * q.z + kv[c].w * q.w); }
        if ((c & 3) == 3) __builtin_amdgcn_sched_barrier(0); }
    asm volatile("" : "+v"(s[0]), "+v"(s[1]), "+v"(s[2]), "+v"(s[3]));
    f32x4 pv;
#pragma unroll
    for (int g = 0; g < 4; ++g) { const float sc = valid ? s[g] - slope[g] * dist : -1e30f; const float tm = wave_max(sc); const float mn = fmaxf(st.m[g], tm);
        const float p = valid ? __expf(sc - mn) : 0.f; const float corr = __expf(st.m[g] - mn); st.l[g] = st.l[g] * corr + wave_sum(p); st.o[g] *= corr; st.m[g] = mn; pv[g] = p; }
    pb[lane] = pv; LDS_WAIT(); asm volatile("" ::: "memory");
    float v2[32];
#pragma unroll
    for (int k = 0; k < 32; ++k) { const unsigned lo = __builtin_amdgcn_readlane((unsigned)vpa, 32 + k), hi = __builtin_amdgcn_readlane((unsigned)(vpa >> 32), 32 + k); v2[k] = ((const float*)(((unsigned long long)hi << 32) | lo))[lane]; }
#pragma unroll
    for (int k = 0; k < 32; ++k) { const f32x4 p = pb[k]; st.o[0] += p.x * vv[k]; st.o[1] += p.y * vv[k]; st.o[2] += p.z * vv[k]; st.o[3] += p.w * vv[k]; if ((k & 7) == 7) __builtin_amdgcn_sched_barrier(0); }
#pragma unroll
    for (int k = 0; k < 32; ++k) { const f32x4 p = pb[32 + k]; st.o[0] += p.x * v2[k]; st.o[1] += p.y * v2[k]; st.o[2] += p.z * v2[k]; st.o[3] += p.w * v2[k]; if ((k & 7) == 7) __builtin_amdgcn_sched_barrier(0); }
    LDS_WAIT(); asm volatile("" ::: "memory");
}
__device__ __forceinline__ void att_phase(Frame& F, int l) {
    const float* QG = WSP(float, WS_QG); bf16_t* AO = WSP(bf16_t, WS_AO); const float* KC = WSP(float, WS_KCMP); const float* VC = KC + (size_t)CROWS * 64;
    const float* cache = INF(2); const float* cwin = INF(3); const int* pt = (const int*)F.in[6]; const float* winp = WSP(float, WS_WINP);
    LAS unsigned char* wl = F.lds + F.wave * 8192;
    LAS f32x4* qs4 = (LAS f32x4*)wl;
    LAS f32x4* pb = (LAS f32x4*)(wl + 1024);
    LAS float* psum = (LAS float*)(wl + 1024 + 4096);
    const int lane = F.lane;
    const int nitems = MS * NKV;
    for (int it = F.gw; it < nitems; it += F.NGW) {
        const int m = MP + (it >> 2); const int kvh = it & 3;
        const RowInfo ri = row_info(m); const int tpos = ri.stream == 0 ? ri.t : PAST + ri.t;
        float slope[4], gate[4][3];
#pragma unroll
        for (int g = 0; g < 4; ++g) { slope[g] = exp2f(-0.5f * (float)(kvh * 4 + g + 1));
#pragma unroll
            for (int c = 0; c < 3; ++c) gate[g][c] = QG[(size_t)m * NQI + 1024 + (kvh * 4 + g) * 3 + c]; }
        { const float* qrow = QG + (size_t)m * NQI + kvh * 256; LAS float* qs = (LAS float*)qs4;
#pragma unroll
          for (int g = 0; g < 4; ++g) qs[g * 64 + lane] = qrow[g * 64 + lane]; }
        LDS_WAIT(); asm volatile("" ::: "memory");
        const float* safe = QG + (size_t)m * NQI;
        float otot[4] = {0.f, 0.f, 0.f, 0.f};
        const int ncv = tpos >= 31 ? ((tpos - 31) >> 4) + 1 : 0;
        const size_t crow0 = ri.stream == 0 ? (size_t)CROWS_S + (size_t)(ri.b * 4 + kvh) * 256 : (size_t)(ri.b * 4 + kvh) * 128;
        const int ntile_c = (ncv + 63) >> 6;
#pragma unroll
        for (int q = 0; q < 5; ++q) { const int idx = lane + 64 * q; if (idx < 264) psum[idx] = 0.f; }
        if (ncv > 0) {
            float mx[4] = {-1e30f, -1e30f, -1e30f, -1e30f};
#pragma unroll 1
            for (int tl = 0; tl < ntile_c; ++tl) { const int n = tl * 64 + lane; const bool valid = n < ncv; const float* kp = valid ? KC + (crow0 + n) * 64 : safe; float s[4] = {0.f, 0.f, 0.f, 0.f};
#pragma unroll 4
                for (int c = 0; c < 16; ++c) { const f32x4 kv = ((const f32x4*)kp)[c];
#pragma unroll
                    for (int g = 0; g < 4; ++g) { const f32x4 q = qs4[g * 16 + c]; s[g] += (kv.x * q.x + kv.y * q.y) + (kv.z * q.z + kv.w * q.w); } }
                const float dist = (float)(tpos - (16 * n + 31)); f32x4 sv;
#pragma unroll
                for (int g = 0; g < 4; ++g) { sv[g] = valid ? s[g] - slope[g] * dist : -1e30f; mx[g] = fmaxf(mx[g], sv[g]); }
                pb[n] = sv; }
            float sm[4];
#pragma unroll
            for (int g = 0; g < 4; ++g) { mx[g] = wave_max(mx[g]); sm[g] = 0.f; }
            LDS_WAIT(); asm volatile("" ::: "memory");
#pragma unroll 1
            for (int tl = 0; tl < ntile_c; ++tl) { const int n = tl * 64 + lane; const f32x4 sv = pb[n]; f32x4 p;
#pragma unroll
                for (int g = 0; g < 4; ++g) { p[g] = n < ncv ? __expf(sv[g] - mx[g]) : 0.f; sm[g] += p[g]; }
                pb[n] = p; }
#pragma unroll
            for (int g = 0; g < 4; ++g) sm[g] = 1.0f / wave_sum(sm[g]);
            LDS_WAIT(); asm volatile("" ::: "memory");
#pragma unroll 1
            for (int tl = 0; tl < ntile_c; ++tl) { const int n = tl * 64 + lane; f32x4 p = pb[n]; p.x *= sm[0]; p.y *= sm[1]; p.z *= sm[2]; p.w *= sm[3]; pb[n] = p; psum[n + 1] = (p.x + p.y) + (p.z + p.w); }
            LDS_WAIT(); asm volatile("" ::: "memory");
            float oc[4] = {0.f, 0.f, 0.f, 0.f};
#pragma unroll 4
            for (int n = 0; n < ncv; ++n) { const float vv = VC[(crow0 + n) * 64 + lane]; const f32x4 p = pb[n]; oc[0] += p.x * vv; oc[1] += p.y * vv; oc[2] += p.z * vv; oc[3] += p.w * vv; }
#pragma unroll
            for (int g = 0; g < 4; ++g) otot[g] += gate[g][0] * oc[g];
        }
        LDS_WAIT(); asm volatile("" ::: "memory");
        const int cur = tpos >> 6; const int ns = ri.stream == 0 ? 64 : 33;
        float val;
        {
          float imp = 0.f; if (lane < ns) { imp = ((psum[4 * lane] + psum[4 * lane + 1]) + (psum[4 * lane + 2] + psum[4 * lane + 3])) + psum[4 * lane + 4]; }
          const bool forced = lane == 0 || lane == cur || lane == cur - 1;
          val = lane >= ns ? -2.f : (lane <= cur ? (forced ? 1e4f : imp) : -1.f); }
        int rank = 0;
        for (int s2 = 0; s2 < 64; ++s2) { const float v2 = __builtin_bit_cast(float, __builtin_amdgcn_readlane(__builtin_bit_cast(int, val), s2)); rank += (v2 > val || (v2 == val && s2 < lane)) ? 1 : 0; }
        const unsigned long long selmask = __ballot(rank < 16 && lane <= cur && lane < ns);
        { AttSt st; att_init(st);
          for (unsigned long long mm = selmask; mm; mm &= mm - 1) { const int s = __builtin_ctzll(mm); const int pos = s * 64 + lane; const bool valid = pos <= tpos;
              const float *kp = safe, *vp = safe;
              if (valid) { if (ri.stream == 0) { kp = F.out + O_PCS + (((size_t)ri.b * TP + pos) * 4 + 2) * 256 + kvh * 64; vp = kp + 256; }
                  else if (pos < PAST) { const int page = pt[ri.b * NPG + (pos >> 7)]; kp = cache + (((size_t)page * PAGE + (pos & 127)) * 4 + 2) * 256 + kvh * 64; vp = kp + 256; }
                  else { kp = F.out + O_SCS + (((size_t)ri.b * TS + (pos - PAST)) * 4 + 2) * 256 + kvh * 64; vp = kp + 256; } }
              att_tile(st, kp, vp, valid, (float)(tpos - pos), slope, qs4, pb, lane); }
#pragma unroll
          for (int g = 0; g < 4; ++g) otot[g] += gate[g][1] * st.o[g] / st.l[g]; }
        { AttSt st; att_init(st); const int wpos0 = ri.stream == 0 ? 0 : PAST + TS - 516; const int lo = max(tpos - 512, wpos0);
          for (int p0 = lo; p0 <= tpos; p0 += 64) { const int pos = p0 + lane; const bool valid = pos <= tpos; const float *kp = safe, *vp = safe;
              if (valid) { if (ri.stream == 0) { kp = winp + (size_t)(ri.b * TP + pos) * 512 + kvh * 64; vp = kp + 256; }
                  else if (pos < PAST) { kp = cwin + ((size_t)ri.b * 512 + (pos - wpos0)) * 512 + kvh * 64; vp = kp + 256; }
                  else { kp = F.out + O_SWIN + ((size_t)ri.b * 512 + 508 + (pos - PAST)) * 512 + kvh * 64; vp = kp + 256; } }
              att_tile(st, kp, vp, valid, (float)(tpos - pos), slope, qs4, pb, lane); }
#pragma unroll
          for (int g = 0; g < 4; ++g) otot[g] += gate[g][2] * st.o[g] / st.l[g]; }
#pragma unroll
        for (int g = 0; g < 4; ++g) AO[(size_t)m * D + (kvh * 4 + g) * 64 + lane] = (bf16_t)f2bf(otot[g]);
        LDS_WAIT(); asm volatile("" ::: "memory");
    }
}

__device__ __forceinline__ void resid_reduce_phase(Frame& F, int npieces, float scale) {
    const float* part = WSP(float, WS_PART); float* H = WSP(float, WS_H); bf16_t* HB = WSP(bf16_t, WS_HB); float* RS = WSP(float, WS_RS);
    for (int it = F.gw; it < MS * 4; it += F.NGW) { const int r = it >> 2, c = (it & 3) * 256 + F.lane * 4; const size_t off = (size_t)(MP + r) * D + c;
        f32x4 pv[11];
#pragma unroll
        for (int pc = 0; pc < 11; ++pc) pv[pc] = *(const f32x4*)(part + ((size_t)pc * MS + r) * D + c);
        f32x4 acc = (f32x4){0.f, 0.f, 0.f, 0.f};
#pragma unroll
        for (int pc = 0; pc < 11; ++pc) acc = acc + pv[pc];
        f32x4 h = *(const f32x4*)(H + off); h = h + acc * scale; *(f32x4*)(H + off) = h; u32x2 w; w.x = pk2(h.x, h.y); w.y = pk2(h.z, h.w); *(u32x2*)(HB + off) = w;
        float ss = wave_sum((h.x * h.x + h.y * h.y) + (h.z * h.z + h.w * h.w));
        if (F.lane < 4) RS[(size_t)(MP + r) * 16 + (it & 3) * 4 + F.lane] = F.lane == 0 ? ss : 0.f; }
}
__device__ __forceinline__ void final_phase(Frame& F) {
    const float* H = WSP(float, WS_H); const float* g = INF(36);
    for (int grp = F.gw; grp < MT / 4; grp += F.NGW) { f32x4 x[4][4]; float ss[4];
#pragma unroll
        for (int q = 0; q < 4; ++q) { const int m = grp * 4 + q; ss[q] = 0.f;
#pragma unroll
            for (int j = 0; j < 4; ++j) { x[q][j] = *(const f32x4*)(H + (size_t)m * D + j * 256 + F.lane * 4); ss[q] += (x[q][j].x * x[q][j].x + x[q][j].y * x[q][j].y) + (x[q][j].z * x[q][j].z + x[q][j].w * x[q][j].w); } }
        f32x4 gg[4];
#pragma unroll
        for (int j = 0; j < 4; ++j) gg[j] = *(const f32x4*)(g + j * 256 + F.lane * 4);
#pragma unroll
        for (int q = 0; q < 4; ++q) { const float ir = 1.0f / sqrtf(wave_sum(ss[q]) * (1.0f / D) + RMS_EPS); const int m = grp * 4 + q;
#pragma unroll
            for (int j = 0; j < 4; ++j) { const int c = j * 256 + F.lane * 4; *(f32x4*)(F.out + O_Y + (size_t)m * D + c) = x[q][j] * ir * gg[j]; } } }
}

__global__ void __launch_bounds__(NTHREADS, 2) yoco_fwd(Args args) {
    extern __shared__ __attribute__((aligned(16))) unsigned char lds_raw[];
    Frame F; F.rot = 0; F.lds = (LAS unsigned char*)lds_raw; F.tid = threadIdx.x; F.lane = F.tid & 63; F.wave = __builtin_amdgcn_readfirstlane(F.tid >> 6);
    F.G = gridDim.x; F.gw = blockIdx.x * NWAVES + F.wave; F.NGW = F.G * NWAVES; F.in = args.in; F.out = args.out; F.ws = args.ws;
    volatile LAS unsigned* misc = (volatile LAS unsigned*)(F.lds + LDS_MISC + 16000);
    if (F.tid < 4) misc[F.tid] = 0u;
    __syncthreads();
    const bool single = (args.ph_hi - args.ph_lo) > 1;
    XcdBarrier bar; bar.bar = (unsigned*)(F.ws + WS_CTL); bar.x = 0; bar.st = misc;
    if (single) bar = xcd_barrier_post((unsigned*)(F.ws + WS_CTL), misc);
    int ph = 0;
#define PH_BEGIN if (args.ph_lo <= ph && ph < args.ph_hi) { { int ln_; asm volatile("v_mbcnt_lo_u32_b32 %0, -1, 0\n\tv_mbcnt_hi_u32_b32 %0, -1, %0" : "=v"(ln_)); F.lane = ln_; } \
    { int wv_ = F.wave; unsigned wl_ = (unsigned)(unsigned long long)args.ws, wh_ = (unsigned)((unsigned long long)args.ws >> 32), ol_ = (unsigned)(unsigned long long)args.out, oh_ = (unsigned)((unsigned long long)args.out >> 32); \
      asm volatile("" : "+v"(wv_), "+v"(wl_), "+v"(wh_), "+v"(ol_), "+v"(oh_));     \
      F.wave = __builtin_amdgcn_readfirstlane(wv_); { int bx_ = blockIdx.x; asm volatile("" : "+s"(bx_)); F.bx = bx_; } F.gw = F.bx * NWAVES + F.wave; F.tid = F.wave * 64 + F.lane; \
      F.ws = (unsigned char*)(((unsigned long long)(unsigned)__builtin_amdgcn_readfirstlane(wh_) << 32) | (unsigned)__builtin_amdgcn_readfirstlane(wl_)); \
      F.out = (float*)(((unsigned long long)(unsigned)__builtin_amdgcn_readfirstlane(oh_) << 32) | (unsigned)__builtin_amdgcn_readfirstlane(ol_)); }
#define PH_END   if (single) { int ln2_; asm volatile("v_mbcnt_lo_u32_b32 %0, -1, 0\n\tv_mbcnt_hi_u32_b32 %0, -1, %0" : "=v"(ln2_)); xcd_barrier(bar, F.wave == 0 && ln2_ == 0); } } ++ph;

    PH_BEGIN if (EN_P0) p0_part(F, 0); PH_END
    PH_BEGIN if (EN_P0) p0b_prologue(F); PH_END

    #define H WSP(float, WS_H)
#define HB WSP(bf16_t, WS_HB)
#define RSB WSP(float, WS_RS)
#define FFH WSP(bf16_t, WS_FFH)
#define RS_TBL ((const LAS float*)(F.lds + LDS_TBL))
#define TAIL_WORK(stmt_) if (EN_P0 && F.bx >= 8) { Frame F2 = F; F2.bx = F.bx - 8; F2.G = F.G - 8; F2.gw = F2.bx * NWAVES + F.wave; F2.NGW = F2.G * NWAVES; stmt_ }
#define FFN_PHASES(lf) \
    PH_BEGIN { pg8::StaticOrder S; S.init(MT, 2 * DFF, F.G, F.bx); PMSimple P{(const char*)HB, (const char*)(WSP(bf16_t, WS_WIN) + (size_t)(lf) * 2 * DFF * D), (size_t)256 * D * 2, (size_t)256 * D * 2}; \
        build_rs_table(F.lds, RSB, S, F.tid); EpiFFN1 E{FFH, RS_TBL, 0}; if (EN_GEMM) pg8::gemm_phase(F.lds, F.tid, D, D, D, S, P, E); } PH_END \
    PH_BEGIN { pg8::OrderSplit S; S.init(DFF, F.G, F.bx); PMSimple P{(const char*)FFH, (const char*)(WSP(bf16_t, WS_WOUT) + (size_t)(lf) * D * DFF), (size_t)256 * DFF * 2, (size_t)256 * DFF * 2}; \
        EpiResid E{H, HB, RSB, 0.5f, WSP(float, WS_PART)}; if (EN_GEMM) pg8::gemm_phase(F.lds, F.tid, DFF, DFF, DFF, S, P, E); } PH_END \
    PH_BEGIN resid_reduce_phase(F, DFF / 256, 0.5f); PH_END

    for (int l = 0; l < 2; ++l) {
        FFN_PHASES(l * 2)
        PH_BEGIN if (EN_ELT) r1_phase(F, l); PH_END
        PH_BEGIN { pg8::StaticOrder S; S.init(MT, l == 0 ? NR2 - 256 : NR2, F.G, F.bx);        PMR2 P{(const char*)WSP(bf16_t, WS_XS), (const char*)(WSP(bf16_t, WS_WR2) + (size_t)l * NR2 * D)};
            EpiR2 E{WSP(float, WS_RKV), 2 + l, WSP(bf16_t, WS_LH), WSP(bf16_t, WS_SCN) + (size_t)l * SCN_L}; if (EN_GEMM) pg8::gemm_phase(F.lds, F.tid, D, D, D, S, P, E); } PH_END
        PH_BEGIN { pg8::StaticOrder S; S.init(MT, l == 0 ? NR3 - 1024 : NR3, F.G, F.bx);        PMSimple P{(const char*)WSP(bf16_t, WS_LH), (const char*)(WSP(bf16_t, WS_WR3) + (size_t)l * NR3 * KR3), (size_t)256 * KR3 * 2, (size_t)256 * KR3 * 2};
            EpiR3 E{WSP(float, WS_LU), WSP(bf16_t, WS_SCN) + (size_t)l * SCN_L}; if (EN_GEMM) pg8::gemm_phase(F.lds, F.tid, KR3, KR3, KR3, S, P, E); } PH_END
        PH_BEGIN if (EN_SCAN) { r4_phase(F, l); scanA_phase(F, l); } PH_END
        PH_BEGIN if (EN_SCAN) scanB_phase(F, l); PH_END
        PH_BEGIN if (EN_SCAN) { scanC_phase(F, l); r5b_phase(F, l); } PH_END
        PH_BEGIN { pg8::StaticOrder S; S.init(MT, D, F.G, F.bx); PMSimple P{(const char*)WSP(bf16_t, WS_YG), (const char*)(WSP(bf16_t, WS_WRO) + (size_t)l * D * D), (size_t)256 * D * 2, (size_t)256 * D * 2};
            EpiResid E{H, HB, RSB, 1.0f, nullptr}; if (EN_GEMM) pg8::gemm_phase(F.lds, F.tid, D, D, D, S, P, E);
            TAIL_WORK({ LAS float* scr_ = (LAS float*)(F.lds + F.wave * 16384); F2.rot = 0; p0_ffn(F2, 6 + l, scr_); }) } PH_END
        FFN_PHASES(l * 2 + 1)
    }
    PH_BEGIN { pg8::StaticOrder S; S.init(MT, NKVW, F.G, F.bx); PMSimple P{(const char*)HB, (const char*)WSP(bf16_t, WS_WKV), (size_t)256 * D * 2, (size_t)256 * D * 2};
        build_rs_table(F.lds, RSB, S, F.tid); EpiKV E{F.out, WSP(float, WS_WINP), RS_TBL, 0}; if (EN_GEMM) pg8::gemm_phase(F.lds, F.tid, D, D, D, S, P, E); } PH_END
    PH_BEGIN if (EN_ELT) { cst_phase(F); kvstage_phase(F); } PH_END
    PH_BEGIN { OrderC1 S{F.G, F.bx}; PMC1 P{(const char*)WSP(bf16_t, WS_CST), (const char*)WSP(bf16_t, WS_WC1)}; EpiC1 E{WSP(float, WS_CH)}; if (EN_GEMM) pg8::gemm_phase(F.lds, F.tid, 1024, 1024, 1024, S, P, E); } PH_END
    PH_BEGIN if (EN_ELT) c2_phase(F); PH_END
    for (int l = 0; l < 2; ++l) {
        FFN_PHASES(4 + l * 2)
        PH_BEGIN { pg8::StaticOrder S; S.init(MT, NQI, F.G, F.bx); PMSimple P{(const char*)HB, (const char*)(WSP(bf16_t, WS_WQI) + (size_t)l * NQI * D), (size_t)256 * D * 2, (size_t)256 * D * 2};
            build_rs_table(F.lds, RSB, S, F.tid); EpiQI E{WSP(float, WS_QG), WSP(bf16_t, WS_QB), RS_TBL, 0}; if (EN_GEMM) pg8::gemm_phase(F.lds, F.tid, D, D, D, S, P, E); } PH_END
        PH_BEGIN if (EN_ATT) { attp_phase(F, l); __syncthreads(); atts2_phase(F, l); } PH_END
        PH_BEGIN { pg8::StaticOrder S; S.init(MT, D, F.G, F.bx); PMSimple P{(const char*)WSP(bf16_t, WS_AO), (const char*)(WSP(bf16_t, WS_WBO) + (size_t)l * D * D), (size_t)256 * D * 2, (size_t)256 * D * 2};
            EpiResid E{H, HB, RSB, 1.0f, nullptr}; if (EN_GEMM) pg8::gemm_phase(F.lds, F.tid, D, D, D, S, P, E);
            TAIL_WORK({ swin_copy(F2, 64 + 32 * l, 96 + 32 * l); }) } PH_END
        FFN_PHASES(4 + l * 2 + 1)
    }
    PH_BEGIN if (EN_ELT) final_phase(F); PH_END
}
constexpr int N_PHASES = 2 + 2 * 13 + 4 + 2 * 9 + 1;

extern "C" void kernel_launch(void* const* d_in, const int* in_sizes, int n_in, void* d_out, int out_size, void* d_ws, size_t ws_size, hipStream_t stream) {
    static int grid = 0;
    if (grid == 0) {
        if (n_in != 37 || ws_size < WS_END) { fprintf(stderr, "kernel_launch: expected 37 inputs and >= %zu bytes of workspace (got %d, %zu)\n", (size_t)WS_END, n_in, ws_size); grid = -1; return; }
        int dev = 0, cus = 0, per_cu = 0;
        if (hipGetDevice(&dev) != hipSuccess || hipDeviceGetAttribute(&cus, hipDeviceAttributeMultiprocessorCount, dev) != hipSuccess) { grid = -1; return; }
        if (hipFuncSetAttribute((const void*)yoco_fwd, hipFuncAttributeMaxDynamicSharedMemorySize, LDS_BYTES) != hipSuccess) { fprintf(stderr, "kernel_launch: hipFuncSetAttribute failed\n"); grid = -1; return; }
        if (hipOccupancyMaxActiveBlocksPerMultiprocessor(&per_cu, (const void*)yoco_fwd, NTHREADS, LDS_BYTES) != hipSuccess || per_cu < 1) fprintf(stderr, "kernel_launch: occupancy query says %d\n", per_cu);
        (void)hipGetLastError();
        grid = cus;
    }
    if (grid < 0) return;
    (void)hipMemsetAsync((char*)d_ws + WS_CTL, 0, CTL_BYTES, stream);
    Args a{};
    for (int i = 0; i < 37; ++i) a.in[i] = d_in[i];
    a.out = (float*)d_out; a.ws = (unsigned char*)d_ws;
#if MK_MULTI
    for (int p = 0; p < N_PHASES; ++p) { a.ph_lo = p; a.ph_hi = p + 1; hipLaunchKernelGGL(yoco_fwd, dim3(grid), dim3(NTHREADS), LDS_BYTES, stream, a); }
#else
    a.ph_lo = 0; a.ph_hi = N_PHASES;
    hipLaunchKernelGGL(yoco_fwd, dim3(grid), dim3(NTHREADS), LDS_BYTES, stream, a);
#endif
    const hipError_t le = hipPeekAtLastError();
    if (le != hipSuccess) fprintf(stderr, "kernel_launch: launch failed: %s\n", hipGetErrorName(le));
}
```

```cpp
#include <hip/hip_runtime.h>
#include <cstdio>
#include <cstdint>

#ifndef MK_MULTI
#define MK_MULTI 0
#endif

#define LAS __attribute__((address_space(3)))
#define GAS __attribute__((address_space(1)))
#define CAS __attribute__((address_space(4)))
typedef unsigned short bf16_t;
typedef short bf16x8 __attribute__((ext_vector_type(8)));
typedef float f32x4 __attribute__((ext_vector_type(4)));
typedef float f32x2 __attribute__((ext_vector_type(2)));
typedef unsigned u32x4 __attribute__((ext_vector_type(4)));
typedef unsigned u32x2 __attribute__((ext_vector_type(2)));

constexpr int D = 1024, NBP = 4, TP = 4096, MP = NBP * TP, NBS = 128, TS = 4, MS = NBS * TS, MT = MP + MS;
constexpr int PAST = 2048, PAGE = 128, NPG = 16;
constexpr int DFF = 2816, NH = 16, HD = 64, NKV = 4;
constexpr int NR2 = 4096, KR3 = 384, NR3 = 4096, NKVW = 1536, NQI = 1280;
constexpr int CROWS_S = NBS * NKV * 128, CROWS_P = NBP * NKV * 256, CROWS = CROWS_S + CROWS_P;
constexpr int NCH_P = 64, NCH_S = NBS * NH, SIW = 320;
constexpr float RMS_EPS = 1e-6f, GN_EPS = 64e-5f;

constexpr size_t O_Y = 0, O_PSHIFT = (size_t)MT * D, O_PWKV = O_PSHIFT + 2 * NBP * D, O_PCS = O_PWKV + (size_t)2 * NBP * NH * 64 * 64, O_PWIN = O_PCS + (size_t)MP * 1024,
                 O_SSHIFT = O_PWIN + (size_t)NBP * 512 * 512, O_SWKV = O_SSHIFT + (size_t)2 * NBS * D, O_SCS = O_SWKV + (size_t)2 * NBS * NH * 64 * 64, O_SWIN = O_SCS + (size_t)MS * 1024;

constexpr size_t al256(size_t x) { return (x + 255) & ~(size_t)255; }
constexpr size_t WS_CTL = 0, CTL_BYTES = 1u << 20;
constexpr size_t SZ_WIN1 = (size_t)2 * DFF * D * 2, SZ_WOUT1 = (size_t)D * DFF * 2;
constexpr size_t WS_WIN = WS_CTL + CTL_BYTES;
constexpr size_t WS_WOUT = WS_WIN + 8 * SZ_WIN1;
constexpr size_t WS_WR2 = WS_WOUT + 8 * SZ_WOUT1;
constexpr size_t WS_WR3 = WS_WR2 + (size_t)2 * NR2 * D * 2;
constexpr size_t WS_WRO = WS_WR3 + (size_t)2 * NR3 * KR3 * 2;
constexpr size_t WS_WKV = WS_WRO + (size_t)2 * D * D * 2;
constexpr size_t WS_WQI = WS_WKV + (size_t)NKVW * D * 2;
constexpr size_t WS_WBO = WS_WQI + (size_t)2 * NQI * D * 2;
constexpr size_t WS_WC1 = WS_WBO + (size_t)2 * D * D * 2;
constexpr size_t WS_POSB = WS_WC1 + (size_t)2 * 256 * 1024 * 2;
constexpr size_t WS_H = al256(WS_POSB + 2 * 128 * 4);
constexpr size_t WS_HB = WS_H + (size_t)MT * D * 4;
constexpr size_t WS_RS = WS_HB + (size_t)MT * D * 2;
constexpr size_t WS_FFH = WS_RS + (size_t)MT * 16 * 4;
constexpr size_t WS_XS = WS_FFH + (size_t)MT * DFF * 2;
constexpr size_t WS_RKV = WS_XS + (size_t)6 * MT * D * 2;
constexpr size_t WS_LH = WS_RKV + (size_t)4 * MT * D * 4;
constexpr size_t WS_LU = WS_LH + (size_t)MT * KR3 * 2;
constexpr size_t WS_SIP = WS_LU + (size_t)MT * NR3 * 4;
constexpr size_t SIP_L = (size_t)NCH_P * TP * SIW, SIS_L = (size_t)NCH_S * TS * SIW;
constexpr size_t WS_SIS = WS_SIP + 2 * SIP_L * 4;
constexpr size_t WS_SV = WS_SIS + 2 * SIS_L * 4;
constexpr size_t WS_YS = WS_SV + (size_t)MT * D * 4;
constexpr size_t WS_YG = WS_YS + (size_t)MT * D * 4;
constexpr size_t WS_WINP = WS_YG + (size_t)MT * D * 2;
constexpr size_t WS_CST = WS_WINP + (size_t)MP * 512 * 4;
constexpr size_t WS_CH = WS_CST + (size_t)2 * CROWS * 1024 * 2;
constexpr size_t WS_KCMP = WS_CH + (size_t)2 * CROWS * 256 * 4;
constexpr size_t WS_QG = WS_KCMP + (size_t)2 * CROWS * 64 * 4;
constexpr size_t WS_AO = WS_QG + (size_t)MT * NQI * 4;
constexpr size_t WS_QB = WS_AO + (size_t)MT * D * 2;
constexpr size_t WS_KVS = WS_QB + (size_t)MT * D * 2;
constexpr size_t WS_KCB = WS_KVS + (size_t)4 * 16 * TP * 64 * 2;
constexpr size_t WS_TG = WS_KCB + (size_t)2 * 16 * 256 * 64 * 2;
constexpr size_t WS_SS = WS_TG + (size_t)NCH_P * 64 * 8192 * 4;
constexpr size_t WS_PART = WS_SS + (size_t)NCH_P * 64 * 4096 * 4;
constexpr size_t WS_YQ = WS_PART + (size_t)11 * MS * D * 4;
constexpr size_t SCN_L = (size_t)MP * NH * 7 * 64;
constexpr size_t WS_SCN = WS_YQ + (size_t)NCH_P * 64 * 12288 * 4;
constexpr size_t WS_END = WS_SCN + 2 * SCN_L * 2;

constexpr int NWAVES = 8, NTHREADS = 512;
constexpr int LDS_STAGE = 131072, LDS_MISC = LDS_STAGE, LDS_BYTES = LDS_STAGE + 16384;

__device__ __forceinline__ unsigned f2bf(float f) { unsigned u = __builtin_bit_cast(unsigned, f); return (u + 0x7fffu + ((u >> 16) & 1u)) >> 16; }
__device__ __forceinline__ unsigned pk2(float lo, float hi) { return f2bf(lo) | (f2bf(hi) << 16); }
__device__ __forceinline__ int lane_id_() { int l; asm volatile("v_mbcnt_lo_u32_b32 %0, -1, 0\n\tv_mbcnt_hi_u32_b32 %0, -1, %0" : "=v"(l)); return l; }
__device__ __forceinline__ float shflx_l(float v, int mask, int lane) { return __builtin_bit_cast(float, __builtin_amdgcn_ds_bpermute((lane ^ mask) << 2, __builtin_bit_cast(int, v))); }
__device__ __forceinline__ float shflx(float v, int mask) { return shflx_l(v, mask, lane_id_()); }
__device__ __forceinline__ float wave_sum(float v) { const int l = lane_id_();
#pragma unroll
    for (int o = 1; o < 64; o <<= 1) v += shflx_l(v, o, l);
    return v;
}
__device__ __forceinline__ float wave_max(float v) { const int l = lane_id_();
#pragma unroll
    for (int o = 1; o < 64; o <<= 1) v = fmaxf(v, shflx_l(v, o, l));
    return v;
}
__device__ __forceinline__ float sigmoidf_(float x) { return __builtin_amdgcn_rcpf(1.0f + __expf(-x)); }
__device__ __forceinline__ float tanh_fast(float x) { const float e = __expf(-2.0f * fabsf(x)); const float t = (1.0f - e) * __builtin_amdgcn_rcpf(1.0f + e); return x < 0.f ? -t : t; }
#define LDS_WAIT() asm volatile("s_waitcnt lgkmcnt(0)" ::: "memory")

#define XB_TMO      128
#define XB_XCNT(j)  (256  + 64 * (j))
#define XB_XSUB(j)  (1280 + 64 * (j))
#define XB_XGEN(j)  (2304 + 64 * (j))
#define XB_TOP      3328
#define XB_TOPGEN   3392
#define XCD_BAR_WORDS 3456
#define XB_SPIN_CAP (1u << 18)
__device__ __forceinline__ unsigned xb_ld(unsigned* p)              { return __hip_atomic_load(p, __ATOMIC_RELAXED, __HIP_MEMORY_SCOPE_AGENT); }
__device__ __forceinline__ unsigned xb_add(unsigned* p, unsigned v) { return __hip_atomic_fetch_add(p, v, __ATOMIC_RELAXED, __HIP_MEMORY_SCOPE_AGENT); }
__device__ __forceinline__ unsigned xb_xcc_id() { return (unsigned)__builtin_amdgcn_s_getreg((3 << 11) | 20) & 0xFu; }
#define XB_SPIN(cond, bar) do { unsigned _sp = 0; while (cond) { __builtin_amdgcn_s_sleep(1); \
    if ((++_sp & 255u) == 0u) { if (xb_ld(&(bar)[XB_TMO])) break; if (_sp > XB_SPIN_CAP) { atomicAdd(&(bar)[XB_TMO], 1u); break; } } } } while (0)
struct XcdBarrier { unsigned* bar; unsigned x; volatile LAS unsigned* st; };
__device__ __forceinline__ XcdBarrier xcd_barrier_post(unsigned* bar, volatile LAS unsigned* st) {
    XcdBarrier b; b.bar = bar; b.x = xb_xcc_id(); b.st = st;
    if (threadIdx.x == 0) (void)xb_add(&bar[XB_XCNT(b.x)], 1u);
    return b;
}
__device__ __forceinline__ void xcd_barrier_complete(unsigned* bar, unsigned x, unsigned& nloc, unsigned& nx) {
    const unsigned G = gridDim.x * gridDim.y * gridDim.z;
    unsigned sum, cnt, mine, sp = 0u;
    for (;;) {
        sum = 0u; cnt = 0u; mine = 0u;
#pragma unroll
        for (unsigned j = 0; j < 16; ++j) { const unsigned c = xb_ld(&bar[XB_XCNT(j)]); sum += c; cnt += (c > 0u) ? 1u : 0u; }
        if (sum == G) { mine = xb_ld(&bar[XB_XCNT(x)]); break; }
        __builtin_amdgcn_s_sleep(1);
        if ((++sp & 255u) == 0u) { if (xb_ld(&bar[XB_TMO])) break; if (sp > XB_SPIN_CAP) { atomicAdd(&bar[XB_TMO], 1u); break; } }
    }
    nloc = mine > 0u ? mine : 1u; nx = cnt > 0u ? cnt : 1u;
}
__device__ __forceinline__ void xcd_barrier(const XcdBarrier& b, const bool leader_thread) {
    asm volatile("s_waitcnt vmcnt(0)" ::: "memory");
    __syncthreads();
    if (leader_thread) {
        unsigned* bar = b.bar;
        __builtin_amdgcn_s_waitcnt(0);
        unsigned nloc = b.st[0], nx = b.st[1];
        if (nloc == 0u) { xcd_barrier_complete(bar, b.x, nloc, nx); b.st[0] = nloc; b.st[1] = nx; }
        const unsigned old = xb_add(&bar[XB_XSUB(b.x)], 1u);
        const unsigned gen = old / nloc;
        if (old + 1u == (gen + 1u) * nloc) {
            __builtin_amdgcn_fence(__ATOMIC_RELEASE, "agent");
            asm volatile("s_waitcnt vmcnt(0)" ::: "memory");
            const unsigned og = xb_add(&bar[XB_TOP], 1u);
            const unsigned tg = og / nx;
            if (og + 1u == (tg + 1u) * nx) xb_add(&bar[XB_TOPGEN], 1u);
            else XB_SPIN(xb_ld(&bar[XB_TOPGEN]) == tg, bar);
            __builtin_amdgcn_fence(__ATOMIC_ACQUIRE, "agent");
            xb_add(&bar[XB_XGEN(b.x)], 1u);
            asm volatile("s_waitcnt vmcnt(0)" ::: "memory");
        } else {
            XB_SPIN(xb_ld(&bar[XB_XGEN(b.x)]) == gen, bar);
            __builtin_amdgcn_fence(__ATOMIC_ACQUIRE, "agent");
            asm volatile("s_waitcnt vmcnt(0)" ::: "memory");
        }
    }
    __syncthreads();
}

namespace pg8 {
constexpr int BM = 256, BK = 64, HALF = 128, HTB = HALF * BK * 2, STAGE_BYTES = 8 * HTB, NXCD = 8, WGM = 8;
__host__ __device__ __forceinline__ int lds_byte(int r, int c) { const int st = (r >> 4) * 2 + (c >> 5), rr = r & 15, cc = c & 31, ob = rr * 64 + cc * 2; return st * 1024 + (ob ^ (((ob >> 9) & 1) << 5)); }
__host__ __device__ __forceinline__ void stage_rc(int b, int& R, int& C) { const int st = b / 1024, sb = b % 1024, swz = sb ^ (((sb >> 9) & 1) << 5); R = (st >> 1) * 16 + swz / 64; C = (st & 1) * 32 + (swz % 64) / 2; }
__host__ __device__ __forceinline__ int perm32(int rho) { const int n = rho >> 4, i = rho & 15; return 8 * (i >> 2) + 4 * n + (i & 3); }
struct Unit { int pm, pn, k0, nk; };
struct StaticOrder {
    int nM, nN, nwg, G, c;
    __device__ void init(int M, int N, int G_, int c_) { nM = M / BM; nN = N / BM; nwg = nM * nN; G = G_; c = c_; }
    __device__ bool next(int i, Unit& u) const {
        const long L = (long)i * G + c; if (L >= nwg) return false;
        int wgid = (int)L; { const int q = nwg / NXCD, r = nwg % NXCD, xcd = wgid % NXCD, off = wgid / NXCD; wgid = (xcd < r ? xcd * (q + 1) : r * (q + 1) + (xcd - r) * q) + off; }
        const int nig = WGM * nN, gid = wgid / nig, fm = gid * WGM, gsz = (nM - fm) < WGM ? (nM - fm) : WGM;
        u.pm = fm + ((wgid % nig) % gsz); u.pn = (wgid % nig) / gsz; u.k0 = 0; u.nk = 0; return true;
    }
};
struct OrderSplit { StaticOrder so; int G, c, npieces;
    __device__ void init(int K, int G_, int c_) { so.init(MP, D, G_, c_); G = G_; c = c_; npieces = K / (4 * BK); }
    __device__ bool next(int i, Unit& u) const { const int L = i * G + c; if (L < 256) { const int i0 = L / G; StaticOrder s2 = so; s2.c = L - i0 * G; return s2.next(i0, u); }
        const int idx = L - 256; if (idx >= 8 * npieces) return false; const int u8 = idx / npieces, pc = idx % npieces; u.pm = MP / 256 + (u8 >> 2); u.pn = u8 & 3; u.k0 = pc * 4; u.nk = 4; return true; } };
template <class Epi, class Sched, class PM>
__device__ __forceinline__ void gemm_phase(LAS unsigned char* lds, const int tid_in, const int K, const int lda, const int ldb, const Sched& S, const PM& P, const Epi& E) {
    int tid_ = tid_in; asm volatile("" : "+v"(tid_));
    const int tid = tid_, wid = __builtin_amdgcn_readfirstlane(tid >> 6), lane = tid & 63, wr = wid >> 2, wc = wid & 3, fr = lane & 15, fq = lane >> 4;
    const int nt = K / BK;
    unsigned voffA[2], voffB[2];
#pragma unroll
    for (int i = 0; i < 2; ++i) { int R, C; stage_rc(tid * 16 + i * 8192, R, C); const int Rb = Epi::PERM ? ((R & ~31) + perm32(R & 31)) : R;
        voffA[i] = (unsigned)(R * lda + C) * 2u; voffB[i] = (unsigned)(Rb * ldb + C) * 2u; }
    const size_t kstep = (size_t)(BK * 2);
    const size_t hstepA = (size_t)HALF * lda * 2, hstepB = (size_t)HALF * ldb * 2;
    const unsigned ldsw = (unsigned)wid * 1024u;
    const int aoff = lds_byte(wr * 64 + fr, fq * 8), boff = lds_byte(wc * 32 + fr, fq * 8);
#define PG8_SA(b, h) (((b) * 2 + (h)) * HTB)
#define PG8_SB(b, h) ((4 + (b) * 2 + (h)) * HTB)
#define PG8_STAGE(bufoff, gbase, voff) do { _Pragma("unroll") for (int _i = 0; _i < 2; ++_i) \
        __builtin_amdgcn_global_load_lds((const unsigned*)((const char*)(gbase) + (voff)[_i]), (LAS unsigned*)(lds + (bufoff) + ldsw + _i * 8192), 16, 0, 0); } while (0)
#define PG8_LDA(dst, b, h) do { _Pragma("unroll") for (int m = 0; m < 4; ++m) _Pragma("unroll") for (int k = 0; k < 2; ++k) dst[m][k] = *(const LAS bf16x8*)(lds + PG8_SA(b, h) + aoff + m * 2048 + k * 1024); } while (0)
#define PG8_LDB(dst, b, h) do { _Pragma("unroll") for (int n = 0; n < 2; ++n) _Pragma("unroll") for (int k = 0; k < 2; ++k) dst[n][k] = *(const LAS bf16x8*)(lds + PG8_SB(b, h) + boff + n * 2048 + k * 1024); } while (0)
#define PG8_MMA(ai, bj, At, Bt) do { __builtin_amdgcn_s_setprio(1); _Pragma("unroll") for (int m = 0; m < 4; ++m) _Pragma("unroll") for (int n = 0; n < 2; ++n) _Pragma("unroll") for (int k = 0; k < 2; ++k) \
        acc[ai][bj][m][n] = __builtin_amdgcn_mfma_f32_16x16x32_bf16(Bt[n][k], At[m][k], acc[ai][bj][m][n], 0, 0, 0); __builtin_amdgcn_s_setprio(0); } while (0)
#define PG8_WAIT_V(n) asm volatile("s_waitcnt vmcnt(" #n ")" ::: "memory")
#define PG8_WAIT_L(n) asm volatile("s_waitcnt lgkmcnt(" #n ")" ::: "memory")
#define PG8_BAR __builtin_amdgcn_s_barrier()
#define PG8_SCHED __builtin_amdgcn_sched_barrier(0)
    Unit cur, nxt; int ui = 0;
    if (!S.next(0, cur)) return;
    f32x4 acc[2][2][4][2];
#pragma unroll
    for (int a = 0; a < 2; ++a)
#pragma unroll
        for (int b = 0; b < 2; ++b)
#pragma unroll
            for (int m = 0; m < 4; ++m)
#pragma unroll
                for (int n = 0; n < 2; ++n) acc[a][b][m][n] = (f32x4){0.f, 0.f, 0.f, 0.f};
    bf16x8 At[4][2], B0[2][2], B1[2][2];
    const char* cA = P.a(cur) + (size_t)cur.k0 * (BK * 2); const char* cB = P.b(cur) + (size_t)cur.k0 * (BK * 2);
    PG8_STAGE(PG8_SB(0, 0), cB, voffB); PG8_STAGE(PG8_SB(0, 1), cB + hstepB, voffB); PG8_STAGE(PG8_SA(0, 0), cA, voffA); PG8_STAGE(PG8_SA(0, 1), cA + hstepA, voffA);
    if (wr == 1) PG8_BAR;
    PG8_WAIT_V(2); PG8_BAR;
    PG8_STAGE(PG8_SB(1, 0), cB + kstep, voffB); PG8_STAGE(PG8_SA(1, 0), cA + kstep, voffA); PG8_STAGE(PG8_SB(1, 1), cB + hstepB + kstep, voffB);
    PG8_WAIT_V(6); PG8_BAR;
    for (;;) {
        const bool has_next = S.next(ui + 1, nxt);
        const char* nA = has_next ? P.a(nxt) + (size_t)nxt.k0 * (BK * 2) : cA; const char* nB = has_next ? P.b(nxt) + (size_t)nxt.k0 * (BK * 2) : cB;
        const int ntc = cur.nk ? cur.nk : nt;
        for (int t = 0; t < ntc; t += 2) {
            const bool last = (t == ntc - 2);
            const char* a1 = cA + (size_t)(t + 1) * kstep;
            const char* a2 = last ? nA : cA + (size_t)(t + 2) * kstep; const char* b2 = last ? nB : cB + (size_t)(t + 2) * kstep;
            const char* a3 = a2 + kstep; const char* b3 = b2 + kstep;
            PG8_LDB(B0, 0, 0); PG8_LDB(B1, 0, 1); PG8_SCHED; PG8_LDA(At, 0, 0); PG8_STAGE(PG8_SA(1, 1), a1 + hstepA, voffA);
            PG8_WAIT_V(8); PG8_WAIT_L(0); PG8_BAR; PG8_MMA(0, 0, At, B0); PG8_MMA(0, 1, At, B1); PG8_BAR; PG8_SCHED;
            PG8_LDA(At, 0, 1); PG8_STAGE(PG8_SB(0, 0), b2, voffB); PG8_STAGE(PG8_SB(0, 1), b2 + hstepB, voffB); PG8_STAGE(PG8_SA(0, 0), a2, voffA);
            PG8_WAIT_V(8); PG8_WAIT_L(0); PG8_BAR; PG8_MMA(1, 0, At, B0); PG8_MMA(1, 1, At, B1); PG8_BAR; PG8_SCHED;
            PG8_LDB(B0, 1, 0); PG8_LDB(B1, 1, 1); PG8_SCHED; PG8_LDA(At, 1, 0); PG8_STAGE(PG8_SA(0, 1), a2 + hstepA, voffA);
            PG8_WAIT_V(8); PG8_WAIT_L(0); PG8_BAR; PG8_MMA(0, 0, At, B0); PG8_MMA(0, 1, At, B1); PG8_BAR; PG8_SCHED;
            PG8_LDA(At, 1, 1); PG8_STAGE(PG8_SB(1, 0), b3, voffB); PG8_STAGE(PG8_SB(1, 1), b3 + hstepB, voffB); PG8_STAGE(PG8_SA(1, 0), a3, voffA);
            PG8_WAIT_V(8); PG8_WAIT_L(0); PG8_BAR; PG8_MMA(1, 0, At, B0); PG8_MMA(1, 1, At, B1); PG8_BAR; PG8_SCHED;
        }
        if (wr == 0) PG8_BAR;
        { int le_; asm volatile("v_mbcnt_lo_u32_b32 %0, -1, 0\n\tv_mbcnt_hi_u32_b32 %0, -1, %0" : "=v"(le_));
          E(acc, cur, wr, wc, le_ & 15, le_ >> 4); }
        if (!has_next) break;
#pragma unroll
        for (int a = 0; a < 2; ++a)
#pragma unroll
            for (int b = 0; b < 2; ++b)
#pragma unroll
                for (int m = 0; m < 4; ++m)
#pragma unroll
                    for (int n = 0; n < 2; ++n) acc[a][b][m][n] = (f32x4){0.f, 0.f, 0.f, 0.f};
        cur = nxt; cA = nA; cB = nB; ++ui;
        if (wr == 1) PG8_BAR;
    }
    PG8_WAIT_V(0);
    PG8_BAR;
#undef PG8_SA
#undef PG8_SB
#undef PG8_STAGE
#undef PG8_LDA
#undef PG8_LDB
#undef PG8_MMA
#undef PG8_WAIT_V
#undef PG8_WAIT_L
#undef PG8_BAR
#undef PG8_SCHED
}
}
using pg8::Unit;

struct Args { const void* in[37]; float* out; unsigned char* ws; int ph_lo, ph_hi; };
struct Frame {
    LAS unsigned char* lds; int tid, lane, wave, gw, NGW, G, bx, rot;
    const void* const* in; float* out; unsigned char* ws;
};
#define INF(i) ((const float*)F.in[i])
#define WSP(T, off) ((T*)(F.ws + (off)))

constexpr int LDS_TBL = LDS_STAGE;
template <class Sched> __device__ __forceinline__ void build_rs_table(LAS unsigned char* lds, const float* rs, const Sched& S, int t) {
    LAS float* tbl = (LAS float*)(lds + LDS_TBL); const int half = __builtin_amdgcn_readfirstlane(t >> 8), r = t & 255;
    f32x4 v[4][4]; bool ok[4];
#pragma unroll
    for (int j = 0; j < 4; ++j) { Unit u; ok[j] = S.next(2 * j + half, u);
        if (ok[j]) { const f32x4* p = (const f32x4*)(rs + (size_t)(u.pm * 256 + r) * 16); v[j][0] = p[0]; v[j][1] = p[1]; v[j][2] = p[2]; v[j][3] = p[3]; } }
#pragma unroll
    for (int j = 0; j < 4; ++j) if (ok[j]) { const f32x4 a = v[j][0], b = v[j][1], c = v[j][2], d = v[j][3];
        const float s = (((a.x + a.y) + (a.z + a.w)) + ((b.x + b.y) + (b.z + b.w))) + (((c.x + c.y) + (c.z + c.w)) + ((d.x + d.y) + (d.z + d.w)));
        tbl[(2 * j + half) * 256 + r] = 1.0f / sqrtf(s * (1.0f / D) + RMS_EPS); }
    __syncthreads();
}

struct PMSimple { const char* A; const char* B; size_t at, bt;
    __device__ __forceinline__ const char* a(const Unit& u) const { return A + (size_t)u.pm * at; }
    __device__ __forceinline__ const char* b(const Unit& u) const { return B + (size_t)u.pn * bt; } };

struct EpiFFN1 {
    static constexpr bool PERM = true;
    bf16_t* O; const LAS float* tbl; mutable int k;
    __device__ __forceinline__ void operator()(const f32x4 (&acc)[2][2][4][2], const Unit& u, int wr, int wc, int fr, int fq) const {
        const int row0 = u.pm * 256 + wr * 64 + fr, col0 = u.pn * 128 + wc * 32 + 8 * fq; const LAS float* tk = tbl + k * 256 + wr * 64 + fr; ++k;
#pragma unroll
        for (int ai = 0; ai < 2; ++ai)
#pragma unroll
            for (int m = 0; m < 4; ++m) { const int row = row0 + ai * 128 + m * 16; const float ir = tk[ai * 128 + m * 16];
                float o[8];
#pragma unroll
                for (int n = 0; n < 2; ++n)
#pragma unroll
                    for (int j = 0; j < 4; ++j) { const float g = acc[ai][0][m][n][j] * ir, up = acc[ai][1][m][n][j] * ir; o[n * 4 + j] = g * sigmoidf_(g) * up; }
                u32x4 w; w.x = pk2(o[0], o[1]); w.y = pk2(o[2], o[3]); w.z = pk2(o[4], o[5]); w.w = pk2(o[6], o[7]);
                *(u32x4*)(O + (size_t)row * DFF + col0) = w; }
    }
};
struct EpiResid {
    static constexpr bool PERM = false;
    float* H; bf16_t* HB; float* rs; float scale; float* part;
    __device__ __forceinline__ void operator()(const f32x4 (&acc)[2][2][4][2], const Unit& u, int wr, int wc, int fr, int fq) const {
        const int row0 = u.pm * 256 + wr * 64 + fr, col0 = u.pn * 256 + wc * 32 + 4 * fq;
        if (u.nk) { float* dst = part + (size_t)(u.k0 / u.nk) * MS * D;
#pragma unroll
            for (int ai = 0; ai < 2; ++ai)
#pragma unroll
                for (int m = 0; m < 4; ++m) { const int row = row0 + ai * 128 + m * 16 - MP;
#pragma unroll
                    for (int bj = 0; bj < 2; ++bj)
#pragma unroll
                        for (int n = 0; n < 2; ++n) *(f32x4*)(dst + (size_t)row * D + col0 + bj * 128 + n * 16) = acc[ai][bj][m][n]; }
            return; }
#pragma unroll
        for (int ai = 0; ai < 2; ++ai) {
            f32x4 hv[4][2][2];
#pragma unroll
            for (int m = 0; m < 4; ++m)
#pragma unroll
                for (int bj = 0; bj < 2; ++bj)
#pragma unroll
                    for (int n = 0; n < 2; ++n) hv[m][bj][n] = *(const f32x4*)(H + (size_t)(row0 + ai * 128 + m * 16) * D + col0 + bj * 128 + n * 16);
            __builtin_amdgcn_sched_barrier(0);
#pragma unroll
            for (int m = 0; m < 4; ++m) { const int row = row0 + ai * 128 + m * 16; float ss = 0.f;
#pragma unroll
                for (int bj = 0; bj < 2; ++bj)
#pragma unroll
                    for (int n = 0; n < 2; ++n) { const size_t off = (size_t)row * D + col0 + bj * 128 + n * 16;
                        f32x4 h = hv[m][bj][n]; h = h + acc[ai][bj][m][n] * scale; *(f32x4*)(H + off) = h;
                        u32x2 w; w.x = pk2(h.x, h.y); w.y = pk2(h.z, h.w); *(u32x2*)(HB + off) = w;
                        ss += (h.x * h.x + h.y * h.y) + (h.z * h.z + h.w * h.w); }
                ss += shflx(ss, 16); ss += shflx(ss, 32);
                if (fq == 0) rs[(size_t)row * 16 + u.pn * 4 + wc] = ss; }
            __builtin_amdgcn_sched_barrier(0); }
    }
};
struct EpiR2 {
    static constexpr bool PERM = false;
    float* RKV; int vslot; bf16_t* LH; bf16_t* SCN;
    __device__ __forceinline__ void operator()(const f32x4 (&acc)[2][2][4][2], const Unit& u, int wr, int wc, int fr, int fq) const {
        const int row0 = u.pm * 256 + wr * 64 + fr, cl0 = wc * 32 + 4 * fq;
        if (u.pn < 12 && u.pm < MP / 256) {
            const int q = u.pn >> 2;
#pragma unroll
            for (int ai = 0; ai < 2; ++ai)
#pragma unroll
                for (int m = 0; m < 4; ++m) { const int row = row0 + ai * 128 + m * 16, b = row >> 12, t = row & (TP - 1);
#pragma unroll
                    for (int bj = 0; bj < 2; ++bj)
#pragma unroll
                        for (int n = 0; n < 2; ++n) { const int head = (u.pn & 3) * 4 + 2 * bj + (wc >> 1), ch = 32 * (wc & 1) + 16 * n + 4 * fq; const f32x4 v = acc[ai][bj][m][n];
                            u32x2 w; w.x = pk2(v.x, v.y); w.y = pk2(v.z, v.w); *(u32x2*)(SCN + ((size_t)(b * NH + head) * TP + t) * 448 + q * 64 + ch) = w; } }
        } else if (u.pn < 12) { const int slot = u.pn < 4 ? 0 : (u.pn < 8 ? 1 : vslot); float* dst = RKV + (size_t)slot * MT * D; const int cb = (u.pn & 3) * 256;
#pragma unroll
            for (int ai = 0; ai < 2; ++ai)
#pragma unroll
                for (int m = 0; m < 4; ++m) { const int row = row0 + ai * 128 + m * 16;
#pragma unroll
                    for (int bj = 0; bj < 2; ++bj)
#pragma unroll
                        for (int n = 0; n < 2; ++n) *(f32x4*)(dst + (size_t)row * D + cb + cl0 + bj * 128 + n * 16) = acc[ai][bj][m][n]; }
        } else {
            const int q = u.pn - 12; const int lim = q == 0 ? 64 : (q == 1 ? 64 : (q == 2 ? 160 : 96)); const int base = q == 0 ? 0 : (q == 1 ? 64 : (q == 2 ? 128 : 288));
#pragma unroll
            for (int ai = 0; ai < 2; ++ai)
#pragma unroll
                for (int m = 0; m < 4; ++m) { const int row = row0 + ai * 128 + m * 16;
#pragma unroll
                    for (int bj = 0; bj < 2; ++bj)
#pragma unroll
                        for (int n = 0; n < 2; ++n) { const int c = cl0 + bj * 128 + n * 16; if (c < lim) { f32x4 v = acc[ai][bj][m][n];
                            if (q == 0) { v.x = tanh_fast(v.x); v.y = tanh_fast(v.y); v.z = tanh_fast(v.z); v.w = tanh_fast(v.w); }
                            if (q == 2) { v.x = sigmoidf_(v.x); v.y = sigmoidf_(v.y); v.z = sigmoidf_(v.z); v.w = sigmoidf_(v.w); }
                            if (q == 3 && c >= 32) v = (f32x4){0.f, 0.f, 0.f, 0.f};
                            u32x2 w; w.x = pk2(v.x, v.y); w.y = pk2(v.z, v.w); *(u32x2*)(LH + (size_t)row * KR3 + base + c) = w; } } }
        }
    }
};
struct PMR2 { const char* XS; const char* B;
    __device__ __forceinline__ const char* a(const Unit& u) const { const int s = u.pn < 4 ? 0 : (u.pn < 8 ? 1 : (u.pn < 12 ? 2 : (u.pn == 15 ? 2 : u.pn - 9))); return XS + ((size_t)s * MT + (size_t)u.pm * 256) * D * 2; }
    __device__ __forceinline__ const char* b(const Unit& u) const { return B + (size_t)u.pn * 256 * D * 2; } };
struct EpiR3 {
    static constexpr bool PERM = false;
    float* LU; bf16_t* SCN;
    __device__ __forceinline__ void operator()(const f32x4 (&acc)[2][2][4][2], const Unit& u, int wr, int wc, int fr, int fq) const {
        const int row0 = u.pm * 256 + wr * 64 + fr, col0 = u.pn * 256 + wc * 32 + 4 * fq;
        if (u.pm < MP / 256) { const int q = 3 + (u.pn >> 2);
#pragma unroll
            for (int ai = 0; ai < 2; ++ai)
#pragma unroll
                for (int m = 0; m < 4; ++m) { const int row = row0 + ai * 128 + m * 16, b = row >> 12, t = row & (TP - 1);
#pragma unroll
                    for (int bj = 0; bj < 2; ++bj)
#pragma unroll
                        for (int n = 0; n < 2; ++n) { const int head = (u.pn & 3) * 4 + 2 * bj + (wc >> 1), ch = 32 * (wc & 1) + 16 * n + 4 * fq; const f32x4 v = acc[ai][bj][m][n];
                            u32x2 w; w.x = pk2(v.x, v.y); w.y = pk2(v.z, v.w); *(u32x2*)(SCN + ((size_t)(b * NH + head) * TP + t) * 448 + q * 64 + ch) = w; } }
        } else {
#pragma unroll
            for (int ai = 0; ai < 2; ++ai)
#pragma unroll
                for (int m = 0; m < 4; ++m) { float* rowp = LU + (size_t)(row0 + ai * 128 + m * 16) * NR3 + col0;
#pragma unroll
                    for (int bj = 0; bj < 2; ++bj)
#pragma unroll
                        for (int n = 0; n < 2; ++n) *(f32x4*)(rowp + bj * 128 + n * 16) = acc[ai][bj][m][n]; } }
    }
};
struct EpiF32 {
    static constexpr bool PERM = false;
    float* C; int ldc;
    __device__ __forceinline__ void operator()(const f32x4 (&acc)[2][2][4][2], const Unit& u, int wr, int wc, int fr, int fq) const {
        const int row0 = u.pm * 256 + wr * 64 + fr, col0 = u.pn * 256 + wc * 32 + 4 * fq;
#pragma unroll
        for (int ai = 0; ai < 2; ++ai)
#pragma unroll
            for (int m = 0; m < 4; ++m) { float* rowp = C + (size_t)(row0 + ai * 128 + m * 16) * ldc + col0;
#pragma unroll
                for (int bj = 0; bj < 2; ++bj)
#pragma unroll
                    for (int n = 0; n < 2; ++n) *(f32x4*)(rowp + bj * 128 + n * 16) = acc[ai][bj][m][n]; }
    }
};
struct EpiKV {
    static constexpr bool PERM = false;
    float* out; float* winp; const LAS float* tbl; mutable int k;
    __device__ __forceinline__ void operator()(const f32x4 (&acc)[2][2][4][2], const Unit& u, int wr, int wc, int fr, int fq) const {
        const int row0 = u.pm * 256 + wr * 64 + fr, col0 = u.pn * 256 + wc * 32 + 4 * fq; const LAS float* tk = tbl + k * 256 + wr * 64 + fr; ++k;
#pragma unroll
        for (int ai = 0; ai < 2; ++ai)
#pragma unroll
            for (int m = 0; m < 4; ++m) { const int row = row0 + ai * 128 + m * 16; const float ir = tk[ai * 128 + m * 16];
#pragma unroll
                for (int bj = 0; bj < 2; ++bj)
#pragma unroll
                    for (int n = 0; n < 2; ++n) { const int c = col0 + bj * 128 + n * 16; const f32x4 v = acc[ai][bj][m][n] * ir;
                        if (c < 1024) { float* dst = row < MP ? out + O_PCS + (size_t)row * 1024 + c : out + O_SCS + (size_t)(row - MP) * 1024 + c; *(f32x4*)dst = v; }
                        else { const int c2 = c - 1024;
                            if (row < MP) { *(f32x4*)(winp + (size_t)row * 512 + c2) = v; const int t = row & (TP - 1), b = row >> 12;
                                if (t >= TP - 512) *(f32x4*)(out + O_PWIN + ((size_t)b * 512 + (t - (TP - 512))) * 512 + c2) = v; }
                            else { const int ms = row - MP, b = ms >> 2, t = ms & 3; *(f32x4*)(out + O_SWIN + ((size_t)b * 512 + 508 + t) * 512 + c2) = v; } } } }
    }
};
struct EpiQI {
    static constexpr bool PERM = false;
    float* QG; bf16_t* QB; const LAS float* tbl; mutable int k;
    __device__ __forceinline__ void operator()(const f32x4 (&acc)[2][2][4][2], const Unit& u, int wr, int wc, int fr, int fq) const {
        const int row0 = u.pm * 256 + wr * 64 + fr, col0 = u.pn * 256 + wc * 32 + 4 * fq; const LAS float* tk = tbl + k * 256 + wr * 64 + fr; ++k;
#pragma unroll
        for (int ai = 0; ai < 2; ++ai)
#pragma unroll
            for (int m = 0; m < 4; ++m) { const int row = row0 + ai * 128 + m * 16; const float ir = tk[ai * 128 + m * 16];
#pragma unroll
                for (int bj = 0; bj < 2; ++bj)
#pragma unroll
                    for (int n = 0; n < 2; ++n) { const int c = col0 + bj * 128 + n * 16; f32x4 v = acc[ai][bj][m][n] * ir;
                        if (c < 1024) { v = v * 0.125f; const f32x4 v2 = v * 1.4426950408889634f; u32x2 w; w.x = pk2(v2.x, v2.y); w.y = pk2(v2.z, v2.w); *(u32x2*)(QB + (size_t)row * D + c) = w; }
                        else { v.x = sigmoidf_(v.x); v.y = sigmoidf_(v.y); v.z = sigmoidf_(v.z); v.w = sigmoidf_(v.w); }
                        *(f32x4*)(QG + (size_t)row * NQI + c) = v; } }
    }
};
struct OrderC1 { int G, c;
    __device__ bool next(int i, Unit& u) const { const int L = i * G + c; if (L >= 2 * (CROWS / 256)) return false; u.pn = L / (CROWS / 256); u.pm = L % (CROWS / 256); u.k0 = 0; u.nk = 0; return true; } };
struct PMC1 { const char* A; const char* B;
    __device__ __forceinline__ const char* a(const Unit& u) const { return A + ((size_t)u.pn * CROWS + (size_t)u.pm * 256) * 1024 * 2; }
    __device__ __forceinline__ const char* b(const Unit& u) const { return B + (size_t)u.pn * 256 * 1024 * 2; } };
struct EpiC1 {
    static constexpr bool PERM = false;
    float* C;
    __device__ __forceinline__ void operator()(const f32x4 (&acc)[2][2][4][2], const Unit& u, int wr, int wc, int fr, int fq) const {
        const int row0 = u.pm * 256 + wr * 64 + fr, col0 = wc * 32 + 4 * fq;
#pragma unroll
        for (int ai = 0; ai < 2; ++ai)
#pragma unroll
            for (int m = 0; m < 4; ++m) { float* rowp = C + ((size_t)u.pn * CROWS + row0 + ai * 128 + m * 16) * 256 + col0;
#pragma unroll
                for (int bj = 0; bj < 2; ++bj)
#pragma unroll
                    for (int n = 0; n < 2; ++n) *(f32x4*)(rowp + bj * 128 + n * 16) = acc[ai][bj][m][n]; }
    }
};


#ifndef EN_P0
#define EN_P0 1
#endif
#ifndef EN_GEMM
#define EN_GEMM 1
#endif
#ifndef EN_ELT
#define EN_ELT 1
#endif
#ifndef EN_SCAN
#define EN_SCAN 1
#endif
#ifndef EN_ATT
#define EN_ATT 1
#endif

__device__ __forceinline__ int vt_slot(int k) { const int kk = k & 15; return (k & ~15) + ((kk >> 2) & 1) * 8 + (kk & 3) + 4 * (kk >> 3); }
struct RowInfo { int stream, b, t, tlen; };
__device__ __forceinline__ RowInfo row_info(int m) { RowInfo r; if (m < MP) { r.stream = 0; r.b = m >> 12; r.t = m & (TP - 1); r.tlen = TP; } else { const int ms = m - MP; r.stream = 1; r.b = ms >> 2; r.t = ms & 3; r.tlen = TS; } return r; }

__device__ __forceinline__ void transpose_item(const float* W, int ldw, int nvalid, int k0, int n0, bf16_t* WT, int ldk, int drow0, const float* kscale, LAS float* scr, int lane) {
    float tv[32], kv[32];
#pragma unroll
    for (int i = 0; i < 32; ++i) { const int kk = 2 * i + (lane >> 5), col = n0 + (lane & 31); tv[i] = col < nvalid ? W[(size_t)(k0 + kk) * ldw + col] : 0.f; }
    if (kscale) {
#pragma unroll
        for (int i = 0; i < 32; ++i) kv[i] = kscale[k0 + 2 * i + (lane >> 5)]; }
#pragma unroll
    for (int i = 0; i < 32; ++i) { const int kk = 2 * i + (lane >> 5); float v = tv[i]; if (kscale) v *= kv[i]; scr[kk * 33 + (lane & 31)] = v; }
    LDS_WAIT(); asm volatile("" ::: "memory");
    const int c = lane & 7;
    float rv[4][8];
#pragma unroll
    for (int j = 0; j < 4; ++j) { const int n = (lane >> 3) + 8 * j; const LAS float* s = scr + (8 * c) * 33 + n;
#pragma unroll
        for (int e = 0; e < 8; ++e) rv[j][e] = s[e * 33]; }
    __builtin_amdgcn_sched_barrier(0);
#pragma unroll
    for (int j = 0; j < 4; ++j) { const int n = (lane >> 3) + 8 * j;
        u32x4 o; o.x = pk2(rv[j][0], rv[j][1]); o.y = pk2(rv[j][2], rv[j][3]); o.z = pk2(rv[j][4], rv[j][5]); o.w = pk2(rv[j][6], rv[j][7]);
        *(u32x4*)(WT + (size_t)(drow0 + n) * ldk + k0 + 8 * c) = o; }
    LDS_WAIT(); asm volatile("" ::: "memory");
}
__device__ __forceinline__ void transpose_matrix(Frame& F, const float* W, int K, int N, int nvalid, bf16_t* WT, int ldk, int drow_base, const float* kscale, LAS float* scr) {
    const int ng = (N + 31) / 32, nk = K / 64, nit = ng * nk;
    { const int st = F.gw - F.rot; for (int it = st < 0 ? st + F.NGW : st; it < nit; it += F.NGW) { const int kb = it / ng, nb = it % ng; transpose_item(W, N, nvalid, kb * 64, nb * 32, WT, ldk, drow_base + nb * 32, kscale, scr, F.lane); } }
    F.rot = (F.rot + nit) % F.NGW;
}
__device__ __forceinline__ void zero_bf16(Frame& F, bf16_t* p, size_t n8) {
    u32x4 z = (u32x4){0u, 0u, 0u, 0u};
    for (size_t i = (size_t)F.bx * NTHREADS + F.tid; i < n8; i += (size_t)F.G * NTHREADS) ((u32x4*)p)[i] = z;
}
__device__ __forceinline__ void p0_ffn(Frame& F, int lf, LAS float* scr) {
    const float* norm_g = INF(7);
    const float* Win = INF(8) + (size_t)lf * D * 2 * DFF; bf16_t* WT = WSP(bf16_t, WS_WIN) + (size_t)lf * 2 * DFF * D;
    const float* g = norm_g + (size_t)((lf >> 1) * 3 + ((lf & 1) ? 2 : 0)) * D;
    const int ng = 2 * DFF / 32, nit = ng * (D / 64);
    const int st0_ = F.gw - F.rot; F.rot = (F.rot + nit) % F.NGW;
    for (int it = st0_ < 0 ? st0_ + F.NGW : st0_; it < nit; it += F.NGW) { const int kb = it / ng, nb = it % ng; const int col = nb * 32; const int isup = col >= DFF, j = isup ? col - DFF : col;
        const int drow = (j >> 7) * 256 + isup * 128 + (j & 127);
        transpose_item(Win, 2 * DFF, 2 * DFF, kb * 64, col, WT, D, drow, g, scr, F.lane); }
    transpose_matrix(F, INF(9) + (size_t)lf * DFF * D, DFF, D, D, WSP(bf16_t, WS_WOUT) + (size_t)lf * D * DFF, DFF, 0, nullptr, scr);
}
__device__ __forceinline__ void p0_rwkv(Frame& F, int l, bool with_lora, LAS float* scr) {
    bf16_t* W2 = WSP(bf16_t, WS_WR2) + (size_t)l * NR2 * D;
    for (int c = 0; c < 3; ++c) transpose_matrix(F, INF(11) + ((size_t)l * 3 + c) * D * D, D, D, D, W2, D, c * 1024, nullptr, scr);
    if (!with_lora) zero_bf16(F, W2 + (size_t)3072 * D, (size_t)1024 * D * 2 / 16);
    else {
        zero_bf16(F, W2 + (size_t)3136 * D, (size_t)(3328 - 3136) * D * 2 / 16); zero_bf16(F, W2 + (size_t)3392 * D, (size_t)(3584 - 3392) * D * 2 / 16);
        zero_bf16(F, W2 + (size_t)3744 * D, (size_t)(3840 - 3744) * D * 2 / 16); zero_bf16(F, W2 + (size_t)3872 * D, (size_t)(4096 - 3872) * D * 2 / 16);
        transpose_matrix(F, INF(13) + (size_t)l * D * 64, D, 64, 64, W2, D, 3072, nullptr, scr);
        transpose_matrix(F, INF(16) + (size_t)l * D * 64, D, 64, 64, W2, D, 3328, nullptr, scr);
        transpose_matrix(F, INF(18) + (size_t)l * D * 160, D, 160, 160, W2, D, 3584, nullptr, scr);
        transpose_matrix(F, INF(27), D, 32, 32, W2, D, 3840, nullptr, scr); }
    transpose_matrix(F, INF(25) + (size_t)l * D * D, D, D, D, WSP(bf16_t, WS_WRO) + (size_t)l * D * D, D, 0, nullptr, scr);
    bf16_t* W3 = WSP(bf16_t, WS_WR3) + (size_t)l * NR3 * KR3;
    const size_t nth3 = (size_t)F.G * NTHREADS;
    for (size_t i0 = (size_t)F.bx * NTHREADS + F.tid; i0 < (size_t)NR3 * KR3; i0 += 4 * nth3) { float v[4];
#pragma unroll
        for (int e = 0; e < 4; ++e) { const size_t i = i0 + e * nth3; v[e] = 0.f; if (i < (size_t)NR3 * KR3) { const int n = (int)(i / KR3), k = (int)(i % KR3), q = n >> 10, ch = n & 1023;
            if (q == 0) { if (k < 64) v[e] = INF(14)[((size_t)l * 64 + k) * D + ch]; }
            else if (q == 1) { if (k >= 64 && k < 128) v[e] = INF(17)[((size_t)l * 64 + (k - 64)) * D + ch]; }
            else if (q == 2) { if (k >= 128 && k < 288) v[e] = INF(19)[((size_t)l * 160 + (k - 128)) * D + ch]; }
            else { if (l == 1 && k >= 288 && k < 320) v[e] = INF(28)[(size_t)(k - 288) * D + ch]; } } }
#pragma unroll
        for (int e = 0; e < 4; ++e) { const size_t i = i0 + e * nth3; if (i < (size_t)NR3 * KR3) W3[i] = (bf16_t)f2bf(v[e]); } }
}
constexpr int SWIN_SPLIT = 96;
__device__ __forceinline__ void swin_copy(Frame& F, int b_lo, int b_hi) {
    const size_t per = (size_t)508 * 512 / 4; const f32x4* cw = (const f32x4*)INF(3); f32x4* sw = (f32x4*)(F.out + O_SWIN);
    const size_t nth = (size_t)F.G * NTHREADS, tot = (size_t)(b_hi - b_lo) * per;
    for (size_t i0 = (size_t)F.bx * NTHREADS + F.tid; i0 < tot; i0 += 8 * nth) { f32x4 v[8];
#pragma unroll
        for (int q = 0; q < 8; ++q) { const size_t i = i0 + q * nth; if (i < tot) { const size_t b = b_lo + i / per, r = i % per; v[q] = cw[b * (512 * 512 / 4) + 4 * 512 / 4 + r]; } }
#pragma unroll
        for (int q = 0; q < 8; ++q) { const size_t i = i0 + q * nth; if (i < tot) { const size_t b = b_lo + i / per, r = i % per; sw[b * (512 * 512 / 4) + r] = v[q]; } } }
}
__device__ __forceinline__ void p0_part(Frame& F, int part) {
    LAS float* scr = (LAS float*)(F.lds + F.wave * 16384);
    F.rot = 0;
    if (part == 0) {
        p0_ffn(F, 0, scr); p0_ffn(F, 1, scr); p0_rwkv(F, 0, false, scr);
        for (int grp = F.gw; grp < MT / 4; grp += F.NGW) { f32x4 v[4][4];
#pragma unroll
            for (int q = 0; q < 4; ++q) { const int m = grp * 4 + q; const float* src = m < MP ? INF(0) + (size_t)m * D : INF(1) + (size_t)(m - MP) * D;
#pragma unroll
                for (int j = 0; j < 4; ++j) v[q][j] = *(const f32x4*)(src + j * 256 + F.lane * 4); }
#pragma unroll
            for (int q = 0; q < 4; ++q) { const int m = grp * 4 + q; float ss = 0.f;
#pragma unroll
                for (int j = 0; j < 4; ++j) { const f32x4 x = v[q][j]; *(f32x4*)(WSP(float, WS_H) + (size_t)m * D + j * 256 + F.lane * 4) = x;
                    u32x2 w; w.x = pk2(x.x, x.y); w.y = pk2(x.z, x.w); *(u32x2*)(WSP(bf16_t, WS_HB) + (size_t)m * D + j * 256 + F.lane * 4) = w; ss += (x.x * x.x + x.y * x.y) + (x.z * x.z + x.w * x.w); }
                ss = wave_sum(ss); if (F.lane < 16) WSP(float, WS_RS)[(size_t)m * 16 + F.lane] = F.lane == 0 ? ss : 0.f; } }
    } else if (part == 1) {
        p0_ffn(F, 2, scr); p0_ffn(F, 3, scr); p0_rwkv(F, 1, true, scr);
        swin_copy(F, 0, 64);
    } else {
        const float* norm_g = INF(7);
        for (int lf = 4; lf < 6; ++lf) p0_ffn(F, lf, scr);
        for (int l = 0; l < 2; ++l) {
            transpose_matrix(F, INF(34) + (size_t)l * D * 1072, D, 1072, 1072, WSP(bf16_t, WS_WQI) + (size_t)l * NQI * D, D, 0, norm_g + (size_t)((2 + l) * 3 + 1) * D, scr);
            zero_bf16(F, WSP(bf16_t, WS_WQI) + (size_t)l * NQI * D + (size_t)1088 * D, (size_t)(NQI - 1088) * D * 2 / 16);
            transpose_matrix(F, INF(35) + (size_t)l * D * D, D, D, D, WSP(bf16_t, WS_WBO) + (size_t)l * D * D, D, 0, nullptr, scr);
            transpose_matrix(F, INF(32) + (size_t)l * 2048 * 128, 1024, 128, 128, WSP(bf16_t, WS_WC1) + (size_t)l * 256 * 1024, 1024, 0, nullptr, scr);
            transpose_matrix(F, INF(32) + (size_t)l * 2048 * 128 + (size_t)1024 * 128, 1024, 128, 128, WSP(bf16_t, WS_WC1) + (size_t)l * 256 * 1024, 1024, 128, nullptr, scr); }
        transpose_matrix(F, INF(30), D, NKVW, NKVW, WSP(bf16_t, WS_WKV), D, 0, INF(29), scr);
        for (int o = F.gw; o < 256; o += F.NGW) { const int which = o >> 7, n = o & 127; float s = 0.f;
            float pv_[32], wv_[32];
#pragma unroll
            for (int q = 0; q < 32; ++q) { const int k = F.lane + 64 * q; pv_[q] = INF(31)[(size_t)which * 2048 + k]; wv_[q] = INF(32)[((size_t)which * 2048 + k) * 128 + n]; }
#pragma unroll
            for (int q = 0; q < 32; ++q) s += pv_[q] * wv_[q];
            s = wave_sum(s); if (F.lane == 0) WSP(float, WS_POSB)[o] = s; }
    }
}
__device__ __forceinline__ void p0b_prologue(Frame& F) {
    LAS float* scr = (LAS float*)(F.lds + F.wave * 16384);
    F.rot = 0;
    bf16_t* W2 = WSP(bf16_t, WS_WR2);
    transpose_matrix(F, INF(13), D, 64, 64, W2, D, 3072, nullptr, scr);
    transpose_matrix(F, INF(16), D, 64, 64, W2, D, 3328, nullptr, scr);
    transpose_matrix(F, INF(18), D, 160, 160, W2, D, 3584, nullptr, scr);
}

__device__ __forceinline__ void r1_phase(Frame& F, int l) {
    const float* H = WSP(float, WS_H); const float* g = INF(7) + (size_t)(l * 3 + 1) * D; const float* mu = INF(10) + (size_t)l * 6 * D; bf16_t* XS = WSP(bf16_t, WS_XS);
    for (int grp = F.gw; grp < MT / 4; grp += F.NGW) { const int m0 = grp * 4; const RowInfo ri = row_info(m0);
        f32x4 x[5][4]; float ss[5];
#pragma unroll
        for (int q = 0; q < 5; ++q) { const int m = m0 - 1 + q;
            if (q > 0 || ri.t > 0) {
#pragma unroll
                for (int j = 0; j < 4; ++j) x[q][j] = *(const f32x4*)(H + (size_t)m * D + j * 256 + F.lane * 4); }
            else {
#pragma unroll
                for (int j = 0; j < 4; ++j) x[q][j] = (f32x4){0.f, 0.f, 0.f, 0.f}; } }
        __builtin_amdgcn_sched_barrier(0);
#pragma unroll
        for (int q = 0; q < 5; ++q) { ss[q] = 0.f;
#pragma unroll
            for (int j = 0; j < 4; ++j) ss[q] += (x[q][j].x * x[q][j].x + x[q][j].y * x[q][j].y) + (x[q][j].z * x[q][j].z + x[q][j].w * x[q][j].w); }
#pragma unroll
        for (int q = 0; q < 5; ++q) ss[q] = 1.0f / sqrtf(wave_sum(ss[q]) * (1.0f / D) + RMS_EPS);
#pragma unroll
        for (int j = 0; j < 4; ++j) { const int c = j * 256 + F.lane * 4; const f32x4 gg = *(const f32x4*)(g + c);
#pragma unroll
            for (int q = 0; q < 5; ++q) x[q][j] = x[q][j] * ss[q] * gg;
            if (ri.t == 0) x[0][j] = ri.stream == 1 ? *(const f32x4*)(INF(4) + ((size_t)l * NBS + ri.b) * D + c) : (f32x4){0.f, 0.f, 0.f, 0.f};
            f32x4 mm[6];
#pragma unroll
            for (int s6 = 0; s6 < 6; ++s6) mm[s6] = *(const f32x4*)(mu + (size_t)s6 * D + c);
#pragma unroll
            for (int q = 1; q < 5; ++q) { const int m = m0 - 1 + q; const f32x4 xx = x[q - 1][j] - x[q][j];
#pragma unroll
                for (int s6 = 0; s6 < 6; ++s6) { const f32x4 v = x[q][j] + xx * mm[s6]; u32x2 w; w.x = pk2(v.x, v.y); w.y = pk2(v.z, v.w); *(u32x2*)(XS + ((size_t)s6 * MT + m) * D + c) = w; } }
            if (ri.t + 4 == ri.tlen) { float* dst = ri.stream == 0 ? F.out + O_PSHIFT + ((size_t)l * NBP + ri.b) * D + c : F.out + O_SSHIFT + ((size_t)l * NBS + ri.b) * D + c; *(f32x4*)dst = x[4][j]; }
        }
    }
}

__device__ __forceinline__ float softplusf_(float x) { return fmaxf(x, 0.f) + log1pf(__expf(-fabsf(x))); }
__device__ __forceinline__ void r4_phase(Frame& F, int l) {
    const float* R = WSP(float, WS_RKV); const float* Kk = R + (size_t)MT * D; const float* V = R + (size_t)(2 + l) * MT * D; const float* VF = R + (size_t)2 * MT * D;
    const float* LU = WSP(float, WS_LU); float* SV = WSP(float, WS_SV);
    const float* w0 = INF(12) + (size_t)l * D; const float* a0 = INF(15) + (size_t)l * D; const float* k_k = INF(20) + (size_t)l * D; const float* k_a = INF(21) + (size_t)l * D; const float* v0 = INF(26);
    for (int m = MP + F.gw; m < MT; m += F.NGW) {
        const RowInfo ri = row_info(m); const int h = F.lane >> 2, j0 = (F.lane & 3) * 16, c0 = F.lane * 16;
        float* si = ri.stream == 0 ? WSP(float, WS_SIP) + (size_t)l * SIP_L + ((size_t)(ri.b * NH + h) * TP + ri.t) * SIW : WSP(float, WS_SIS) + (size_t)l * SIS_L + ((size_t)(ri.b * NH + h) * TS + ri.t) * SIW;
        float ss = 0.f;
#pragma unroll
        for (int q = 0; q < 4; ++q) { const f32x4 k = *(const f32x4*)(Kk + (size_t)m * D + c0 + q * 4), kk = *(const f32x4*)(k_k + c0 + q * 4); const f32x4 p = k * kk; ss += (p.x * p.x + p.y * p.y) + (p.z * p.z + p.w * p.w); }
        ss += shflx(ss, 1); ss += shflx(ss, 2);
        const float rn = 1.0f / sqrtf(fmaxf(ss, 1e-24f));
#pragma unroll
        for (int q = 0; q < 4; ++q) { const int c = c0 + q * 4, j = j0 + q * 4;
            const f32x4 r = *(const f32x4*)(R + (size_t)m * D + c), k = *(const f32x4*)(Kk + (size_t)m * D + c); f32x4 v = *(const f32x4*)(V + (size_t)m * D + c);
            const f32x4 wp = *(const f32x4*)(LU + (size_t)m * NR3 + c), ap = *(const f32x4*)(LU + (size_t)m * NR3 + 1024 + c);
            const f32x4 w0v = *(const f32x4*)(w0 + c), a0v = *(const f32x4*)(a0 + c), kkv = *(const f32x4*)(k_k + c), kav = *(const f32x4*)(k_a + c);
            f32x4 dec, a, km, an, bn;
#pragma unroll
            for (int e = 0; e < 4; ++e) { const float wl = -softplusf_(-(w0v[e] + wp[e])) - 0.5f; dec[e] = __expf(-__expf(wl)); a[e] = sigmoidf_(a0v[e] + ap[e]);
                const float kn = k[e] * kkv[e] * rn; an[e] = -kn; bn[e] = kn * a[e]; km[e] = k[e] * (1.0f + (a[e] - 1.0f) * kav[e]); }
            if (l == 1) { const f32x4 vg = *(const f32x4*)(LU + (size_t)m * NR3 + 3072 + c), v0v = *(const f32x4*)(v0 + c), vf = *(const f32x4*)(VF + (size_t)m * D + c);
#pragma unroll
                for (int e = 0; e < 4; ++e) v[e] = v[e] + (vf[e] - v[e]) * sigmoidf_(v0v[e] + vg[e]); }
            *(f32x4*)(si + 0 * 64 + j) = dec; *(f32x4*)(si + 1 * 64 + j) = km; *(f32x4*)(si + 2 * 64 + j) = an; *(f32x4*)(si + 3 * 64 + j) = bn; *(f32x4*)(si + 4 * 64 + j) = r;
            *(f32x4*)(SV + (size_t)m * D + c) = v; }
    }
}

__device__ __forceinline__ void scan_chain(const float* si_g, const float* v, float* y, int tlen, const float* s0, float* sT, int lane) {
    float s[64];
    if (s0) {
#pragma unroll
        for (int q = 0; q < 16; ++q) { const f32x4 t = *(const f32x4*)(s0 + (size_t)lane * 64 + q * 4); s[q * 4] = t.x; s[q * 4 + 1] = t.y; s[q * 4 + 2] = t.z; s[q * 4 + 3] = t.w; }
    } else {
#pragma unroll
        for (int j = 0; j < 64; ++j) s[j] = 0.f;
    }
    const CAS float* sp = (const CAS float*)(unsigned long long)si_g;
    for (int t = 0; t < tlen; ++t) {
        const float vi = v[(size_t)t * D + lane];
        float sa = 0.f;
#pragma unroll
        for (int j = 0; j < 64; ++j) sa += s[j] * sp[128 + j];
        float yy = 0.f;
#pragma unroll
        for (int j = 0; j < 64; ++j) { s[j] = s[j] * sp[j] + sa * sp[192 + j] + vi * sp[64 + j]; yy += s[j] * sp[256 + j]; }
        y[(size_t)t * D + lane] = yy;
        sp += SIW;
    }
#pragma unroll
    for (int q = 0; q < 16; ++q) *(f32x4*)(sT + (size_t)lane * 64 + q * 4) = (f32x4){s[q * 4], s[q * 4 + 1], s[q * 4 + 2], s[q * 4 + 3]};
}
__device__ __forceinline__ void r5_phase(Frame& F, int l) {
    const float* SV = WSP(float, WS_SV); float* YS = WSP(float, WS_YS);
    if (F.wave == 0 && F.bx < NCH_P) { const int ch = F.bx, b = ch >> 4, h = ch & 15;
        scan_chain(WSP(float, WS_SIP) + (size_t)l * SIP_L + (size_t)ch * TP * SIW, SV + (size_t)b * TP * D + h * 64, YS + (size_t)b * TP * D + h * 64, TP, nullptr, F.out + O_PWKV + ((size_t)(l * NBP + b) * NH + h) * 4096, F.lane);
    } else {
        const int nworkers = F.G * NWAVES - NCH_P; int widx = (F.wave == 0) ? F.bx - NCH_P : NCH_P * 0 + (F.G - NCH_P) + F.bx * (NWAVES - 1) + (F.wave - 1);
        for (int ch = widx; ch < NCH_S; ch += nworkers) { const int b = ch >> 4, h = ch & 15;
            scan_chain(WSP(float, WS_SIS) + (size_t)l * SIS_L + (size_t)ch * TS * SIW, SV + (size_t)(MP + b * TS) * D + h * 64, YS + (size_t)(MP + b * TS) * D + h * 64, TS,
                       INF(5) + ((size_t)(l * NBS + b) * NH + h) * 4096, F.out + O_SWKV + ((size_t)(l * NBS + b) * NH + h) * 4096, F.lane); }
        __syncthreads(); { Frame F2 = F; F2.bx = F.bx - NCH_P; F2.G = F.G - NCH_P; F2.gw = F2.bx * NWAVES + F.wave; F2.NGW = F2.G * NWAVES; p0_part(F2, 1 + l); }
    }
}


constexpr int NCHK = TP / 64;
#define RL(x, j) __builtin_bit_cast(float, __builtin_amdgcn_readlane(__builtin_bit_cast(int, (x)), (j)))
__device__ __forceinline__ float dpp_add(float v, const int ctrl_sel) {
    int r;
    if (ctrl_sel == 0) r = __builtin_amdgcn_update_dpp(0, __builtin_bit_cast(int, v), 0xB1, 0xF, 0xF, true);
    else if (ctrl_sel == 1) r = __builtin_amdgcn_update_dpp(0, __builtin_bit_cast(int, v), 0x4E, 0xF, 0xF, true);
    else if (ctrl_sel == 2) r = __builtin_amdgcn_update_dpp(0, __builtin_bit_cast(int, v), 0x141, 0xF, 0xF, true);
    else r = __builtin_amdgcn_update_dpp(0, __builtin_bit_cast(int, v), 0x140, 0xF, 0xF, true);
    return v + __builtin_bit_cast(float, r); }
__device__ __forceinline__ float wave_sum_dpp(float v) { v = dpp_add(v, 0); v = dpp_add(v, 1); v = dpp_add(v, 2); v = dpp_add(v, 3); return (RL(v, 0) + RL(v, 16)) + (RL(v, 32) + RL(v, 48)); }
struct StepIn { float w, k, a, b, r, v; };
struct RawIn { float r, k, v, wp, ap, vg, vf; };
struct ChanC { float w0, a0, kk, ka, v0; };
__device__ __forceinline__ float bf2f(bf16_t u) { return __builtin_bit_cast(float, (unsigned)u << 16); }
__device__ __forceinline__ void rawin_load(RawIn& x, const bf16_t* rec_, int lane, int l) {
    const GAS bf16_t* rec = (const GAS bf16_t*)rec_; const GAS bf16_t* rec0 = rec - (size_t)l * SCN_L; const unsigned o = (unsigned)lane;
    const GAS bf16_t* pl = rec + o;
    x.r = bf2f(pl[0]); x.k = bf2f(pl[64]); x.v = bf2f(pl[128]); x.wp = bf2f(pl[192]); x.ap = bf2f(pl[256]);
    if (l == 1) { x.vg = bf2f(pl[384]); x.vf = bf2f((rec0 + o)[128]); } else { x.vg = 0.f; x.vf = 0.f; } }
__device__ __forceinline__ void rawin_xform(StepIn& s, const RawIn& x, const LAS float* cb, int l) {
    ChanC cc; cc.w0 = cb[0]; cc.a0 = cb[64]; cc.kk = cb[128]; cc.ka = cb[192]; cc.v0 = cb[256];
    const float z = -(cc.w0 + x.wp); const float wl = -(fmaxf(z, 0.f) + __logf(1.0f + __expf(-fabsf(z)))) - 0.5f;
    s.w = __expf(-__expf(wl)); const float a = __builtin_amdgcn_rcpf(1.0f + __expf(-(cc.a0 + x.ap)));
    const float kk = x.k * cc.kk; const float ss = wave_sum_dpp(kk * kk); const float kn = kk * __builtin_amdgcn_rsqf(fmaxf(ss, 1e-24f));
    s.a = -kn; s.b = kn * a; s.k = x.k * (1.0f + (a - 1.0f) * cc.ka); s.r = x.r;
    s.v = (l == 1) ? x.v + (x.vf - x.v) * __builtin_amdgcn_rcpf(1.0f + __expf(-(cc.v0 + x.vg))) : x.v; }
struct SG8 { f32x4 bk[4], r4[2]; };
__device__ __forceinline__ f32x2 fma2(f32x2 a, f32x2 b, f32x2 c) { return __builtin_elementwise_fma(a, b, c); }
__device__ __forceinline__ void stepA(f32x2 (&g)[32], f32x2 (&tt)[32], const StepIn& s, LAS float* sb, int lane, float& y0, float& q) {
    { const int jp = (lane >> 1) * 4 + (lane & 1); sb[lane] = s.a; sb[64 + jp] = s.b; sb[64 + jp + 2] = s.k; sb[192 + lane] = s.r; }
    asm volatile("s_waitcnt lgkmcnt(0)" ::: "memory");
    f32x2 sga = (f32x2){0.f, 0.f}, sta = (f32x2){0.f, 0.f}; LAS float* pb = sb;
    f32x4 a4[16];
#pragma unroll
    for (int jq = 0; jq < 16; ++jq) a4[jq] = *(const LAS f32x4*)(pb + 4 * jq);
    SG8 d0, d1, d2;
#define SA_LD(gi, d) do { _Pragma("unroll") for (int e = 0; e < 4; ++e) d.bk[e] = *(const LAS f32x4*)(pb + 64 + 4 * (4 * (gi) + e)); \
        _Pragma("unroll") for (int e = 0; e < 2; ++e) d.r4[e] = *(const LAS f32x4*)(pb + 192 + 4 * (2 * (gi) + e)); } while (0)
#define SA_CP(gi, d) do { _Pragma("unroll") for (int e = 0; e < 4; ++e) { const int jp = 4 * (gi) + e; const f32x2 b2 = (f32x2){d.bk[e].x, d.bk[e].y}, k2 = (f32x2){d.bk[e].z, d.bk[e].w}; \
        const f32x2 r2 = (e & 1) ? (f32x2){d.r4[e >> 1].z, d.r4[e >> 1].w} : (f32x2){d.r4[e >> 1].x, d.r4[e >> 1].y}; \
        g[jp] = fma2(sv2, k2, fma2(sg2, b2, g[jp])); tt[jp] = fma2(st2, b2, tt[jp]); yab = fma2(g[jp], r2, yab); qab = fma2(tt[jp], r2, qab); } \
        asm volatile("" : "+v"(pb), "+v"(yab), "+v"(qab)); } while (0)
    SA_LD(0, d0);
#pragma unroll
    for (int jq = 0; jq < 16; ++jq) { const f32x2 lo = (f32x2){a4[jq].x, a4[jq].y}, hi = (f32x2){a4[jq].z, a4[jq].w};
        sga = fma2(g[2 * jq], lo, sga); sga = fma2(g[2 * jq + 1], hi, sga); sta = fma2(tt[2 * jq], lo, sta); sta = fma2(tt[2 * jq + 1], hi, sta); }
    const float sg = sga.x + sga.y, st = sta.x + sta.y; const f32x2 sg2 = (f32x2){sg, sg}, st2 = (f32x2){st, st}, sv2 = (f32x2){s.v, s.v}; f32x2 yab = (f32x2){0.f, 0.f}, qab = (f32x2){0.f, 0.f};
    asm volatile("" : "+v"(pb), "+v"(yab));
    SA_LD(1, d1); SA_LD(2, d2);
    SA_CP(0, d0); SA_LD(3, d0); SA_CP(1, d1); SA_LD(4, d1); SA_CP(2, d2); SA_LD(5, d2); SA_CP(3, d0); SA_LD(6, d0);
    SA_CP(4, d1); SA_LD(7, d1); SA_CP(5, d2); SA_CP(6, d0); SA_CP(7, d1);
#undef SA_LD
#undef SA_CP
    y0 = yab.x + yab.y; q = qab.x + qab.y;
    asm volatile("" ::: "memory");
}
__device__ __forceinline__ float stepC(float (&g)[64], const StepIn& s) {
    float sg0 = 0.f, sg1 = 0.f;
#pragma unroll
    for (int j = 0; j < 64; j += 2) { sg0 = fmaf(g[j], RL(s.a, j), sg0); sg1 = fmaf(g[j + 1], RL(s.a, j + 1), sg1); if ((j & 15) == 14) __builtin_amdgcn_sched_barrier(0); }
    const float sg = sg0 + sg1; float y0 = 0.f, y1 = 0.f;
#pragma unroll
    for (int j = 0; j < 64; j += 2) {
        g[j] = fmaf(s.v, RL(s.k, j), fmaf(sg, RL(s.b, j), g[j] * RL(s.w, j))); y0 = fmaf(g[j], RL(s.r, j), y0);
        g[j + 1] = fmaf(s.v, RL(s.k, j + 1), fmaf(sg, RL(s.b, j + 1), g[j + 1] * RL(s.w, j + 1))); y1 = fmaf(g[j + 1], RL(s.r, j + 1), y1);
        if ((j & 7) == 6) __builtin_amdgcn_sched_barrier(0); }
    return y0 + y1;
}
__device__ __forceinline__ void scanA_phase(Frame& F, int l) {
    const bf16_t* SCN = WSP(bf16_t, WS_SCN) + (size_t)l * SCN_L; float* TG = WSP(float, WS_TG);
    for (int job = F.gw; job < NCH_P * NCHK; job += F.NGW) { const int ch = job >> 6, c = job & 63, b = ch >> 4, h = ch & 15; const size_t m0 = (size_t)b * TP + c * 64;
        int lane_; asm volatile("v_mbcnt_lo_u32_b32 %0, -1, 0\n\tv_mbcnt_hi_u32_b32 %0, -1, %0" : "=v"(lane_)); const int lane = lane_, cn = h * 64 + lane;
        f32x2 g[32], tt[32]; LAS float* sb = (LAS float*)(F.lds + F.wave * 4096); LAS float* cb = sb + 320 + lane;
        cb[0] = INF(12)[(size_t)l * D + cn]; cb[64] = INF(15)[(size_t)l * D + cn]; cb[128] = INF(20)[(size_t)l * D + cn]; cb[192] = INF(21)[(size_t)l * D + cn]; cb[256] = INF(26)[cn]; cb[320] = INF(22)[(size_t)l * D + cn];
#pragma unroll
        for (int j = 0; j < 32; ++j) { g[j] = (f32x2){0.f, 0.f}; tt[j] = (f32x2){(2 * j == lane) ? 1.f : 0.f, (2 * j + 1 == lane) ? 1.f : 0.f}; }
        const size_t rbase = ((size_t)ch * TP + c * 64) * 448;
        StepIn s; float Pj = 1.0f; unsigned ur, uk, uv, uw, ua, ug = 0u, uf = 0u; const unsigned vo = (unsigned)lane * 2u;
#define GLD_U16(dst, base, OFF) asm volatile("global_load_ushort %0, %1, %2 offset:" #OFF : "=v"(dst) : "v"(vo), "s"(base) : "memory")
#define RAW_ISSUE(tt_) do { const unsigned long long a_ = (unsigned long long)(SCN + rbase + (size_t)(tt_) * 448); \
            const unsigned long long rb_ = ((unsigned long long)(unsigned)__builtin_amdgcn_readfirstlane((unsigned)(a_ >> 32)) << 32) | (unsigned)__builtin_amdgcn_readfirstlane((unsigned)a_); \
            GLD_U16(ur, rb_, 0); GLD_U16(uk, rb_, 128); GLD_U16(uv, rb_, 256); GLD_U16(uw, rb_, 384); GLD_U16(ua, rb_, 512); \
            if (l == 1) { GLD_U16(ug, rb_, 768); const unsigned long long r0_ = rb_ - (unsigned long long)SCN_L * 2ull; GLD_U16(uf, r0_, 256); } } while (0)
        RAW_ISSUE(0);
        GAS float* yq = (GAS float*)(WSP(float, WS_YQ) + (size_t)job * 12288);
        float py0 = 0.f, pq = 0.f, pvb = 0.f;
#pragma unroll 1
        for (int t = 0; t < 64; ++t) {
            asm volatile("s_waitcnt vmcnt(0)" : "+v"(ur), "+v"(uk), "+v"(uv), "+v"(uw), "+v"(ua), "+v"(ug), "+v"(uf) : : "memory");
            if (t > 0) { const unsigned o = (unsigned)((t - 1) * 64 + lane); yq[o] = py0; yq[4096 + o] = pq; yq[8192 + o] = pvb; }
            RawIn x0; x0.r = __builtin_bit_cast(float, ur << 16); x0.k = __builtin_bit_cast(float, uk << 16); x0.v = __builtin_bit_cast(float, uv << 16); x0.wp = __builtin_bit_cast(float, uw << 16); x0.ap = __builtin_bit_cast(float, ua << 16);
            x0.vg = __builtin_bit_cast(float, ug << 16); x0.vf = __builtin_bit_cast(float, uf << 16);
            asm volatile("" : "+v"(x0.r), "+v"(x0.k), "+v"(x0.v), "+v"(x0.wp), "+v"(x0.ap), "+v"(x0.vg), "+v"(x0.vf));
            if (t + 1 < 64) RAW_ISSUE(t + 1);
            rawin_xform(s, x0, cb, l);
            const float bon = wave_sum_dpp(s.r * s.k * cb[320]);
            { const float Pp = Pj; Pj *= s.w; const float iP = __builtin_amdgcn_rcpf(Pj); s.a *= Pp; s.b *= iP; s.k *= iP; s.r *= Pj; }
            float y0, q; stepA(g, tt, s, sb, lane, y0, q); py0 = y0; pq = q; pvb = s.v * bon; }
        { const unsigned o = (unsigned)(63 * 64 + lane); yq[o] = py0; yq[4096 + o] = pq; yq[8192 + o] = pvb; }
#undef RAW_ISSUE
#undef GLD_U16
        float* gt = TG + (size_t)job * 8192; float* tm = gt + 4096;
        sb[lane] = Pj; asm volatile("s_waitcnt lgkmcnt(0)" ::: "memory");
#pragma unroll
        for (int j = 0; j < 32; ++j) { const f32x2 p2 = *(const LAS f32x2*)(sb + 2 * j); g[j] = g[j] * p2; tt[j] = tt[j] * p2; }
#pragma unroll
        for (int j = 0; j < 32; ++j) { gt[(2 * j) * 64 + lane] = g[j].x; gt[(2 * j + 1) * 64 + lane] = g[j].y; }
#pragma unroll
        for (int q = 0; q < 16; ++q) *(f32x4*)(tm + lane * 64 + q * 4) = (f32x4){tt[2 * q].x, tt[2 * q].y, tt[2 * q + 1].x, tt[2 * q + 1].y};
    }
}
__device__ __forceinline__ void scanC_phase(Frame& F, int l) {
    const bf16_t* SCN = WSP(bf16_t, WS_SCN) + (size_t)l * SCN_L; bf16_t* YG = WSP(bf16_t, WS_YG); const float* SS = WSP(float, WS_SS);
    const int lane = F.lane, c16 = lane & 15, g4 = lane >> 4;
    for (int job = F.gw; job < NCH_P * NCHK; job += F.NGW) { const int ch = job >> 6, c = job & 63, b = ch >> 4, h = ch & 15; const size_t m0 = (size_t)b * TP + c * 64;
        const float* yq = WSP(float, WS_YQ) + (size_t)job * 12288; const float* sp = SS + (size_t)job * 4096;
        float lw[4], lb[4];
#pragma unroll
        for (int ct = 0; ct < 4; ++ct) { lw[ct] = INF(23)[(size_t)l * D + h * 64 + 16 * ct + c16]; lb[ct] = INF(24)[(size_t)l * D + h * 64 + 16 * ct + c16]; }
        float sv[16][4];
        if (c > 0) {
#pragma unroll
            for (int ks = 0; ks < 16; ++ks)
#pragma unroll
                for (int ct = 0; ct < 4; ++ct) sv[ks][ct] = sp[(16 * ct + c16) * 64 + 4 * ks + g4]; }
#pragma unroll 1
        for (int tt = 0; tt < 4; ++tt) {
            f32x4 acc[4]; float av[16], vbv[4][4], gtv[4][4];
#pragma unroll
            for (int ct = 0; ct < 4; ++ct)
#pragma unroll
                for (int rg = 0; rg < 4; ++rg) acc[ct][rg] = yq[(16 * tt + 4 * g4 + rg) * 64 + 16 * ct + c16];
#pragma unroll
            for (int ks = 0; ks < 16; ++ks) av[ks] = yq[4096 + (16 * tt + c16) * 64 + 4 * ks + g4];
#pragma unroll
            for (int rg = 0; rg < 4; ++rg)
#pragma unroll
                for (int ct = 0; ct < 4; ++ct) { const int t = 16 * tt + 4 * g4 + rg, i = 16 * ct + c16; vbv[rg][ct] = yq[8192 + t * 64 + i]; gtv[rg][ct] = bf2f(SCN[((size_t)ch * TP + c * 64 + t) * 448 + 320 + i]); }
            if (c > 0) {
#pragma unroll
                for (int ks = 0; ks < 16; ++ks)
#pragma unroll
                    for (int ct = 0; ct < 4; ++ct) acc[ct] = __builtin_amdgcn_mfma_f32_16x16x4f32(av[ks], sv[ks][ct], acc[ct], 0, 0, 0); }
#pragma unroll
            for (int rg = 0; rg < 4; ++rg) { const int t = 16 * tt + 4 * g4 + rg;
                float s1 = (acc[0][rg] + acc[1][rg]) + (acc[2][rg] + acc[3][rg]);
                s1 += shflx(s1, 1); s1 += shflx(s1, 2); s1 += shflx(s1, 4); s1 += shflx(s1, 8);
                const float mean = s1 * (1.0f / 64.0f); float d[4], s2 = 0.f;
#pragma unroll
                for (int ct = 0; ct < 4; ++ct) { d[ct] = acc[ct][rg] - mean; s2 += d[ct] * d[ct]; }
                s2 += shflx(s2, 1); s2 += shflx(s2, 2); s2 += shflx(s2, 4); s2 += shflx(s2, 8);
                const float rstd = 1.0f / sqrtf(s2 * (1.0f / 64.0f) + GN_EPS);
#pragma unroll
                for (int ct = 0; ct < 4; ++ct) { const int i = 16 * ct + c16;
                    YG[(m0 + t) * D + h * 64 + i] = (bf16_t)f2bf((d[ct] * rstd * lw[ct] + lb[ct] + vbv[rg][ct]) * gtv[rg][ct]); } }
        }
    }
}
__device__ __forceinline__ void scanB_phase(Frame& F, int l) {
    if (F.bx < NCH_P) {
        const int ch = F.bx, b = ch >> 4, h = ch & 15, w = F.wave, lane = F.lane, c16 = lane & 15, g4 = lane >> 4;
        const float* TG = WSP(float, WS_TG) + (size_t)ch * NCHK * 8192; float* SS = WSP(float, WS_SS) + (size_t)ch * NCHK * 4096;
        LAS float* TL = (LAS float*)F.lds;
        LAS float* SL = (LAS float*)(F.lds + 49152) + w * (16 * 68);
        LAS float* GL = (LAS float*)(F.lds + 81920);
        if (w < 4) { for (int e = lane; e < 16 * 68; e += 64) SL[e] = 0.f; }
#define SCANB_DMA(cc_) do { const char* src_ = (const char*)(TG + (size_t)(cc_) * 8192 + 4096); LAS char* dst_ = (LAS char*)TL + ((cc_) % 3) * 16384; \
        _Pragma("unroll") for (int i4 = 0; i4 < 4; ++i4) __builtin_amdgcn_global_load_lds((const unsigned*)(src_ + (i4 * 256 + (w - 4) * 64 + lane) * 16), (LAS unsigned*)(dst_ + (i4 * 256 + (w - 4) * 64) * 16), 16, 0, 0); \
        const char* srg_ = (const char*)(TG + (size_t)(cc_) * 8192); LAS char* dsg_ = (LAS char*)GL + ((cc_) % 3) * 16384; \
        _Pragma("unroll") for (int i4 = 0; i4 < 4; ++i4) { const int s_ = i4 * 256 + (w - 4) * 64 + lane, R_ = s_ >> 4; \
            __builtin_amdgcn_global_load_lds((const unsigned*)(srg_ + (R_ * 16 + ((s_ & 15) ^ (R_ & 15))) * 16), (LAS unsigned*)(dsg_ + (i4 * 256 + (w - 4) * 64) * 16), 16, 0, 0); } } while (0)
        if (w >= 4) { SCANB_DMA(0); SCANB_DMA(1); asm volatile("s_waitcnt vmcnt(8)" ::: "memory"); }
        asm volatile("s_waitcnt lgkmcnt(0)" ::: "memory"); __syncthreads();
        for (int c = 0; c < NCHK; ++c) {
            if (w >= 4 && c + 2 < NCHK) SCANB_DMA(c + 2);
            if (w < 4) { const LAS float* tl = TL + (c % 3) * 4096; const LAS float* gl = GL + (c % 3) * 4096; f32x4 acc[4], gv[4];
#pragma unroll
                for (int ct = 0; ct < 4; ++ct) acc[ct] = (f32x4){0.f, 0.f, 0.f, 0.f};
                float av[16], tv[2][4][4];
#pragma unroll
                for (int ks = 0; ks < 16; ++ks) av[ks] = SL[c16 * 68 + 4 * ks + g4];
#pragma unroll
                for (int ct = 0; ct < 4; ++ct) gv[ct] = *(const LAS f32x4*)(gl + (16 * ct + c16) * 64 + 4 * ((4 * w + g4) ^ c16));
#pragma unroll
                for (int k4 = 0; k4 < 4; ++k4)
#pragma unroll
                    for (int ct = 0; ct < 4; ++ct) tv[0][k4][ct] = tl[(4 * k4 + g4) * 64 + 16 * ct + c16];
                __builtin_amdgcn_sched_barrier(0);
#pragma unroll
                for (int grp = 0; grp < 4; ++grp) {
                    if (grp < 3) {
#pragma unroll
                        for (int k4 = 0; k4 < 4; ++k4)
#pragma unroll
                            for (int ct = 0; ct < 4; ++ct) tv[(grp + 1) & 1][k4][ct] = tl[(4 * (4 * (grp + 1) + k4) + g4) * 64 + 16 * ct + c16]; }
                    __builtin_amdgcn_sched_barrier(0);
#pragma unroll
                    for (int k4 = 0; k4 < 4; ++k4)
#pragma unroll
                        for (int ct = 0; ct < 4; ++ct) acc[ct] = __builtin_amdgcn_mfma_f32_16x16x4f32(av[4 * grp + k4], tv[grp & 1][k4][ct], acc[ct], 0, 0, 0);
                    __builtin_amdgcn_sched_barrier(0); }
#pragma unroll
                for (int ct = 0; ct < 4; ++ct) acc[ct] = acc[ct] + gv[ct];
                asm volatile("s_waitcnt lgkmcnt(0)" ::: "memory");
                GAS float* so = (GAS float*)((c + 1 < NCHK) ? SS + (size_t)(c + 1) * 4096 : F.out + O_PWKV + ((size_t)(l * NBP + b) * NH + h) * 4096);
#pragma unroll
                for (int ct = 0; ct < 4; ++ct)
#pragma unroll
                    for (int rg = 0; rg < 4; ++rg) { SL[(4 * g4 + rg) * 68 + 16 * ct + c16] = acc[ct][rg]; so[(16 * w + 4 * g4 + rg) * 64 + 16 * ct + c16] = acc[ct][rg]; }
                asm volatile("s_waitcnt lgkmcnt(0)" ::: "memory");
            }
            if (w >= 4) { if (c + 2 < NCHK) asm volatile("s_waitcnt vmcnt(8)" ::: "memory"); else asm volatile("s_waitcnt vmcnt(0)" ::: "memory"); }
            __syncthreads();
        }
#undef SCANB_DMA
    } else {
        const float* SV = WSP(float, WS_SV); float* YS = WSP(float, WS_YS);
        const int nworkers = (F.G - NCH_P) * NWAVES; const int widx = (F.bx - NCH_P) * NWAVES + F.wave;
        for (int ch = widx; ch < NCH_S; ch += nworkers) { const int b = ch >> 4, h = ch & 15;
            scan_chain(WSP(float, WS_SIS) + (size_t)l * SIS_L + (size_t)ch * TS * SIW, SV + (size_t)(MP + b * TS) * D + h * 64, YS + (size_t)(MP + b * TS) * D + h * 64, TS,
                       INF(5) + ((size_t)(l * NBS + b) * NH + h) * 4096, F.out + O_SWKV + ((size_t)(l * NBS + b) * NH + h) * 4096, F.lane); }
        __syncthreads(); { Frame F2 = F; F2.bx = F.bx - NCH_P; F2.G = F.G - NCH_P; F2.gw = F2.bx * NWAVES + F.wave; F2.NGW = F2.G * NWAVES; p0_part(F2, 1 + l); }
    }
}

__device__ __forceinline__ void r5b_phase(Frame& F, int l) {
    const float* YS = WSP(float, WS_YS); const float* SV = WSP(float, WS_SV); const float* LU = WSP(float, WS_LU); bf16_t* YG = WSP(bf16_t, WS_YG);
    const float* lw = INF(23) + (size_t)l * D; const float* lb = INF(24) + (size_t)l * D; const float* rk = INF(22) + (size_t)l * D;
    for (int m = MP + F.gw; m < MT; m += F.NGW) {
        const RowInfo ri = row_info(m); const int h = F.lane >> 2, j0 = (F.lane & 3) * 16, c0 = F.lane * 16;
        const float* si = ri.stream == 0 ? WSP(float, WS_SIP) + (size_t)l * SIP_L + ((size_t)(ri.b * NH + h) * TP + ri.t) * SIW : WSP(float, WS_SIS) + (size_t)l * SIS_L + ((size_t)(ri.b * NH + h) * TS + ri.t) * SIW;
        f32x4 y[4]; float s1 = 0.f, bon = 0.f;
#pragma unroll
        for (int q = 0; q < 4; ++q) { y[q] = *(const f32x4*)(YS + (size_t)m * D + c0 + q * 4); s1 += (y[q].x + y[q].y) + (y[q].z + y[q].w);
            const f32x4 k = *(const f32x4*)(si + 64 + j0 + q * 4), r = *(const f32x4*)(si + 256 + j0 + q * 4), rkv = *(const f32x4*)(rk + c0 + q * 4);
            bon += (r.x * k.x * rkv.x + r.y * k.y * rkv.y) + (r.z * k.z * rkv.z + r.w * k.w * rkv.w); }
        s1 += shflx(s1, 1); s1 += shflx(s1, 2); bon += shflx(bon, 1); bon += shflx(bon, 2);
        const float mean = s1 * (1.0f / 64.0f); float s2 = 0.f;
#pragma unroll
        for (int q = 0; q < 4; ++q) { const f32x4 d = y[q] - mean; s2 += (d.x * d.x + d.y * d.y) + (d.z * d.z + d.w * d.w); }
        s2 += shflx(s2, 1); s2 += shflx(s2, 2);
        const float rstd = 1.0f / sqrtf(s2 * (1.0f / 64.0f) + GN_EPS);
#pragma unroll
        for (int q = 0; q < 4; ++q) { const int c = c0 + q * 4; const f32x4 w = *(const f32x4*)(lw + c), b = *(const f32x4*)(lb + c), v = *(const f32x4*)(SV + (size_t)m * D + c), g = *(const f32x4*)(LU + (size_t)m * NR3 + 2048 + c);
            const f32x4 o = ((y[q] - mean) * rstd * w + b + v * bon) * g;
            u32x2 ww; ww.x = pk2(o.x, o.y); ww.y = pk2(o.z, o.w); *(u32x2*)(YG + (size_t)m * D + c) = ww; }
    }
}

__device__ __forceinline__ const float* cst_src(Frame& F, int it, int p, int d0) {
    const float* cache = INF(2); const int* pt = (const int*)F.in[6]; const int which = it / CROWS, row = it % CROWS;
    if (row < CROWS_S) { const int bk = row >> 7, n = row & 127, b = bk >> 2, kvh = bk & 3, pos = 16 * n + p; const int page = pt[b * NPG + (pos >> 7)];
        return cache + (((size_t)page * PAGE + (pos & 127)) * 4 + which) * 256 + kvh * 64 + d0; }
    const int r2 = row - CROWS_S, bk = r2 >> 8, n = r2 & 255, b = bk >> 2, kvh = bk & 3, pos = 16 * n + p;
    return F.out + O_PCS + (((size_t)b * TP + pos) * 4 + which) * 256 + kvh * 64 + d0; }
__device__ __forceinline__ void cst_phase(Frame& F) {
    bf16_t* CST = WSP(bf16_t, WS_CST);
    const int p = F.lane >> 2, d0 = (F.lane & 3) * 16;
    for (int it0 = F.gw; it0 < 2 * CROWS; it0 += 4 * F.NGW) { const float* src[4]; f32x4 v[4][4];
#pragma unroll
        for (int q = 0; q < 4; ++q) { const int it = it0 + q * F.NGW; src[q] = cst_src(F, it < 2 * CROWS ? it : it0, p, d0); }
#pragma unroll
        for (int q = 0; q < 4; ++q)
#pragma unroll
            for (int e = 0; e < 4; ++e) v[q][e] = *(const f32x4*)(src[q] + 4 * e);
#pragma unroll
        for (int q = 0; q < 4; ++q) { const int it = it0 + q * F.NGW; if (it < 2 * CROWS) { u32x4 w0, w1;
            w0.x = pk2(v[q][0].x, v[q][0].y); w0.y = pk2(v[q][0].z, v[q][0].w); w0.z = pk2(v[q][1].x, v[q][1].y); w0.w = pk2(v[q][1].z, v[q][1].w);
            w1.x = pk2(v[q][2].x, v[q][2].y); w1.y = pk2(v[q][2].z, v[q][2].w); w1.z = pk2(v[q][3].x, v[q][3].y); w1.w = pk2(v[q][3].z, v[q][3].w);
            bf16_t* dst = CST + (size_t)it * 1024 + p * 64 + d0; *(u32x4*)dst = w0; *(u32x4*)(dst + 8) = w1; } }
    }
}
__device__ __forceinline__ float gelu_tanh(float x) { const float u = 0.7978845608028654f * (x + 0.044715f * x * x * x); return 0.5f * x * (1.0f + tanh_fast(u)); }
__device__ __forceinline__ void c2_phase(Frame& F) {
    const float* CH = WSP(float, WS_CH); float* KC = WSP(float, WS_KCMP); const float* posb = WSP(float, WS_POSB); LAS float* hv = (LAS float*)(F.lds + F.wave * 2048);
    for (int it0 = F.gw * 4; it0 < 2 * CROWS; it0 += 4 * F.NGW) { const int which = it0 / CROWS, row0 = it0 % CROWS;
        const float* w2 = INF(33) + (size_t)which * 128 * 64;
        float xl[4][2], xh[4][2], pb[2];
#pragma unroll
        for (int e = 0; e < 2; ++e) pb[e] = posb[which * 128 + F.lane + 64 * e];
#pragma unroll
        for (int q = 0; q < 4; ++q) { const int row = row0 + q; bool has_hi; if (row < CROWS_S) has_hi = (row & 127) != 127; else has_hi = ((row - CROWS_S) & 255) != 255;
            const float* lo = CH + ((size_t)which * CROWS + row) * 256; const float* hi = has_hi ? lo + 256 + 128 : lo;
#pragma unroll
            for (int e = 0; e < 2; ++e) { const int c = F.lane + 64 * e; xl[q][e] = lo[c]; const float hval = hi[c]; xh[q][e] = has_hi ? hval : 0.f; } }
        __builtin_amdgcn_sched_barrier(0);
#pragma unroll
        for (int q = 0; q < 4; ++q)
#pragma unroll
            for (int e = 0; e < 2; ++e) { const int c = F.lane + 64 * e; const float x = xl[q][e] + xh[q][e] + pb[e]; hv[c * 4 + q] = gelu_tanh(x); }
        LDS_WAIT(); asm volatile("" ::: "memory");
        float o0 = 0.f, o1 = 0.f, o2 = 0.f, o3 = 0.f;
        const GAS float* w2g = (const GAS float*)w2 + F.lane;
#pragma unroll 32
        for (int c = 0; c < 128; ++c) { const float w = w2g[c * 64]; const f32x4 h4 = *(const LAS f32x4*)(hv + c * 4); o0 += h4.x * w; o1 += h4.y * w; o2 += h4.z * w; o3 += h4.w * w; }
#pragma unroll
        for (int q = 0; q < 4; ++q) { const int row = row0 + q; const float o = q == 0 ? o0 : (q == 1 ? o1 : (q == 2 ? o2 : o3));
            KC[((size_t)which * CROWS + row) * 64 + F.lane] = o;
            if (row >= CROWS_S) { const int r2 = row - CROWS_S, bkc = r2 >> 8, n = r2 & 255; bf16_t* KCB = WSP(bf16_t, WS_KCB);
                if (which == 0) KCB[(size_t)r2 * 64 + F.lane] = (bf16_t)f2bf(o);
                else KCB[(size_t)16 * 256 * 64 + ((size_t)(bkc * 4 + (n >> 6)) * 64 + F.lane) * 64 + vt_slot(n & 63)] = (bf16_t)f2bf(o); } }
        LDS_WAIT(); asm volatile("" ::: "memory"); }
}


constexpr size_t KVB = (size_t)16 * TP * 64;
__device__ __forceinline__ void kvstage_phase(Frame& F) {
    bf16_t* KS = WSP(bf16_t, WS_KVS); const float* winp = WSP(float, WS_WINP);
    for (int it = F.gw; it < 16 * 64 * 4; it += F.NGW) { const int which = it & 3, blk = (it >> 2) & 63, bk = it >> 8, b = bk >> 2, kvh = bk & 3;
        const float* src; size_t pitch;
        if (which < 2) { src = F.out + O_PCS + ((size_t)(b * TP + blk * 64) * 4 + 2 + which) * 256 + kvh * 64; pitch = 1024; }
        else { src = winp + (size_t)(b * TP + blk * 64) * 512 + (which - 2) * 256 + kvh * 64; pitch = 512; }
        bf16_t* dst = KS + (size_t)which * KVB + ((size_t)bk * TP + blk * 64) * 64;
        if ((which & 1) == 0) { const float* rp = src + (size_t)F.lane * pitch; u32x4 w[8];
#pragma unroll
            for (int c = 0; c < 8; ++c) { const f32x4 a = *(const f32x4*)(rp + c * 8), bq = *(const f32x4*)(rp + c * 8 + 4); w[c].x = pk2(a.x, a.y); w[c].y = pk2(a.z, a.w); w[c].z = pk2(bq.x, bq.y); w[c].w = pk2(bq.z, bq.w); }
#pragma unroll
            for (int c = 0; c < 8; ++c) *(u32x4*)(dst + (size_t)F.lane * 64 + c * 8) = w[c];
        } else { float v[64];
#pragma unroll
            for (int k = 0; k < 64; ++k) v[k] = src[(size_t)k * pitch + F.lane];
#pragma unroll
            for (int c = 0; c < 8; ++c) { u32x4 w;
                const int kb = 16 * (c >> 1) + 4 * (c & 1);
                w.x = pk2(v[kb + 0], v[kb + 1]); w.y = pk2(v[kb + 2], v[kb + 3]); w.z = pk2(v[kb + 8], v[kb + 9]); w.w = pk2(v[kb + 10], v[kb + 11]);
                *(u32x4*)(dst + (size_t)F.lane * 64 + c * 8) = w; } }
    }
}

typedef __bf16 bf16x2v __attribute__((ext_vector_type(2)));
typedef float f32x16 __attribute__((ext_vector_type(16)));
#define MFMA32(a, b, c) __builtin_amdgcn_mfma_f32_32x32x16_bf16((a), (b), (c), 0, 0, 0)
__device__ __forceinline__ unsigned cvtpk(float a, float b) { f32x2 v; v.x = a; v.y = b; return __builtin_bit_cast(unsigned, __builtin_convertvector(v, bf16x2v)); }
template <int S> __device__ __forceinline__ bf16x8 pack8(const f32x16& x) { u32x4 p; p.x = cvtpk(x[8 * S], x[8 * S + 1]); p.y = cvtpk(x[8 * S + 2], x[8 * S + 3]); p.z = cvtpk(x[8 * S + 4], x[8 * S + 5]); p.w = cvtpk(x[8 * S + 6], x[8 * S + 7]); return __builtin_bit_cast(bf16x8, p); }
__device__ __forceinline__ void xchg32(float v, float& lo, float& hi) { const auto r = __builtin_amdgcn_permlane32_swap(__builtin_bit_cast(unsigned, v), __builtin_bit_cast(unsigned, v), false, false); lo = __builtin_bit_cast(float, r[0]); hi = __builtin_bit_cast(float, r[1]); }
constexpr int AP_KB = 64 * 128, AP_BUF = 2 * AP_KB, AP_IMPG = 2 * AP_BUF, AP_SELM = AP_IMPG + 4 * 64 * 65 * 4, AP_UNI = AP_SELM + 512, AP_PARK = AP_IMPG, AP_QF = AP_UNI + 64, AP_GATE = 133120;
constexpr float LOG2E = 1.4426950408889634f;
__device__ __forceinline__ void tile_dma(const bf16_t* kg, const bf16_t* vg, LAS unsigned char* buf, int wave, int lane) {
    const int row = wave * 8 + (lane >> 3), cs = (lane & 7) ^ ((row >> 1) & 7), off = row * 128 + cs * 16;
    __builtin_amdgcn_global_load_lds((const unsigned*)((const char*)kg + off), (LAS unsigned*)(buf + wave * 1024), 16, 0, 0);
    __builtin_amdgcn_global_load_lds((const unsigned*)((const char*)vg + off), (LAS unsigned*)(buf + AP_KB + wave * 1024), 16, 0, 0);
}
#define TILE_SYNC() do { asm volatile("s_waitcnt vmcnt(0)" ::: "memory"); __syncthreads(); } while (0)
__device__ __forceinline__ void ap_scores(f32x16 (&sc)[2], const LAS unsigned char* kb, const LAS unsigned char* qf, const int ka0) {
    bf16x8 qv[4];
#pragma unroll
    for (int ds = 0; ds < 4; ++ds) qv[ds] = *(const LAS bf16x8*)(qf + ds * 1024);
#pragma unroll
    for (int kt = 0; kt < 2; ++kt) {
#pragma unroll
        for (int i = 0; i < 16; ++i) sc[kt][i] = 0.f;
#pragma unroll
        for (int ds = 0; ds < 4; ++ds) { const bf16x8 a = *(const LAS bf16x8*)(kb + kt * 4096 + (ka0 ^ (ds * 32))); sc[kt] = MFMA32(a, qv[ds], sc[kt]); }
        if (kt == 0) __builtin_amdgcn_sched_barrier(0); }
}
template <bool EDGE> __device__ __forceinline__ void ap_bias(f32x16 (&sc)[2], float bs, float b0, int lo, int hi, int h) {
    const float bh = bs * (float)(4 * h) + b0; const int lo2 = lo - 4 * h, hi2 = hi - 4 * h;
#pragma unroll
    for (int kt = 0; kt < 2; ++kt)
#pragma unroll
        for (int i = 0; i < 16; ++i) { const int c = 32 * kt + (i & 3) + 8 * (i >> 2); float x = sc[kt][i] + (bs * (float)c + bh);
            if (EDGE) x = (c >= lo2 && c <= hi2) ? x : -1e30f; sc[kt][i] = x; }
}
struct ApSt { f32x16 o0, o1; float m, l; };
__device__ __forceinline__ void ap_pv(f32x16& o0, f32x16& o1, const f32x16 (&p)[2], const LAS unsigned char* vb, const int ka0) {
    asm volatile("" ::: "memory");
    bf16x8 pf[4]; pf[0] = pack8<0>(p[0]); pf[1] = pack8<1>(p[0]); pf[2] = pack8<0>(p[1]); pf[3] = pack8<1>(p[1]);
#pragma unroll
    for (int ks = 0; ks < 4; ++ks) { const bf16x8 v0 = *(const LAS bf16x8*)(vb + (ka0 ^ (ks * 32))), v1 = *(const LAS bf16x8*)(vb + 4096 + (ka0 ^ (ks * 32)));
        o0 = MFMA32(v0, pf[ks], o0); o1 = MFMA32(v1, pf[ks], o1); }
}
template <bool EDGE> __device__ __forceinline__ void ap_online(ApSt& st, const LAS unsigned char* buf, const LAS unsigned char* qf, float bs, float b0, int lo, int hi, const int ka0, int h) {
    f32x16 sc[2]; ap_scores(sc, buf, qf, ka0); ap_bias<EDGE>(sc, bs, b0, lo, hi, h);
    float tm = -1e30f;
#pragma unroll
    for (int kt = 0; kt < 2; ++kt)
#pragma unroll
        for (int i = 0; i < 16; ++i) tm = fmaxf(tm, sc[kt][i]);
    tm = fmaxf(tm, shflx(tm, 32));
    const float mn = fmaxf(st.m, tm), mu = fmaxf(mn, -1e29f), corr = __builtin_amdgcn_exp2f(st.m - mn); float rs = 0.f;
#pragma unroll
    for (int kt = 0; kt < 2; ++kt)
#pragma unroll
        for (int i = 0; i < 16; ++i) { const float p = __builtin_amdgcn_exp2f(sc[kt][i] - mu); sc[kt][i] = p; rs += p; }
    rs += shflx(rs, 32);
    st.l = st.l * corr + rs; st.m = mn; st.o0 = st.o0 * corr; st.o1 = st.o1 * corr;
    ap_pv(st.o0, st.o1, sc, buf + AP_KB, ka0);
}
__device__ __forceinline__ void attp_phase(Frame& F, int l) {
    const bf16_t* QB = WSP(bf16_t, WS_QB); const float* QG = WSP(float, WS_QG); bf16_t* AO = WSP(bf16_t, WS_AO);
    const bf16_t* KS = WSP(bf16_t, WS_KVS); const bf16_t* VST = KS + KVB; const bf16_t* KW = KS + 2 * KVB; const bf16_t* VWT = KS + 3 * KVB;
    const bf16_t* KCB = WSP(bf16_t, WS_KCB); const bf16_t* VCT = KCB + (size_t)16 * 256 * 64;
    LAS unsigned char* lds = F.lds; LAS float* IMPG = (LAS float*)(lds + AP_IMPG); LAS unsigned long long* SELM = (LAS unsigned long long*)(lds + AP_SELM); LAS unsigned long long* UNI = (LAS unsigned long long*)(lds + AP_UNI);
    const int nun_ = F.G == 256 ? 2 : (512 + F.G - 1) / F.G;
    for (int r_ = 0; r_ < nun_; ++r_) { const int u = F.G == 256 ? (2 * (F.bx & 7) + r_) * 32 + (F.bx >> 3) : F.bx + r_ * F.G; if (u >= 512) break;
#pragma unroll 1
        for (int mem = 0; mem < 2; ++mem) {
            int wv_ = F.wave; asm volatile("" : "+v"(wv_)); const int w = __builtin_amdgcn_readfirstlane(wv_), g = w >> 1, qh = w & 1;
            int lane_; asm volatile("v_mbcnt_lo_u32_b32 %0, -1, 0\n\tv_mbcnt_hi_u32_b32 %0, -1, %0" : "=v"(lane_));
            const int lane = lane_, tid = w * 64 + lane, r = lane & 31, h = lane >> 5, q = qh * 32 + r;
            const int bk = u >> 5, ii = u & 31, i = mem ? 63 - ii : ii, b = bk >> 2, kvh = bk & 3, t0 = 64 * i, tpos = t0 + q, head = kvh * 4 + g; const size_t m = (size_t)b * TP + tpos;
            LAS unsigned char* qf = lds + AP_QF + w * 4096 + lane * 16;
#pragma unroll
            for (int ds = 0; ds < 4; ++ds) *(LAS bf16x8*)(qf + ds * 1024) = *(const bf16x8*)(QB + m * D + head * 64 + ds * 16 + h * 8);
            const float slope2 = exp2f(-0.5f * (float)(head + 1)) * LOG2E;
            const float gq0 = QG[m * NQI + 1024 + head * 3], gq1 = QG[m * NQI + 1024 + head * 3 + 1], gq2 = QG[m * NQI + 1024 + head * 3 + 2]; LAS float* gsl = (LAS float*)(lds + AP_GATE) + tid;
            LAS float* park = (LAS float*)(lds + AP_PARK) + tid;
            const int ka0 = r * 128 + ((h ^ ((r >> 1) & 7)) << 4);
            const int nct = (4 * i + 3 + 63) >> 6; const int hic = (tpos - 31) >> 4;
            const bf16_t* kc = KCB + (size_t)bk * 256 * 64; const bf16_t* vc = VCT + (size_t)bk * 256 * 64;
            float cm = -1e30f, cl = 0.f;
            tile_dma(kc, vc, lds, w, lane); TILE_SYNC();
            gsl[0] = gq0; gsl[512] = gq1; gsl[1024] = gq2;
            for (int T = 0; T < nct; ++T) { LAS unsigned char* buf = lds + (T & 1) * AP_BUF;
                if (T + 1 < nct) tile_dma(kc + (size_t)(T + 1) * 4096, vc + (size_t)(T + 1) * 4096, lds + ((T + 1) & 1) * AP_BUF, w, lane);
                f32x16 sc[2]; ap_scores(sc, buf, qf, ka0); ap_bias<true>(sc, slope2 * 16.f, slope2 * (float)(1024 * T + 31 - t0), 0, hic - 64 * T, h);
                float tm = -1e30f;
#pragma unroll
                for (int kt = 0; kt < 2; ++kt)
#pragma unroll
                    for (int e = 0; e < 16; ++e) tm = fmaxf(tm, sc[kt][e]);
                tm = fmaxf(tm, shflx(tm, 32));
                const float mn = fmaxf(cm, tm), mu = fmaxf(mn, -1e29f); float rs = 0.f;
#pragma unroll
                for (int kt = 0; kt < 2; ++kt)
#pragma unroll
                    for (int e = 0; e < 16; ++e) rs += __builtin_amdgcn_exp2f(sc[kt][e] - mu);
                rs += shflx(rs, 32);
                cl = cl * __builtin_amdgcn_exp2f(cm - mn) + rs; cm = mn;
                TILE_SYNC(); }
            f32x16 o0, o1;
            { const float cmu = fmaxf(cm, -1e29f), cinv = cl > 0.f ? 1.0f / cl : 0.f;
#pragma unroll
              for (int e = 0; e < 16; ++e) { o0[e] = 0.f; o1[e] = 0.f; }
              float carry = 0.f;
              tile_dma(kc, vc, lds, w, lane); TILE_SYNC();
              for (int T = 0; T < nct; ++T) { LAS unsigned char* buf = lds + (T & 1) * AP_BUF;
                  if (T + 1 < nct) tile_dma(kc + (size_t)(T + 1) * 4096, vc + (size_t)(T + 1) * 4096, lds + ((T + 1) & 1) * AP_BUF, w, lane);
                  f32x16 sc[2]; ap_scores(sc, buf, qf, ka0); ap_bias<true>(sc, slope2 * 16.f, slope2 * (float)(1024 * T + 31 - t0), 0, hic - 64 * T, h);
#pragma unroll
                  for (int kt = 0; kt < 2; ++kt)
#pragma unroll
                      for (int e = 0; e < 16; ++e) sc[kt][e] = __builtin_amdgcn_exp2f(sc[kt][e] - cmu) * cinv;
#pragma unroll
                  for (int kt = 0; kt < 2; ++kt) { float gs[4], xl[4];
#pragma unroll
                      for (int a = 0; a < 4; ++a) { gs[a] = (sc[kt][4 * a] + sc[kt][4 * a + 1]) + (sc[kt][4 * a + 2] + sc[kt][4 * a + 3]); xl[a] = shflx(sc[kt][4 * a + 3], 32); }
                      float val[4];
                      if (h) {
#pragma unroll
                          for (int a = 0; a < 4; ++a) val[a] = gs[a] + xl[a];
                      } else { val[0] = gs[0] + carry; val[1] = gs[1] + xl[0]; val[2] = gs[2] + xl[1]; val[3] = gs[3] + xl[2]; carry = xl[3]; }
#pragma unroll
                      for (int a = 0; a < 4; ++a) { const int blk = 16 * T + 8 * kt + 2 * a + h; IMPG[(g * 64 + q) * 65 + blk] = val[a]; } }
                  ap_pv(o0, o1, sc, buf + AP_KB, ka0);
                  TILE_SYNC(); }
            }
            { unsigned long long uni = 0ull;
#pragma unroll 1
              for (int qq = 0; qq < 8; ++qq) { const int q2 = w * 8 + qq; float val;
                  { const float imp = lane <= i ? ((IMPG[(0 * 64 + q2) * 65 + lane] + IMPG[(1 * 64 + q2) * 65 + lane]) + (IMPG[(2 * 64 + q2) * 65 + lane] + IMPG[(3 * 64 + q2) * 65 + lane])) : 0.f;
                    const bool forced = lane == 0 || lane == i || lane == i - 1; val = lane <= i ? (forced ? 1e4f : imp) : -1.f; }
                  int rank = 0;
                  for (int s2 = 0; s2 < 64; ++s2) { const float v2 = __builtin_bit_cast(float, __builtin_amdgcn_readlane(__builtin_bit_cast(int, val), s2)); rank += (v2 > val || (v2 == val && s2 < lane)) ? 1 : 0; }
                  const unsigned long long sm = __ballot(rank < 16 && lane <= i); uni |= sm; if (lane == 0) SELM[q2] = sm; }
              if (lane == 0) UNI[w] = uni; }
            __syncthreads();
            { const float g0 = gsl[0];
#pragma unroll
              for (int e = 0; e < 16; ++e) { park[e * 512] = o0[e] * g0; park[(16 + e) * 512] = o1[e] * g0; } }
            unsigned long long uni = 0ull;
#pragma unroll
            for (int ww = 0; ww < 8; ++ww) uni |= UNI[ww];
            uni = ((unsigned long long)__builtin_amdgcn_readfirstlane((unsigned)(uni >> 32)) << 32) | (unsigned)__builtin_amdgcn_readfirstlane((unsigned)uni);
            { ApSt st;
#pragma unroll
              for (int e = 0; e < 16; ++e) { st.o0[e] = 0.f; st.o1[e] = 0.f; }
              st.m = -1e30f; st.l = 0.f;
              const bf16_t* kg = KS + (size_t)bk * TP * 64; const bf16_t* vg = VST + (size_t)bk * TP * 64;
              unsigned long long rem = uni; int s = __builtin_ctzll(rem); rem &= rem - 1; int par = 0;
              tile_dma(kg + (size_t)s * 4096, vg + (size_t)s * 4096, lds, w, lane); TILE_SYNC();
              for (;;) { const int sn = rem ? __builtin_ctzll(rem) : -1; LAS unsigned char* buf = lds + par * AP_BUF;
                  if (sn >= 0) tile_dma(kg + (size_t)sn * 4096, vg + (size_t)sn * 4096, lds + (par ^ 1) * AP_BUF, w, lane);
                  const float b0 = ((SELM[q] >> s) & 1ull) ? slope2 * (float)(64 * s - t0) : -1e30f;
                  if (s == i) ap_online<true>(st, buf, qf, slope2, b0, 0, tpos - 64 * s, ka0, h); else ap_online<false>(st, buf, qf, slope2, b0, 0, 63, ka0, h);
                  if (sn < 0) break;
                  TILE_SYNC(); par ^= 1; s = sn; rem &= rem - 1; }
              __syncthreads();
              const float sc1 = gsl[512] / st.l;
#pragma unroll
              for (int e = 0; e < 16; ++e) { park[e * 512] += st.o0[e] * sc1; park[(16 + e) * 512] += st.o1[e] * sc1; } }
            { ApSt st;
#pragma unroll
              for (int e = 0; e < 16; ++e) { st.o0[e] = 0.f; st.o1[e] = 0.f; }
              st.m = -1e30f; st.l = 0.f;
              const bf16_t* kg = KW + (size_t)bk * TP * 64; const bf16_t* vg = VWT + (size_t)bk * TP * 64;
              const int wb0 = i >= 8 ? i - 8 : 0;
              tile_dma(kg + (size_t)wb0 * 4096, vg + (size_t)wb0 * 4096, lds, w, lane); TILE_SYNC();
              for (int wb = wb0; wb <= i; ++wb) { LAS unsigned char* buf = lds + ((wb - wb0) & 1) * AP_BUF;
                  if (wb < i) tile_dma(kg + (size_t)(wb + 1) * 4096, vg + (size_t)(wb + 1) * 4096, lds + ((wb + 1 - wb0) & 1) * AP_BUF, w, lane);
                  const float b0 = slope2 * (float)(64 * wb - t0);
                  if (wb == i || wb == i - 8) ap_online<true>(st, buf, qf, slope2, b0, tpos - 512 - 64 * wb, tpos - 64 * wb, ka0, h); else ap_online<false>(st, buf, qf, slope2, b0, 0, 63, ka0, h);
                  TILE_SYNC(); }
              const float sc2 = gsl[1024] / st.l;
#pragma unroll
              for (int e = 0; e < 16; ++e) { st.o0[e] = park[e * 512] + st.o0[e] * sc2; st.o1[e] = park[(16 + e) * 512] + st.o1[e] * sc2; }
              int lane2; asm volatile("v_mbcnt_lo_u32_b32 %0, -1, 0\n\tv_mbcnt_hi_u32_b32 %0, -1, %0" : "=v"(lane2));
              const int h2 = lane2 >> 5; const size_t m2 = (size_t)b * TP + t0 + qh * 32 + (lane2 & 31);
              bf16_t* orow = AO + m2 * D + head * 64 + 4 * h2;
#pragma unroll
              for (int a = 0; a < 4; ++a) { u32x2 w0, w1; w0.x = cvtpk(st.o0[4 * a], st.o0[4 * a + 1]); w0.y = cvtpk(st.o0[4 * a + 2], st.o0[4 * a + 3]); w1.x = cvtpk(st.o1[4 * a], st.o1[4 * a + 1]); w1.y = cvtpk(st.o1[4 * a + 2], st.o1[4 * a + 3]);
                  *(u32x2*)(orow + 8 * a) = w0; *(u32x2*)(orow + 32 + 8 * a) = w1; } }
        }
    }
}

#define MFMA16(a, b, c) __builtin_amdgcn_mfma_f32_16x16x32_bf16((a), (b), (c), 0, 0, 0)
__device__ __forceinline__ bf16x8 cvt8(const f32x4 a, const f32x4 b) { u32x4 p; p.x = cvtpk(a.x, a.y); p.y = cvtpk(a.z, a.w); p.z = cvtpk(b.x, b.y); p.w = cvtpk(b.z, b.w); return __builtin_bit_cast(bf16x8, p); }
struct S2K { f32x4 a[4][2], b[4][2]; };
struct S2V { float v[2][4][8]; };
__device__ __forceinline__ void s2_ldk(S2K& K, const float* kb, int kp, int kmax, int r16, int g4) {
#pragma unroll
    for (int kt = 0; kt < 4; ++kt) { const int key = min(16 * kt + r16, kmax); const float* row = kb + (size_t)key * kp + 8 * g4;
#pragma unroll
        for (int ds = 0; ds < 2; ++ds) { K.a[kt][ds] = *(const f32x4*)(row + 32 * ds); K.b[kt][ds] = *(const f32x4*)(row + 32 * ds + 4); } }
}
__device__ __forceinline__ void s2_ldv(S2V& V, const float* vb, int kp, int kmax, int r16, int g4) {
#pragma unroll
    for (int pr = 0; pr < 2; ++pr)
#pragma unroll
        for (int j = 0; j < 8; ++j) { const int key = min(16 * (2 * pr + (j >> 2)) + 4 * g4 + (j & 3), kmax); const float* row = vb + (size_t)key * kp + r16;
#pragma unroll
            for (int dt = 0; dt < 4; ++dt) V.v[pr][dt][j] = row[16 * dt]; }
}
__device__ __forceinline__ void s2_scores_r(f32x4 (&sc)[4], const S2K& K, const bf16x8 (&qf)[2]) {
#pragma unroll
    for (int kt = 0; kt < 4; ++kt) { sc[kt] = (f32x4){0.f, 0.f, 0.f, 0.f};
#pragma unroll
        for (int ds = 0; ds < 2; ++ds) sc[kt] = MFMA16(cvt8(K.a[kt][ds], K.b[kt][ds]), qf[ds], sc[kt]); }
}
__device__ __forceinline__ void s2_pv_r(f32x4 (&o)[4], const f32x4 (&p)[4], const S2V& V) {
#pragma unroll
    for (int pr = 0; pr < 2; ++pr) { u32x4 pw; pw.x = cvtpk(p[2 * pr][0], p[2 * pr][1]); pw.y = cvtpk(p[2 * pr][2], p[2 * pr][3]); pw.z = cvtpk(p[2 * pr + 1][0], p[2 * pr + 1][1]); pw.w = cvtpk(p[2 * pr + 1][2], p[2 * pr + 1][3]);
        const bf16x8 pf = __builtin_bit_cast(bf16x8, pw);
#pragma unroll
        for (int dt = 0; dt < 4; ++dt) { const float (&v)[8] = V.v[pr][dt];
            u32x4 vw; vw.x = cvtpk(v[0], v[1]); vw.y = cvtpk(v[2], v[3]); vw.z = cvtpk(v[4], v[5]); vw.w = cvtpk(v[6], v[7]);
            o[dt] = MFMA16(__builtin_bit_cast(bf16x8, vw), pf, o[dt]); } }
}
struct S2St { f32x4 o[4]; float m, l; };
__device__ __forceinline__ void s2_online(S2St& st, const float* kb, const float* vb, int kp, int kmax, const bf16x8 (&qf)[2], float slope2, int pos0, bool rowok, int lo, int hi, int r16, int g4) {
    S2K K; S2V V; s2_ldk(K, kb, kp, kmax, r16, g4); s2_ldv(V, vb, kp, kmax, r16, g4); __builtin_amdgcn_sched_barrier(0);
    f32x4 sc[4]; s2_scores_r(sc, K, qf);
    float tm = -1e30f;
#pragma unroll
    for (int kt = 0; kt < 4; ++kt)
#pragma unroll
        for (int i = 0; i < 4; ++i) { const int pos = pos0 + 16 * kt + 4 * g4 + i; const bool ok = rowok && pos >= lo && pos <= hi; const float x = ok ? sc[kt][i] + slope2 * (float)(pos - PAST) : -1e30f; sc[kt][i] = x; tm = fmaxf(tm, x); }
    tm = fmaxf(tm, shflx(tm, 16)); tm = fmaxf(tm, shflx(tm, 32));
    const float mn = fmaxf(st.m, tm), mu = fmaxf(mn, -1e29f), corr = __builtin_amdgcn_exp2f(st.m - mn); float rs = 0.f;
#pragma unroll
    for (int kt = 0; kt < 4; ++kt)
#pragma unroll
        for (int i = 0; i < 4; ++i) { const float p = __builtin_amdgcn_exp2f(sc[kt][i] - mu); sc[kt][i] = p; rs += p; }
    rs += shflx(rs, 16); rs += shflx(rs, 32);
    st.l = st.l * corr + rs; st.m = mn;
#pragma unroll
    for (int dt = 0; dt < 4; ++dt) st.o[dt] = st.o[dt] * corr;
    s2_pv_r(st.o, sc, V);
}
__device__ __forceinline__ void atts2_phase(Frame& F, int l) {
    const float* QG = WSP(float, WS_QG); bf16_t* AO = WSP(bf16_t, WS_AO); const float* KC = WSP(float, WS_KCMP); const float* VC = KC + (size_t)CROWS * 64;
    const float* cache = INF(2); const float* cwin = INF(3); const int* pt = (const int*)F.in[6];
    const int team = F.wave >> 2, mem = F.wave & 3;
    LAS unsigned char* tl = F.lds + team * 49152;
    LAS float* GS = (LAS float*)tl; LAS float* LS = GS + 16 * 33; LAS unsigned long long* MS = (LAS unsigned long long*)(tl + 6144);
    LAS float* WINP = (LAS float*)(tl + 30720);
    LAS float* SLCP = (LAS float*)(tl + 12288);
    for (int item = F.bx * 2 + team; item < NBS * NKV; item += F.G * 2) { const int b = item >> 2, kvh = item & 3;
        int lane_; asm volatile("v_mbcnt_lo_u32_b32 %0, -1, 0\n\tv_mbcnt_hi_u32_b32 %0, -1, %0" : "=v"(lane_)); const int lane = lane_, r16 = lane & 15, g4 = lane >> 4, g = r16 >> 2, t = r16 & 3, head = kvh * 4 + g, tpos = PAST + t;
        const size_t mrow = (size_t)MP + b * TS + t; const float slope2 = exp2f(-0.5f * (float)(head + 1)) * LOG2E;
        bf16x8 qf[2];
#pragma unroll
        for (int ds = 0; ds < 2; ++ds) { const float* qp = QG + mrow * NQI + head * 64 + 32 * ds + 8 * g4; const f32x4 a = *(const f32x4*)qp * LOG2E, bq = *(const f32x4*)(qp + 4) * LOG2E; qf[ds] = cvt8(a, bq); }
        f32x4 oacc[4];
#pragma unroll
        for (int dt = 0; dt < 4; ++dt) oacc[dt] = (f32x4){0.f, 0.f, 0.f, 0.f};
        if (mem == 0) {
            const float* kc = KC + (size_t)(b * 4 + kvh) * 128 * 64; const float* vc = VC + (size_t)(b * 4 + kvh) * 128 * 64;
            float cm = -1e30f, cl = 0.f;
#pragma unroll 1
            for (int T = 0; T < 2; ++T) { f32x4 sc[4]; { S2K K; s2_ldk(K, kc + (size_t)T * 64 * 64, 64, 63, r16, g4); __builtin_amdgcn_sched_barrier(0); s2_scores_r(sc, K, qf); } float tm = -1e30f;
#pragma unroll
                for (int kt = 0; kt < 4; ++kt)
#pragma unroll
                    for (int i = 0; i < 4; ++i) { const int n = 64 * T + 16 * kt + 4 * g4 + i; const float x = n <= 126 ? sc[kt][i] + slope2 * (float)(16 * n + 31 - PAST) : -1e30f; sc[kt][i] = x; tm = fmaxf(tm, x); }
                tm = fmaxf(tm, shflx(tm, 16)); tm = fmaxf(tm, shflx(tm, 32)); const float mn = fmaxf(cm, tm); float rs = 0.f;
#pragma unroll
                for (int kt = 0; kt < 4; ++kt)
#pragma unroll
                    for (int i = 0; i < 4; ++i) rs += __builtin_amdgcn_exp2f(sc[kt][i] - mn);
                rs += shflx(rs, 16); rs += shflx(rs, 32); cl = cl * __builtin_amdgcn_exp2f(cm - mn) + rs; cm = mn; }
            const float cinv = 1.0f / cl;
#pragma unroll 1
            for (int T = 0; T < 2; ++T) { f32x4 sc[4]; S2V V; { S2K K; s2_ldk(K, kc + (size_t)T * 64 * 64, 64, 63, r16, g4); s2_ldv(V, vc + (size_t)T * 64 * 64, 64, 63, r16, g4); __builtin_amdgcn_sched_barrier(0); s2_scores_r(sc, K, qf); }
#pragma unroll
                for (int kt = 0; kt < 4; ++kt) { float gs = 0.f;
#pragma unroll
                    for (int i = 0; i < 4; ++i) { const int n = 64 * T + 16 * kt + 4 * g4 + i; const float p = n <= 126 ? __builtin_amdgcn_exp2f(sc[kt][i] + slope2 * (float)(16 * n + 31 - PAST) - cm) * cinv : 0.f; sc[kt][i] = p; gs += p; }
                    const int blk = 16 * T + 4 * kt + g4; GS[r16 * 33 + blk] = gs; LS[r16 * 33 + blk] = sc[kt][3]; }
                s2_pv_r(oacc, sc, V); }
            const float g0 = QG[mrow * NQI + 1024 + head * 3];
#pragma unroll
            for (int dt = 0; dt < 4; ++dt) oacc[dt] = oacc[dt] * g0;
            asm volatile("s_waitcnt lgkmcnt(0)" ::: "memory");
            unsigned long long uni = 0ull;
#pragma unroll 1
            for (int tq = 0; tq < 4; ++tq) { float imp = 0.f;
                if (lane < 33) {
#pragma unroll
                    for (int gg = 0; gg < 4; ++gg) { const int row = gg * 4 + tq; imp += (lane < 32 ? GS[row * 33 + lane] : 0.f) + (lane > 0 ? LS[row * 33 + lane - 1] : 0.f); } }
                const bool forced = lane == 0 || lane == 32 || lane == 31; const float val = lane >= 33 ? -2.f : (forced ? 1e4f : imp);
                int rank = 0;
                for (int s2 = 0; s2 < 64; ++s2) { const float v2 = __builtin_bit_cast(float, __builtin_amdgcn_readlane(__builtin_bit_cast(int, val), s2)); rank += (v2 > val || (v2 == val && s2 < lane)) ? 1 : 0; }
                const unsigned long long sm = __ballot(rank < 16 && lane < 33); uni |= sm; if (lane == 0) MS[tq] = sm; }
            if (lane == 0) MS[4] = uni;
        } else {
            S2St st; st.m = -1e30f; st.l = 0.f;
#pragma unroll
            for (int dt = 0; dt < 4; ++dt) st.o[dt] = (f32x4){0.f, 0.f, 0.f, 0.f};
#pragma unroll 1
            for (int wt = 3 * (mem - 1); wt < 3 * mem; ++wt) { const float* kb; int kmax;
                if (wt < 8) { kb = cwin + ((size_t)b * 512 + 64 * wt) * 512 + kvh * 64; kmax = 63; } else { kb = F.out + O_SWIN + ((size_t)b * 512 + 508) * 512 + kvh * 64; kmax = TS - 1; }
                s2_online(st, kb, kb + 256, 512, kmax, qf, slope2, PAST - 512 + 64 * wt, true, tpos - 512, tpos, r16, g4); }
            LAS float* wp = WINP + ((mem - 1) * 64 + lane) * 18;
#pragma unroll
            for (int dt = 0; dt < 4; ++dt)
#pragma unroll
                for (int i = 0; i < 4; ++i) wp[dt * 4 + i] = st.o[dt][i];
            wp[16] = st.m; wp[17] = st.l;
        }
        asm volatile("s_waitcnt lgkmcnt(0)" ::: "memory"); __syncthreads();
        { const int my = mem; const unsigned long long selq = MS[t]; unsigned long long uni = MS[4];
            uni = ((unsigned long long)__builtin_amdgcn_readfirstlane((unsigned)(uni >> 32)) << 32) | (unsigned)__builtin_amdgcn_readfirstlane((unsigned)uni);
            S2St st; st.m = -1e30f; st.l = 0.f;
#pragma unroll
            for (int dt = 0; dt < 4; ++dt) st.o[dt] = (f32x4){0.f, 0.f, 0.f, 0.f};
            int n = 0;
#pragma unroll 1
            for (unsigned long long rem = uni; rem; rem &= rem - 1, ++n) { if ((n & 3) != my) continue; const int s = __builtin_ctzll(rem); const float* kb; int kmax;
                if (s < 32) { const int page = pt[b * NPG + (s >> 1)]; kb = cache + (((size_t)page * PAGE + (s & 1) * 64) * 4 + 2) * 256 + kvh * 64; kmax = 63; }
                else { kb = F.out + O_SCS + (((size_t)b * TS) * 4 + 2) * 256 + kvh * 64; kmax = TS - 1; }
                s2_online(st, kb, kb + 256, 1024, kmax, qf, slope2, 64 * s, ((selq >> s) & 1ull) != 0ull, 0, tpos, r16, g4); }
            LAS float* sp = SLCP + (my * 64 + lane) * 18;
#pragma unroll
            for (int dt = 0; dt < 4; ++dt)
#pragma unroll
                for (int i = 0; i < 4; ++i) sp[dt * 4 + i] = st.o[dt][i];
            sp[16] = st.m; sp[17] = st.l; }
        asm volatile("s_waitcnt lgkmcnt(0)" ::: "memory"); __syncthreads();
        if (mem == 0) {
            float mm[4], ll[4]; float M = -1e30f;
#pragma unroll
            for (int x = 0; x < 4; ++x) { mm[x] = SLCP[(x * 64 + lane) * 18 + 16]; ll[x] = SLCP[(x * 64 + lane) * 18 + 17]; M = fmaxf(M, mm[x]); }
            float L = 0.f, sc[4];
#pragma unroll
            for (int x = 0; x < 4; ++x) { sc[x] = __builtin_amdgcn_exp2f(mm[x] - M); L += ll[x] * sc[x]; }
            const float g1 = QG[mrow * NQI + 1024 + head * 3 + 1] / L;
            float wm[3], wl[3]; float MW = -1e30f;
#pragma unroll
            for (int x = 0; x < 3; ++x) { wm[x] = WINP[(x * 64 + lane) * 18 + 16]; wl[x] = WINP[(x * 64 + lane) * 18 + 17]; MW = fmaxf(MW, wm[x]); }
            float LW = 0.f, wsc[3];
#pragma unroll
            for (int x = 0; x < 3; ++x) { wsc[x] = __builtin_amdgcn_exp2f(wm[x] - MW); LW += wl[x] * wsc[x]; }
            const float g2 = QG[mrow * NQI + 1024 + head * 3 + 2] / LW;
#pragma unroll
            for (int dt = 0; dt < 4; ++dt) { f32x4 acc = oacc[dt];
#pragma unroll
                for (int x = 0; x < 3; ++x) { const LAS float* wq = WINP + (x * 64 + lane) * 18 + dt * 4; acc = acc + (f32x4){wq[0], wq[1], wq[2], wq[3]} * (wsc[x] * g2); }
#pragma unroll
                for (int x = 0; x < 4; ++x) { const LAS float* sp = SLCP + (x * 64 + lane) * 18 + dt * 4; acc = acc + (f32x4){sp[0], sp[1], sp[2], sp[3]} * (sc[x] * g1); }
                u32x2 w; w.x = cvtpk(acc[0], acc[1]); w.y = cvtpk(acc[2], acc[3]); *(u32x2*)(AO + mrow * D + head * 64 + 16 * dt + 4 * g4) = w; } }
        asm volatile("s_waitcnt lgkmcnt(0)" ::: "memory"); __syncthreads();
    }
}

struct AttSt { float m[4], l[4], o[4]; };
__device__ __forceinline__ void att_init(AttSt& st) {
#pragma unroll
    for (int g = 0; g < 4; ++g) { st.m[g] = -1e30f; st.l[g] = 0.f; st.o[g] = 0.f; } }
__device__ __forceinline__ void att_tile(AttSt& st, const float* kp, const float* vp, bool valid, float dist, const float (&slope)[4], const LAS f32x4* qs4, LAS f32x4* pb, int lane) {
    f32x4 kv[16];
#pragma unroll
    for (int c = 0; c < 16; ++c) kv[c] = ((const f32x4*)kp)[c];
    float vv[32]; const unsigned long long vpa = (unsigned long long)vp;
#pragma unroll
    for (int k = 0; k < 32; ++k) { const unsigned lo = __builtin_amdgcn_readlane((unsigned)vpa, k), hi = __builtin_amdgcn_readlane((unsigned)(vpa >> 32), k); vv[k] = ((const float*)(((unsigned long long)hi << 32) | lo))[lane]; }
    float s[4] = {0.f, 0.f, 0.f, 0.f};
#pragma unroll
    for (int c = 0; c < 16; ++c) {
#pragma unroll
        for (int g = 0; g < 4; ++g) { const f32x4 q = qs4[g * 16 + c]; s[g] += (kv[c].x * q.x + kv[c].y * q.y) + (kv[c].z * q.z + kv[c].w * q.w); }
        if ((c & 3) == 3) __builtin_amdgcn_sched_barrier(0); }
    asm volatile("" : "+v"(s[0]), "+v"(s[1]), "+v"(s[2]), "+v"(s[3]));
    f32x4 pv;
#pragma unroll
    for (int g = 0; g < 4; ++g) { const float sc = valid ? s[g] - slope[g] * dist : -1e30f; const float tm = wave_max(sc); const float mn = fmaxf(st.m[g], tm);
        const float p = valid ? __expf(sc - mn) : 0.f; const float corr = __expf(st.m[g] - mn); st.l[g] = st.l[g] * corr + wave_sum(p); st.o[g] *= corr; st.m[g] = mn; pv[g] = p; }
    pb[lane] = pv; LDS_WAIT(); asm volatile("" ::: "memory");
    float v2[32];
#pragma unroll
    for (int k = 0; k < 32; ++k) { const unsigned lo = __builtin_amdgcn_readlane((unsigned)vpa, 32 + k), hi = __builtin_amdgcn_readlane((unsigned)(vpa >> 32), 32 + k); v2[k] = ((const float*)(((unsigned long long)hi << 32) | lo))[lane]; }
#pragma unroll
    for (int k = 0; k < 32; ++k) { const f32x4 p = pb[k]; st.o[0] += p.x * vv[k]; st.o[1] += p.y * vv[k]; st.o[2] += p.z * vv[k]; st.o[3] += p.w * vv[k]; if ((k & 7) == 7) __builtin_amdgcn_sched_barrier(0); }
#pragma unroll
    for (int k = 0; k < 32; ++k) { const f32x4 p = pb[32 + k]; st.o[0] += p.x * v2[k]; st.o[1] += p.y * v2[k]; st.o[2] += p.z * v2[k]; st.o[3] += p.w * v2[k]; if ((k & 7) == 7) __builtin_amdgcn_sched_barrier(0); }
    LDS_WAIT(); asm volatile("" ::: "memory");
}
__device__ __forceinline__ void att_phase(Frame& F, int l) {
    const float* QG = WSP(float, WS_QG); bf16_t* AO = WSP(bf16_t, WS_AO); const float* KC = WSP(float, WS_KCMP); const float* VC = KC + (size_t)CROWS * 64;
    const float* cache = INF(2); const float* cwin = INF(3); const int* pt = (const int*)F.in[6]; const float* winp = WSP(float, WS_WINP);
    LAS unsigned char* wl = F.lds + F.wave * 8192;
    LAS f32x4* qs4 = (LAS f32x4*)wl;
    LAS f32x4* pb = (LAS f32x4*)(wl + 1024);
    LAS float* psum = (LAS float*)(wl + 1024 + 4096);
    const int lane = F.lane;
    const int nitems = MS * NKV;
    for (int it = F.gw; it < nitems; it += F.NGW) {
        const int m = MP + (it >> 2); const int kvh = it & 3;
        const RowInfo ri = row_info(m); const int tpos = ri.stream == 0 ? ri.t : PAST + ri.t;
        float slope[4], gate[4][3];
#pragma unroll
        for (int g = 0; g < 4; ++g) { slope[g] = exp2f(-0.5f * (float)(kvh * 4 + g + 1));
#pragma unroll
            for (int c = 0; c < 3; ++c) gate[g][c] = QG[(size_t)m * NQI + 1024 + (kvh * 4 + g) * 3 + c]; }
        { const float* qrow = QG + (size_t)m * NQI + kvh * 256; LAS float* qs = (LAS float*)qs4;
#pragma unroll
          for (int g = 0; g < 4; ++g) qs[g * 64 + lane] = qrow[g * 64 + lane]; }
        LDS_WAIT(); asm volatile("" ::: "memory");
        const float* safe = QG + (size_t)m * NQI;
        float otot[4] = {0.f, 0.f, 0.f, 0.f};
        const int ncv = tpos >= 31 ? ((tpos - 31) >> 4) + 1 : 0;
        const size_t crow0 = ri.stream == 0 ? (size_t)CROWS_S + (size_t)(ri.b * 4 + kvh) * 256 : (size_t)(ri.b * 4 + kvh) * 128;
        const int ntile_c = (ncv + 63) >> 6;
#pragma unroll
        for (int q = 0; q < 5; ++q) { const int idx = lane + 64 * q; if (idx < 264) psum[idx] = 0.f; }
        if (ncv > 0) {
            float mx[4] = {-1e30f, -1e30f, -1e30f, -1e30f};
#pragma unroll 1
            for (int tl = 0; tl < ntile_c; ++tl) { const int n = tl * 64 + lane; const bool valid = n < ncv; const float* kp = valid ? KC + (crow0 + n) * 64 : safe; float s[4] = {0.f, 0.f, 0.f, 0.f};
#pragma unroll 4
                for (int c = 0; c < 16; ++c) { const f32x4 kv = ((const f32x4*)kp)[c];
#pragma unroll
                    for (int g = 0; g < 4; ++g) { const f32x4 q = qs4[g * 16 + c]; s[g] += (kv.x * q.x + kv.y * q.y) + (kv.z * q.z + kv.w * q.w); } }
                const float dist = (float)(tpos - (16 * n + 31)); f32x4 sv;
#pragma unroll
                for (int g = 0; g < 4; ++g) { sv[g] = valid ? s[g] - slope[g] * dist : -1e30f; mx[g] = fmaxf(mx[g], sv[g]); }
                pb[n] = sv; }
            float sm[4];
#pragma unroll
            for (int g = 0; g < 4; ++g) { mx[g] = wave_max(mx[g]); sm[g] = 0.f; }
            LDS_WAIT(); asm volatile("" ::: "memory");
#pragma unroll 1
            for (int tl = 0; tl < ntile_c; ++tl) { const int n = tl * 64 + lane; const f32x4 sv = pb[n]; f32x4 p;
#pragma unroll
                for (int g = 0; g < 4; ++g) { p[g] = n < ncv ? __expf(sv[g] - mx[g]) : 0.f; sm[g] += p[g]; }
                pb[n] = p; }
#pragma unroll
            for (int g = 0; g < 4; ++g) sm[g] = 1.0f / wave_sum(sm[g]);
            LDS_WAIT(); asm volatile("" ::: "memory");
#pragma unroll 1
            for (int tl = 0; tl < ntile_c; ++tl) { const int n = tl * 64 + lane; f32x4 p = pb[n]; p.x *= sm[0]; p.y *= sm[1]; p.z *= sm[2]; p.w *= sm[3]; pb[n] = p; psum[n + 1] = (p.x + p.y) + (p.z + p.w); }
            LDS_WAIT(); asm volatile("" ::: "memory");
            float oc[4] = {0.f, 0.f, 0.f, 0.f};
#pragma unroll 4
            for (int n = 0; n < ncv; ++n) { const float vv = VC[(crow0 + n) * 64 + lane]; const f32x4 p = pb[n]; oc[0] += p.x * vv; oc[1] += p.y * vv; oc[2] += p.z * vv; oc[3] += p.w * vv; }
#pragma unroll
            for (int g = 0; g < 4; ++g) otot[g] += gate[g][0] * oc[g];
        }
        LDS_WAIT(); asm volatile("" ::: "memory");
        const int cur = tpos >> 6; const int ns = ri.stream == 0 ? 64 : 33;
        float val;
        {
          float imp = 0.f; if (lane < ns) { imp = ((psum[4 * lane] + psum[4 * lane + 1]) + (psum[4 * lane + 2] + psum[4 * lane + 3])) + psum[4 * lane + 4]; }
          const bool forced = lane == 0 || lane == cur || lane == cur - 1;
          val = lane >= ns ? -2.f : (lane <= cur ? (forced ? 1e4f : imp) : -1.f); }
        int rank = 0;
        for (int s2 = 0; s2 < 64; ++s2) { const float v2 = __builtin_bit_cast(float, __builtin_amdgcn_readlane(__builtin_bit_cast(int, val), s2)); rank += (v2 > val || (v2 == val && s2 < lane)) ? 1 : 0; }
        const unsigned long long selmask = __ballot(rank < 16 && lane <= cur && lane < ns);
        { AttSt st; att_init(st);
          for (unsigned long long mm = selmask; mm; mm &= mm - 1) { const int s = __builtin_ctzll(mm); const int pos = s * 64 + lane; const bool valid = pos <= tpos;
              const float *kp = safe, *vp = safe;
              if (valid) { if (ri.stream == 0) { kp = F.out + O_PCS + (((size_t)ri.b * TP + pos) * 4 + 2) * 256 + kvh * 64; vp = kp + 256; }
                  else if (pos < PAST) { const int page = pt[ri.b * NPG + (pos >> 7)]; kp = cache + (((size_t)page * PAGE + (pos & 127)) * 4 + 2) * 256 + kvh * 64; vp = kp + 256; }
                  else { kp = F.out + O_SCS + (((size_t)ri.b * TS + (pos - PAST)) * 4 + 2) * 256 + kvh * 64; vp = kp + 256; } }
              att_tile(st, kp, vp, valid, (float)(tpos - pos), slope, qs4, pb, lane); }
#pragma unroll
          for (int g = 0; g < 4; ++g) otot[g] += gate[g][1] * st.o[g] / st.l[g]; }
        { AttSt st; att_init(st); const int wpos0 = ri.stream == 0 ? 0 : PAST + TS - 516; const int lo = max(tpos - 512, wpos0);
          for (int p0 = lo; p0 <= tpos; p0 += 64) { const int pos = p0 + lane; const bool valid = pos <= tpos; const float *kp = safe, *vp = safe;
              if (valid) { if (ri.stream == 0) { kp = winp + (size_t)(ri.b * TP + pos) * 512 + kvh * 64; vp = kp + 256; }
                  else if (pos < PAST) { kp = cwin + ((size_t)ri.b * 512 + (pos - wpos0)) * 512 + kvh * 64; vp = kp + 256; }
                  else { kp = F.out + O_SWIN + ((size_t)ri.b * 512 + 508 + (pos - PAST)) * 512 + kvh * 64; vp = kp + 256; } }
              att_tile(st, kp, vp, valid, (float)(tpos - pos), slope, qs4, pb, lane); }
#pragma unroll
          for (int g = 0; g < 4; ++g) otot[g] += gate[g][2] * st.o[g] / st.l[g]; }
#pragma unroll
        for (int g = 0; g < 4; ++g) AO[(size_t)m * D + (kvh * 4 + g) * 64 + lane] = (bf16_t)f2bf(otot[g]);
        LDS_WAIT(); asm volatile("" ::: "memory");
    }
}

__device__ __forceinline__ void resid_reduce_phase(Frame& F, int npieces, float scale) {
    const float* part = WSP(float, WS_PART); float* H = WSP(float, WS_H); bf16_t* HB = WSP(bf16_t, WS_HB); float* RS = WSP(float, WS_RS);
    for (int it = F.gw; it < MS * 4; it += F.NGW) { const int r = it >> 2, c = (it & 3) * 256 + F.lane * 4; const size_t off = (size_t)(MP + r) * D + c;
        f32x4 pv[11];
#pragma unroll
        for (int pc = 0; pc < 11; ++pc) pv[pc] = *(const f32x4*)(part + ((size_t)pc * MS + r) * D + c);
        f32x4 acc = (f32x4){0.f, 0.f, 0.f, 0.f};
#pragma unroll
        for (int pc = 0; pc < 11; ++pc) acc = acc + pv[pc];
        f32x4 h = *(const f32x4*)(H + off); h = h + acc * scale; *(f32x4*)(H + off) = h; u32x2 w; w.x = pk2(h.x, h.y); w.y = pk2(h.z, h.w); *(u32x2*)(HB + off) = w;
        float ss = wave_sum((h.x * h.x + h.y * h.y) + (h.z * h.z + h.w * h.w));
        if (F.lane < 4) RS[(size_t)(MP + r) * 16 + (it & 3) * 4 + F.lane] = F.lane == 0 ? ss : 0.f; }
}
__device__ __forceinline__ void final_phase(Frame& F) {
    const float* H = WSP(float, WS_H); const float* g = INF(36);
    for (int grp = F.gw; grp < MT / 4; grp += F.NGW) { f32x4 x[4][4]; float ss[4];
#pragma unroll
        for (int q = 0; q < 4; ++q) { const int m = grp * 4 + q; ss[q] = 0.f;
#pragma unroll
            for (int j = 0; j < 4; ++j) { x[q][j] = *(const f32x4*)(H + (size_t)m * D + j * 256 + F.lane * 4); ss[q] += (x[q][j].x * x[q][j].x + x[q][j].y * x[q][j].y) + (x[q][j].z * x[q][j].z + x[q][j].w * x[q][j].w); } }
        f32x4 gg[4];
#pragma unroll
        for (int j = 0; j < 4; ++j) gg[j] = *(const f32x4*)(g + j * 256 + F.lane * 4);
#pragma unroll
        for (int q = 0; q < 4; ++q) { const float ir = 1.0f / sqrtf(wave_sum(ss[q]) * (1.0f / D) + RMS_EPS); const int m = grp * 4 + q;
#pragma unroll
            for (int j = 0; j < 4; ++j) { const int c = j * 256 + F.lane * 4; *(f32x4*)(F.out + O_Y + (size_t)m * D + c) = x[q][j] * ir * gg[j]; } } }
}

__global__ void __launch_bounds__(NTHREADS, 2) yoco_fwd(Args args) {
    extern __shared__ __attribute__((aligned(16))) unsigned char lds_raw[];
    Frame F; F.rot = 0; F.lds = (LAS unsigned char*)lds_raw; F.tid = threadIdx.x; F.lane = F.tid & 63; F.wave = __builtin_amdgcn_readfirstlane(F.tid >> 6);
    F.G = gridDim.x; F.gw = blockIdx.x * NWAVES + F.wave; F.NGW = F.G * NWAVES; F.in = args.in; F.out = args.out; F.ws = args.ws;
    volatile LAS unsigned* misc = (volatile LAS unsigned*)(F.lds + LDS_MISC + 16000);
    if (F.tid < 4) misc[F.tid] = 0u;
    __syncthreads();
    const bool single = (args.ph_hi - args.ph_lo) > 1;
    XcdBarrier bar; bar.bar = (unsigned*)(F.ws + WS_CTL); bar.x = 0; bar.st = misc;
    if (single) bar = xcd_barrier_post((unsigned*)(F.ws + WS_CTL), misc);
    int ph = 0;
#define PH_BEGIN if (args.ph_lo <= ph && ph < args.ph_hi) { { int ln_; asm volatile("v_mbcnt_lo_u32_b32 %0, -1, 0\n\tv_mbcnt_hi_u32_b32 %0, -1, %0" : "=v"(ln_)); F.lane = ln_; } \
    { int wv_ = F.wave; unsigned wl_ = (unsigned)(unsigned long long)args.ws, wh_ = (unsigned)((unsigned long long)args.ws >> 32), ol_ = (unsigned)(unsigned long long)args.out, oh_ = (unsigned)((unsigned long long)args.out >> 32); \
      asm volatile("" : "+v"(wv_), "+v"(wl_), "+v"(wh_), "+v"(ol_), "+v"(oh_));     \
      F.wave = __builtin_amdgcn_readfirstlane(wv_); { int bx_ = blockIdx.x; asm volatile("" : "+s"(bx_)); F.bx = bx_; } F.gw = F.bx * NWAVES + F.wave; F.tid = F.wave * 64 + F.lane; \
      F.ws = (unsigned char*)(((unsigned long long)(unsigned)__builtin_amdgcn_readfirstlane(wh_) << 32) | (unsigned)__builtin_amdgcn_readfirstlane(wl_)); \
      F.out = (float*)(((unsigned long long)(unsigned)__builtin_amdgcn_readfirstlane(oh_) << 32) | (unsigned)__builtin_amdgcn_readfirstlane(ol_)); }
#define PH_END   if (single) { int ln2_; asm volatile("v_mbcnt_lo_u32_b32 %0, -1, 0\n\tv_mbcnt_hi_u32_b32 %0, -1, %0" : "=v"(ln2_)); xcd_barrier(bar, F.wave == 0 && ln2_ == 0); } } ++ph;

    PH_BEGIN if (EN_P0) p0_part(F, 0); PH_END
    PH_BEGIN if (EN_P0) p0b_prologue(F); PH_END

    #define H WSP(float, WS_H)
#define HB WSP(bf16_t, WS_HB)
#define RSB WSP(float, WS_RS)
#define FFH WSP(bf16_t, WS_FFH)
#define RS_TBL ((const LAS float*)(F.lds + LDS_TBL))
#define TAIL_WORK(stmt_) if (EN_P0 && F.bx >= 8) { Frame F2 = F; F2.bx = F.bx - 8; F2.G = F.G - 8; F2.gw = F2.bx * NWAVES + F.wave; F2.NGW = F2.G * NWAVES; stmt_ }
#define FFN_PHASES(lf) \
    PH_BEGIN { pg8::StaticOrder S; S.init(MT, 2 * DFF, F.G, F.bx); PMSimple P{(const char*)HB, (const char*)(WSP(bf16_t, WS_WIN) + (size_t)(lf) * 2 * DFF * D), (size_t)256 * D * 2, (size_t)256 * D * 2}; \
        build_rs_table(F.lds, RSB, S, F.tid); EpiFFN1 E{FFH, RS_TBL, 0}; if (EN_GEMM) pg8::gemm_phase(F.lds, F.tid, D, D, D, S, P, E); } PH_END \
    PH_BEGIN { pg8::OrderSplit S; S.init(DFF, F.G, F.bx); PMSimple P{(const char*)FFH, (const char*)(WSP(bf16_t, WS_WOUT) + (size_t)(lf) * D * DFF), (size_t)256 * DFF * 2, (size_t)256 * DFF * 2}; \
        EpiResid E{H, HB, RSB, 0.5f, WSP(float, WS_PART)}; if (EN_GEMM) pg8::gemm_phase(F.lds, F.tid, DFF, DFF, DFF, S, P, E); } PH_END \
    PH_BEGIN resid_reduce_phase(F, DFF / 256, 0.5f); PH_END

    for (int l = 0; l < 2; ++l) {
        FFN_PHASES(l * 2)
        PH_BEGIN if (EN_ELT) r1_phase(F, l); PH_END
        PH_BEGIN { pg8::StaticOrder S; S.init(MT, l == 0 ? NR2 - 256 : NR2, F.G, F.bx);        PMR2 P{(const char*)WSP(bf16_t, WS_XS), (const char*)(WSP(bf16_t, WS_WR2) + (size_t)l * NR2 * D)};
            EpiR2 E{WSP(float, WS_RKV), 2 + l, WSP(bf16_t, WS_LH), WSP(bf16_t, WS_SCN) + (size_t)l * SCN_L}; if (EN_GEMM) pg8::gemm_phase(F.lds, F.tid, D, D, D, S, P, E); } PH_END
        PH_BEGIN { pg8::StaticOrder S; S.init(MT, l == 0 ? NR3 - 1024 : NR3, F.G, F.bx);        PMSimple P{(const char*)WSP(bf16_t, WS_LH), (const char*)(WSP(bf16_t, WS_WR3) + (size_t)l * NR3 * KR3), (size_t)256 * KR3 * 2, (size_t)256 * KR3 * 2};
            EpiR3 E{WSP(float, WS_LU), WSP(bf16_t, WS_SCN) + (size_t)l * SCN_L}; if (EN_GEMM) pg8::gemm_phase(F.lds, F.tid, KR3, KR3, KR3, S, P, E); } PH_END
        PH_BEGIN if (EN_SCAN) { r4_phase(F, l); scanA_phase(F, l); } PH_END
        PH_BEGIN if (EN_SCAN) scanB_phase(F, l); PH_END
        PH_BEGIN if (EN_SCAN) { scanC_phase(F, l); r5b_phase(F, l); } PH_END
        PH_BEGIN { pg8::StaticOrder S; S.init(MT, D, F.G, F.bx); PMSimple P{(const char*)WSP(bf16_t, WS_YG), (const char*)(WSP(bf16_t, WS_WRO) + (size_t)l * D * D), (size_t)256 * D * 2, (size_t)256 * D * 2};
            EpiResid E{H, HB, RSB, 1.0f, nullptr}; if (EN_GEMM) pg8::gemm_phase(F.lds, F.tid, D, D, D, S, P, E);
            TAIL_WORK({ LAS float* scr_ = (LAS float*)(F.lds + F.wave * 16384); F2.rot = 0; p0_ffn(F2, 6 + l, scr_); }) } PH_END
        FFN_PHASES(l * 2 + 1)
    }
    PH_BEGIN { pg8::StaticOrder S; S.init(MT, NKVW, F.G, F.bx); PMSimple P{(const char*)HB, (const char*)WSP(bf16_t, WS_WKV), (size_t)256 * D * 2, (size_t)256 * D * 2};
        build_rs_table(F.lds, RSB, S, F.tid); EpiKV E{F.out, WSP(float, WS_WINP), RS_TBL, 0}; if (EN_GEMM) pg8::gemm_phase(F.lds, F.tid, D, D, D, S, P, E); } PH_END
    PH_BEGIN if (EN_ELT) { cst_phase(F); kvstage_phase(F); } PH_END
    PH_BEGIN { OrderC1 S{F.G, F.bx}; PMC1 P{(const char*)WSP(bf16_t, WS_CST), (const char*)WSP(bf16_t, WS_WC1)}; EpiC1 E{WSP(float, WS_CH)}; if (EN_GEMM) pg8::gemm_phase(F.lds, F.tid, 1024, 1024, 1024, S, P, E); } PH_END
    PH_BEGIN if (EN_ELT) c2_phase(F); PH_END
    for (int l = 0; l < 2; ++l) {
        FFN_PHASES(4 + l * 2)
        PH_BEGIN { pg8::StaticOrder S; S.init(MT, NQI, F.G, F.bx); PMSimple P{(const char*)HB, (const char*)(WSP(bf16_t, WS_WQI) + (size_t)l * NQI * D), (size_t)256 * D * 2, (size_t)256 * D * 2};
            build_rs_table(F.lds, RSB, S, F.tid); EpiQI E{WSP(float, WS_QG), WSP(bf16_t, WS_QB), RS_TBL, 0}; if (EN_GEMM) pg8::gemm_phase(F.lds, F.tid, D, D, D, S, P, E); } PH_END
        PH_BEGIN if (EN_ATT) { attp_phase(F, l); __syncthreads(); atts2_phase(F, l); } PH_END
        PH_BEGIN { pg8::StaticOrder S; S.init(MT, D, F.G, F.bx); PMSimple P{(const char*)WSP(bf16_t, WS_AO), (const char*)(WSP(bf16_t, WS_WBO) + (size_t)l * D * D), (size_t)256 * D * 2, (size_t)256 * D * 2};
            EpiResid E{H, HB, RSB, 1.0f, nullptr}; if (EN_GEMM) pg8::gemm_phase(F.lds, F.tid, D, D, D, S, P, E);
            TAIL_WORK({ swin_copy(F2, 64 + 32 * l, 96 + 32 * l); }) } PH_END
        FFN_PHASES(4 + l * 2 + 1)
    }
    PH_BEGIN if (EN_ELT) final_phase(F); PH_END
}
constexpr int N_PHASES = 2 + 2 * 13 + 4 + 2 * 9 + 1;

extern "C" void kernel_launch(void* const* d_in, const int* in_sizes, int n_in, void* d_out, int out_size, void* d_ws, size_t ws_size, hipStream_t stream) {
    static int grid = 0;
    if (grid == 0) {
        if (n_in != 37 || ws_size < WS_END) { fprintf(stderr, "kernel_launch: expected 37 inputs and >= %zu bytes of workspace (got %d, %zu)\n", (size_t)WS_END, n_in, ws_size); grid = -1; return; }
        int dev = 0, cus = 0, per_cu = 0;
        if (hipGetDevice(&dev) != hipSuccess || hipDeviceGetAttribute(&cus, hipDeviceAttributeMultiprocessorCount, dev) != hipSuccess) { grid = -1; return; }
        if (hipFuncSetAttribute((const void*)yoco_fwd, hipFuncAttributeMaxDynamicSharedMemorySize, LDS_BYTES) != hipSuccess) { fprintf(stderr, "kernel_launch: hipFuncSetAttribute failed\n"); grid = -1; return; }
        if (hipOccupancyMaxActiveBlocksPerMultiprocessor(&per_cu, (const void*)yoco_fwd, NTHREADS, LDS_BYTES) != hipSuccess || per_cu < 1) fprintf(stderr, "kernel_launch: occupancy query says %d\n", per_cu);
        (void)hipGetLastError();
        grid = cus;
    }
    if (grid < 0) return;
    (void)hipMemsetAsync((char*)d_ws + WS_CTL, 0, CTL_BYTES, stream);
    Args a{};
    for (int i = 0; i < 37; ++i) a.in[i] = d_in[i];
    a.out = (float*)d_out; a.ws = (unsigned char*)d_ws;
#if MK_MULTI
    for (int p = 0; p < N_PHASES; ++p) { a.ph_lo = p; a.ph_hi = p + 1; hipLaunchKernelGGL(yoco_fwd, dim3(grid), dim3(NTHREADS), LDS_BYTES, stream, a); }
#else
    a.ph_lo = 0; a.ph_hi = N_PHASES;
    hipLaunchKernelGGL(yoco_fwd, dim3(grid), dim3(NTHREADS), LDS_BYTES, stream, a);
#endif
    const hipError_t le = hipPeekAtLastError();
    if (le != hipSuccess) fprintf(stderr, "kernel_launch: launch failed: %s\n", hipGetErrorName(le));
}
```
